# Optimizing an MI355X kernel written in HIP

```python
import math
import jax
import jax.numpy as jnp
from jax import lax
import numpy as np

D_MODEL = 1024
BATCH = 1
SEQ = 16384
DEPTH = 2

GRID_W = 64
CTX_LEN = 256
BRANCH_W = 512
NA_HEADS = 8
NA_DH = BRANCH_W // NA_HEADS
NA_WIN_R = 8
NA_WIN_C = 16
DA_HEADS = 4
DA_DH = 64
DA_VD = 2 * DA_DH
DA_QK = DA_HEADS * 2 * DA_DH
GM_GROUPS = 4
GM_CHUNK = 128
GM_GW = BRANCH_W // GM_GROUPS
N_BRANCH = 3
N_EXPERTS = 16
EC_CAPACITY = 2
EXPERT_FF = 1024
Q_BLOCK = 128
ROPE_THETA = 10000.0
ROPE_AXIS = DA_DH // 2
N_MOD = 6
EPS = 1e-6
KV_SIZES = (BRANCH_W, BRANCH_W, DA_QK, DA_HEADS * DA_VD)
Q_SIZES = (BRANCH_W, DA_QK, BRANCH_W, BRANCH_W, N_BRANCH * D_MODEL)
KV_COLS = sum(KV_SIZES)
PROJ_COLS = KV_COLS + sum(Q_SIZES)

kernel_name = "hybrid_na_diff_gmlp_ec_block"


def _split(z, sizes):
    offs = np.cumsum(sizes)[:-1].tolist()
    return jnp.split(z, offs, axis=-1)


def rmsnorm(x, g):
    xf = x.astype(jnp.float32)
    y = xf * lax.rsqrt(jnp.mean(xf * xf, axis=-1, keepdims=True) + EPS)
    return y.astype(x.dtype) * g


def layernorm(x, g, b):
    xf = x.astype(jnp.float32)
    mu = jnp.mean(xf, axis=-1, keepdims=True)
    var = jnp.mean(jnp.square(xf - mu), axis=-1, keepdims=True)
    return ((xf - mu) * lax.rsqrt(var + EPS)).astype(x.dtype) * g + b


def modulate(h, shift, scale):
    return h * (1 + scale) + shift


def rope_tables(n):
    t = jnp.arange(n)
    inv = ROPE_THETA ** (-jnp.arange(0, ROPE_AXIS, 2, dtype=jnp.float32) / ROPE_AXIS)
    ang_r = (t // GRID_W).astype(jnp.float32)[:, None] * inv
    ang_c = (t % GRID_W).astype(jnp.float32)[:, None] * inv
    return (jnp.cos(ang_r), jnp.sin(ang_r), jnp.cos(ang_c), jnp.sin(ang_c))


def _rot(x, cos, sin):
    x1, x2 = jnp.split(x, 2, axis=-1)
    return jnp.concatenate([x1 * cos - x2 * sin, x1 * sin + x2 * cos], axis=-1)


def rope_2d(x, tabs):
    cr, sr, cc, sc = [t.astype(x.dtype)[None, :, None, None, :] for t in tabs]
    xr, xcol = jnp.split(x, 2, axis=-1)
    return jnp.concatenate([_rot(xr, cr, sr), _rot(xcol, cc, sc)], axis=-1)


def dense_attn(q, k, v):
    B, n, H, dh = q.shape
    s = jnp.einsum('bqhd,bkhd->bhqk', q, k) * (dh ** -0.5)
    p = jax.nn.softmax(s.astype(jnp.float32), axis=-1).astype(v.dtype)
    return jnp.einsum('bhqk,bkhd->bqhd', p, v).reshape(B, n, H * dh)


def neighbourhood_attn(q, k, v, kc, vc, rpb):
    B, L, H, dh = q.shape
    Lc = kc.shape[1]
    rows = L // GRID_W
    wr = min(NA_WIN_R, rows)
    scale = dh ** -0.5
    kg = k.reshape(B, rows, GRID_W, H, dh)
    vg = v.reshape(B, rows, GRID_W, H, dh)
    qg = jnp.moveaxis(q.reshape(B, rows, GRID_W, H, dh), 1, 0)
    col = jnp.arange(GRID_W)
    col_start = jnp.clip(col - NA_WIN_C // 2, 0, GRID_W - NA_WIN_C)
    col_idx = col_start[:, None] + jnp.arange(NA_WIN_C)[None, :]
    dc = col_idx - col[:, None] + (NA_WIN_C - 1)

    def row_block(args):
        r, qr = args
        r0 = jnp.clip(r - wr // 2, 0, rows - wr)
        kw = lax.dynamic_slice_in_dim(kg, r0, wr, axis=1)[:, :, col_idx]
        vw = lax.dynamic_slice_in_dim(vg, r0, wr, axis=1)[:, :, col_idx]
        dr = r0 + jnp.arange(wr) - r + (NA_WIN_R - 1)
        bias = jnp.transpose(rpb[:, dr[:, None, None], dc[None]], (0, 2, 1, 3))
        s_loc = jnp.einsum('bqhd,brqjhd->bhqrj', qr, kw) * scale + bias[None]
        s_ctx = jnp.einsum('bqhd,bchd->bhqc', qr, kc) * scale
        s = jnp.concatenate([s_ctx, s_loc.reshape(B, H, GRID_W, wr * NA_WIN_C)], axis=-1)
        p = jax.nn.softmax(s.astype(jnp.float32), axis=-1).astype(v.dtype)
        p_loc = p[..., Lc:].reshape(B, H, GRID_W, wr, NA_WIN_C)
        return (jnp.einsum('bhqc,bchd->bqhd', p[..., :Lc], vc)
                + jnp.einsum('bhqrj,brqjhd->bqhd', p_loc, vw))

    out = lax.map(row_block, (jnp.arange(rows), qg))
    return jnp.moveaxis(out, 0, 1).reshape(B, L, H * dh)


def diff_attend(q, k, v, lam):
    s = jnp.einsum('bqhcd,bkhcd->bhcqk', q, k) * (q.shape[-1] ** -0.5)
    p = jax.nn.softmax(s.astype(jnp.float32), axis=-1)
    a = (p[:, :, 0] - lam * p[:, :, 1]).astype(v.dtype)
    return jnp.einsum('bhqk,bkhd->bqhd', a, v)


def diff_attn_blocks(q, k, v, lam):
    B, L, H, _, dh = q.shape
    nb = L // Q_BLOCK
    qblk = jnp.moveaxis(q.reshape(B, nb, Q_BLOCK, H, 2, dh), 1, 0)
    out = lax.map(lambda qb: diff_attend(qb, k, v, lam), qblk)
    return jnp.moveaxis(out, 0, 1).reshape(B, L, H, v.shape[-1])


def diff_head_norm(o, g, lam_init):
    B, n = o.shape[:2]
    return (rmsnorm(o, g) * (1.0 - lam_init)).reshape(B, n, -1)


def gmlp_gate(u, v, ln_g, ln_b, w_s, b_s):
    B, n, _ = u.shape
    vn = layernorm(v, ln_g, ln_b).reshape(B, n // GM_CHUNK, GM_CHUNK, GM_GROUPS, GM_GW)
    mixed = jnp.einsum('gpq,bnqgc->bnpgc', w_s, vn) + jnp.swapaxes(b_s, 0, 1)[:, :, None]
    return u * mixed.reshape(B, n, BRANCH_W)


def branch_merge(ya, yb, yc, gates, w_branch, w_out):
    ga, gb, gc = jnp.split(jax.nn.sigmoid(gates), N_BRANCH, axis=-1)
    m = ga * (ya @ w_branch[0]) + gb * (yb @ w_branch[1]) + gc * (yc @ w_branch[2])
    return m @ w_out


def ec_moe(h, w_r, w1, w3, w2):
    B, n, D = h.shape
    cap = max(1, EC_CAPACITY * n // N_EXPERTS)
    aff = jax.nn.softmax((h @ w_r).astype(jnp.float32), axis=-1)
    gate, idx = lax.top_k(jnp.swapaxes(aff, 1, 2), cap)
    xin = jax.vmap(lambda hb, ib: hb[ib])(h, idx)
    hid = jax.nn.silu(jnp.einsum('becd,edf->becf', xin, w1)) * jnp.einsum('becd,edf->becf', xin, w3)
    ye = jnp.einsum('becf,efd->becd', hid, w2) * gate[..., None].astype(h.dtype)
    return jax.vmap(lambda yb, ib: jnp.zeros((n, D), h.dtype).at[ib.reshape(-1)].add(yb.reshape(-1, D)))(ye, idx)


def _na_heads(t):
    return t.reshape(t.shape[0], t.shape[1], NA_HEADS, NA_DH)


def _da_qk(t):
    return t.reshape(t.shape[0], t.shape[1], DA_HEADS, 2, DA_DH)


def _da_v(t):
    return t.reshape(t.shape[0], t.shape[1], DA_HEADS, DA_VD)


def setup_inputs(seed: int = 0) -> dict:
    key = jax.random.key(seed)
    ks = jax.random.split(key, 32)
    f32 = jnp.float32

    def nrm(k, shape, scale):
        return jax.random.normal(k, shape, f32) * scale

    D = D_MODEL
    return {
        "x": nrm(ks[0], (BATCH, SEQ, D), 1.0),
        "c": nrm(ks[1], (BATCH, D), 1.0),
        "ctx": nrm(ks[2], (BATCH, CTX_LEN, D), 1.0),
        "c_ctx": nrm(ks[3], (D,), 1.0),
        "w_ada": nrm(ks[4], (DEPTH, D, N_MOD * D), 0.5 * D ** -0.5),
        "b_ada": nrm(ks[5], (DEPTH, N_MOD * D), 0.02),
        "g_norm1": 1.0 + nrm(ks[6], (DEPTH, D), 0.05),
        "g_norm2": 1.0 + nrm(ks[7], (DEPTH, D), 0.05),
        "w_in": nrm(ks[8], (DEPTH, D, PROJ_COLS), D ** -0.5),
        "na_rpb": nrm(ks[9], (DEPTH, NA_HEADS, 2 * NA_WIN_R - 1, 2 * NA_WIN_C - 1), 0.1),
        "da_lam_q1": nrm(ks[10], (DEPTH, DA_DH), 0.1),
        "da_lam_k1": nrm(ks[11], (DEPTH, DA_DH), 0.1),
        "da_lam_q2": nrm(ks[12], (DEPTH, DA_DH), 0.1),
        "da_lam_k2": nrm(ks[13], (DEPTH, DA_DH), 0.1),
        "da_subln_g": 1.0 + nrm(ks[14], (DEPTH, DA_VD), 0.05),
        "gm_ln_g": 1.0 + nrm(ks[15], (DEPTH, BRANCH_W), 0.05),
        "gm_ln_b": nrm(ks[16], (DEPTH, BRANCH_W), 0.02),
        "gm_w_s": nrm(ks[17], (DEPTH, GM_GROUPS, GM_CHUNK, GM_CHUNK), GM_CHUNK ** -0.5),
        "gm_b_s": 1.0 + nrm(ks[18], (DEPTH, GM_GROUPS, GM_CHUNK), 0.1),
        "w_branch": nrm(ks[19], (DEPTH, N_BRANCH, BRANCH_W, D), BRANCH_W ** -0.5),
        "w_out": nrm(ks[20], (DEPTH, D, D), D ** -0.5),
        "w_router": nrm(ks[21], (DEPTH, D, N_EXPERTS), D ** -0.5),
        "w_e1": nrm(ks[22], (DEPTH, N_EXPERTS, D, EXPERT_FF), D ** -0.5),
        "w_e3": nrm(ks[23], (DEPTH, N_EXPERTS, D, EXPERT_FF), D ** -0.5),
        "w_e2": nrm(ks[24], (DEPTH, N_EXPERTS, EXPERT_FF, D), EXPERT_FF ** -0.5),
        "g_final": 1.0 + nrm(ks[25], (D,), 0.05),
    }


def reference(x, c, ctx, c_ctx, w_ada, b_ada, g_norm1, g_norm2, w_in, na_rpb,
              da_lam_q1, da_lam_k1, da_lam_q2, da_lam_k2, da_subln_g,
              gm_ln_g, gm_ln_b, gm_w_s, gm_b_s, w_branch, w_out,
              w_router, w_e1, w_e3, w_e2, g_final):
    L = x.shape[1]
    tabs = rope_tables(L)
    xc = ctx
    for i in range(DEPTH):
        last = i == DEPTH - 1
        mod = jax.nn.silu(c) @ w_ada[i] + b_ada[i]
        sh1, sc1, gt1, sh2, sc2, gt2 = jnp.split(mod[:, None, :], N_MOD, axis=-1)
        modc = jax.nn.silu(c_ctx) @ w_ada[i] + b_ada[i]
        sh1c, sc1c, gt1c, sh2c, sc2c, gt2c = jnp.split(modc, N_MOD, axis=-1)
        lam_init = 0.8 - 0.6 * math.exp(-0.3 * i)
        lam = (jnp.exp(jnp.sum(da_lam_q1[i].astype(jnp.float32) * da_lam_k1[i].astype(jnp.float32)))
               - jnp.exp(jnp.sum(da_lam_q2[i].astype(jnp.float32) * da_lam_k2[i].astype(jnp.float32)))
               + lam_init)

        h = modulate(rmsnorm(x, g_norm1[i]), sh1, sc1)
        hc = modulate(rmsnorm(xc, g_norm1[i]), sh1c, sc1c)
        ka, va, kb, vb, qa, qb, u, v, gates = _split(h @ w_in[i], KV_SIZES + Q_SIZES)
        if last:
            kac, vac, kbc, vbc = _split(hc @ w_in[i][:, :KV_COLS], KV_SIZES)
        else:
            kac, vac, kbc, vbc, qac, qbc, uc, vcc, gatesc = _split(hc @ w_in[i], KV_SIZES + Q_SIZES)

        ya = neighbourhood_attn(_na_heads(qa), _na_heads(ka), _na_heads(va),
                                _na_heads(kac), _na_heads(vac), na_rpb[i])
        kb_all = jnp.concatenate([_da_qk(kbc), rope_2d(_da_qk(kb), tabs)], axis=1)
        vb_all = jnp.concatenate([_da_v(vbc), _da_v(vb)], axis=1)
        yb = diff_head_norm(diff_attn_blocks(rope_2d(_da_qk(qb), tabs), kb_all, vb_all, lam),
                            da_subln_g[i], lam_init)
        yc = gmlp_gate(jax.nn.gelu(u), jax.nn.gelu(v), gm_ln_g[i], gm_ln_b[i], gm_w_s[i], gm_b_s[i])
        x = x + gt1 * branch_merge(ya, yb, yc, gates, w_branch[i], w_out[i])
        if not last:
            yac = dense_attn(_na_heads(qac), _na_heads(kac), _na_heads(vac))
            ybc = diff_head_norm(diff_attend(_da_qk(qbc), _da_qk(kbc), _da_v(vbc), lam),
                                 da_subln_g[i], lam_init)
            ycc = gmlp_gate(jax.nn.gelu(uc), jax.nn.gelu(vcc), gm_ln_g[i], gm_ln_b[i], gm_w_s[i], gm_b_s[i])
            xc = xc + gt1c * branch_merge(yac, ybc, ycc, gatesc, w_branch[i], w_out[i])

        h2 = modulate(rmsnorm(x, g_norm2[i]), sh2, sc2)
        x = x + gt2 * ec_moe(h2, w_router[i], w_e1[i], w_e3[i], w_e2[i])
        if not last:
            h2c = modulate(rmsnorm(xc, g_norm2[i]), sh2c, sc2c)
            xc = xc + gt2c * ec_moe(h2c, w_router[i], w_e1[i], w_e3[i], w_e2[i])
    return rmsnorm(x, g_final)
```

```cpp
#include <hip/hip_runtime.h>
#include <cstdint>
#include <cstdio>

typedef unsigned short bf16_t;
__device__ __forceinline__ float bf2f(bf16_t b) { return __uint_as_float(((unsigned)b) << 16); }
__device__ __forceinline__ bf16_t f2bf(float f) { unsigned u = __float_as_uint(f); return (bf16_t)((u + 0x7fffu + ((u >> 16) & 1u)) >> 16); }

constexpr int D = 1024, L = 16384, C = 256, R = L + C, PROJ = 7168, NE = 16, FF = 1024;
constexpr int CAPL = 2048, CAPC = 32, SLOTS = 2304;
constexpr float EPS = 1e-6f;
constexpr float C2 = 0.125f * 1.4426950408889634f;
constexpr int ZKA = 0, ZVA = 512, ZKB = 1024, ZVB = 1536, ZQA = 2048, ZQB = 2560, ZU = 3072, ZV = 3584, ZG = 4096;

constexpr size_t MiB = 1u << 20;
constexpr size_t WS_SMALL = 0;
constexpr size_t OFF_MOD = 0;
constexpr size_t OFF_ROPE = 256 * 1024;
constexpr size_t OFF_LAM = 320 * 1024;
constexpr size_t OFF_GST = 384 * 1024;
constexpr size_t OFF_AFF = 1 * MiB;
constexpr size_t OFF_INV = 2 * MiB + 256 * 1024;
constexpr size_t OFF_IDX = 3 * MiB + 512 * 1024;
constexpr size_t OFF_GATE = 3 * MiB + 768 * 1024;
constexpr size_t WS_XC = 4 * MiB;
constexpr size_t WS_WIN = 5 * MiB;
constexpr size_t WS_WBR = 33 * MiB;
constexpr size_t WS_WOUT = 39 * MiB;
constexpr size_t WS_W13 = 43 * MiB;
constexpr size_t WS_W2 = 171 * MiB;
constexpr size_t WS_H = 235 * MiB;
constexpr size_t WS_Y = 268 * MiB;
constexpr size_t WS_Z = 317 * MiB;
constexpr size_t WS_END = 545 * MiB;
constexpr size_t ZO_HIDRAW = 0;
constexpr size_t ZO_HID = 144 * MiB;
constexpr size_t ZO_YE = 0;

__device__ __forceinline__ float gelu_tanh(float x) { const float y = 1.5957691216057308f * (x + 0.044715f * x * x * x); return x / (1.f + __expf(-y)); }
__device__ __forceinline__ float sigmoidf_(float x) { return 1.f / (1.f + __expf(-x)); }
__device__ __forceinline__ float wave_sum(float v) {
#pragma unroll
    for (int o = 1; o < 64; o <<= 1) v += __shfl_xor(v, o);
    return v;
}

__global__ void k_wt(const float* __restrict__ W, bf16_t* __restrict__ WT, int K, int N, int mode, size_t sstride, size_t dstride) {
    __shared__ float t[32][33];
    const float* w = W + (size_t)blockIdx.z * sstride; bf16_t* o = WT + (size_t)blockIdx.z * dstride;
    const int n0 = blockIdx.x * 32, k0 = blockIdx.y * 32, tx = threadIdx.x, ty = threadIdx.y;
    for (int i = ty; i < 32; i += 8) t[i][tx] = w[(size_t)(k0 + i) * N + n0 + tx];
    __syncthreads();
    for (int i = ty; i < 32; i += 8) { const int n = n0 + i; const int row = mode == 0 ? n : (256 * (n / 128) + (n % 128) + (mode == 2 ? 128 : 0));
        o[(size_t)row * K + k0 + tx] = f2bf(t[tx][i]); }
}
__global__ void k_mod(const float* __restrict__ c, const float* __restrict__ cc, const float* __restrict__ w_ada, const float* __restrict__ b_ada, float* __restrict__ mod) {
    const int gid = blockIdx.x * blockDim.x + threadIdx.x; if (gid >= 2 * 6144) return;
    const int l = gid / 6144, n = gid % 6144; const float* w = w_ada + (size_t)l * D * 6144;
    float a0 = 0.f, a1 = 0.f;
    for (int k = 0; k < D; ++k) { const float wv = w[(size_t)k * 6144 + n]; const float x0 = c[k], x1 = cc[k];
        a0 += (x0 / (1.f + __expf(-x0))) * wv; a1 += (x1 / (1.f + __expf(-x1))) * wv; }
    const float b = b_ada[l * 6144 + n];
    mod[(l * 2 + 0) * 6144 + n] = a0 + b; mod[(l * 2 + 1) * 6144 + n] = a1 + b;
}
__global__ void k_misc(float* __restrict__ rope, float* __restrict__ lam, const float* q1, const float* k1, const float* q2, const float* k2) {
    const int t = blockIdx.x * blockDim.x + threadIdx.x;
    if (t < 320 * 16) { const int pos = t / 16, j = t % 16; const float inv = powf(10000.f, -(float)(2 * j) / 32.f);
        if (pos < 256) { const float a = (float)pos * inv; rope[pos * 16 + j] = cosf(a); rope[4096 + pos * 16 + j] = sinf(a); }
        else { const int p = pos - 256; const float a = (float)p * inv; rope[8192 + p * 16 + j] = cosf(a); rope[8192 + 1024 + p * 16 + j] = sinf(a); } }
    if (t < 2) { float s1 = 0.f, s2 = 0.f; for (int i = 0; i < 64; ++i) { s1 += q1[t * 64 + i] * k1[t * 64 + i]; s2 += q2[t * 64 + i] * k2[t * 64 + i]; }
        const float li = 0.8f - 0.6f * expf(-0.3f * (float)t); lam[t] = expf(s1) - expf(s2) + li; }
}
__global__ void k_h1(const float* __restrict__ xl, const float* __restrict__ xc, const float* __restrict__ g, const float* __restrict__ mod, int sh_off, int sc_off, bf16_t* __restrict__ H, int nrows) {
    const int row = blockIdx.x * 4 + (threadIdx.x >> 6), lane = threadIdx.x & 63; if (row >= nrows) return;
    const float* x = row < L ? xl + (size_t)row * D : xc + (size_t)(row - L) * D; const float* m = mod + (row < L ? 0 : 6144);
    float v[16]; float s = 0.f;
#pragma unroll
    for (int j = 0; j < 4; ++j) { const float4 t = *(const float4*)(x + j * 256 + lane * 4); v[4 * j] = t.x; v[4 * j + 1] = t.y; v[4 * j + 2] = t.z; v[4 * j + 3] = t.w; s += t.x * t.x + t.y * t.y + t.z * t.z + t.w * t.w; }
    const float rs = rsqrtf(wave_sum(s) * (1.f / D) + EPS);
#pragma unroll
    for (int j = 0; j < 4; ++j)
#pragma unroll
        for (int i = 0; i < 4; ++i) { const int d = j * 256 + lane * 4 + i; H[(size_t)row * D + d] = f2bf(v[4 * j + i] * rs * g[d] * (1.f + m[sc_off + d]) + m[sh_off + d]); }
}

struct EStore { bf16_t* dst; size_t ldc; size_t zstride;
    __device__ void operator()(int z, int m, int n, float acc) const { dst[(size_t)z * zstride + (size_t)m * ldc + n] = f2bf(acc); } };
struct EMerge { bf16_t* Mb; const bf16_t* Z; long long j;
    __device__ void operator()(int z, int m, int n, float acc) const { const float g = bf2f(Z[(size_t)m * PROJ + ZG + j * 1024 + n]); bf16_t* p = Mb + (size_t)m * D + n;
        const float prev = j == 0 ? 0.f : bf2f(*p); *p = f2bf(prev + g * acc); } };
struct EResid { const float* xl_old; const float* xc_old; float* xl_new; float* xc_new; const float* mod; long long gt_off;
    __device__ void operator()(int z, int m, int n, float acc) const {
        if (m < L) xl_new[(size_t)m * D + n] = xl_old[(size_t)m * D + n] + mod[gt_off + n] * acc;
        else xc_new[(size_t)(m - L) * D + n] = xc_old[(size_t)(m - L) * D + n] + mod[6144 + gt_off + n] * acc; } };
struct EYe { bf16_t* YE; const float* gate;
    __device__ void operator()(int z, int m, int n, float acc) const { YE[((size_t)z * SLOTS + m) * D + n] = f2bf(acc * gate[z * SLOTS + m]); } };

template <class Epi>
__global__ void __launch_bounds__(256) k_gemm(const bf16_t* __restrict__ A, int lda, size_t a_z, const int* __restrict__ gather, int g_z, const bf16_t* __restrict__ Bt, size_t b_z, int K, Epi epi) {
    __shared__ float As[16][68], Bs[16][68];
    const int z = blockIdx.z, m0 = blockIdx.y * 64, n0 = blockIdx.x * 64, t = threadIdx.x, tx = t & 15, ty = t >> 4;
    const int lr = t >> 2, lk = (t & 3) * 4;
    const int arow = gather ? gather[z * g_z + m0 + lr] : (m0 + lr);
    const bf16_t* ap = A + (size_t)z * a_z + (size_t)arow * lda + lk; const bf16_t* bp = Bt + (size_t)z * b_z + (size_t)(n0 + lr) * K + lk;
    float acc[4][4] = {};
    for (int k0 = 0; k0 < K; k0 += 16) {
        const uint2 av = *(const uint2*)(ap + k0), bv = *(const uint2*)(bp + k0);
        As[lk][lr] = __uint_as_float(av.x << 16); As[lk + 1][lr] = __uint_as_float(av.x & 0xffff0000u); As[lk + 2][lr] = __uint_as_float(av.y << 16); As[lk + 3][lr] = __uint_as_float(av.y & 0xffff0000u);
        Bs[lk][lr] = __uint_as_float(bv.x << 16); Bs[lk + 1][lr] = __uint_as_float(bv.x & 0xffff0000u); Bs[lk + 2][lr] = __uint_as_float(bv.y << 16); Bs[lk + 3][lr] = __uint_as_float(bv.y & 0xffff0000u);
        __syncthreads();
#pragma unroll
        for (int kk = 0; kk < 16; ++kk) { const float4 a = *(const float4*)&As[kk][ty * 4], b = *(const float4*)&Bs[kk][tx * 4];
            const float aa[4] = {a.x, a.y, a.z, a.w}, bb[4] = {b.x, b.y, b.z, b.w};
#pragma unroll
            for (int i = 0; i < 4; ++i)
#pragma unroll
                for (int j = 0; j < 4; ++j) acc[i][j] += aa[i] * bb[j]; }
        __syncthreads();
    }
#pragma unroll
    for (int i = 0; i < 4; ++i)
#pragma unroll
        for (int j = 0; j < 4; ++j) epi(z, m0 + ty * 4 + i, n0 + tx * 4 + j, acc[i][j]);
}

__global__ void k_zfix(bf16_t* __restrict__ Z, const float* __restrict__ rope, int nrows) {
    const size_t gid = (size_t)blockIdx.x * blockDim.x + threadIdx.x; const int row = (int)(gid / PROJ), col = (int)(gid % PROJ); if (row >= nrows) return;
    bf16_t* zr = Z + (size_t)row * PROJ;
    if ((col >= ZKB && col < ZVB) || (col >= ZQB && col < ZU)) {
        const int d = col & 63; const float sc = col >= ZQB ? C2 : 1.f;
        if (row >= L) { if ((d & 16) == 0) { zr[col] = f2bf(bf2f(zr[col]) * sc); zr[col + 16] = f2bf(bf2f(zr[col + 16]) * sc); } return; }
        if (d & 16) return;
        const int j = d & 15; const bool colhalf = (d & 32) != 0; const int pos = colhalf ? (row & 63) : (row >> 6);
        const float cs = colhalf ? rope[8192 + pos * 16 + j] : rope[pos * 16 + j], sn = colhalf ? rope[8192 + 1024 + pos * 16 + j] : rope[4096 + pos * 16 + j];
        const float x1 = bf2f(zr[col]), x2 = bf2f(zr[col + 16]);
        zr[col] = f2bf((x1 * cs - x2 * sn) * sc); zr[col + 16] = f2bf((x1 * sn + x2 * cs) * sc);
    } else if (col >= ZU && col < ZG) zr[col] = f2bf(gelu_tanh(bf2f(zr[col])));
    else if (col >= ZG) zr[col] = f2bf(sigmoidf_(bf2f(zr[col])));
}

__global__ void __launch_bounds__(256) k_na(const bf16_t* __restrict__ Z, const float* __restrict__ rpb, bf16_t* __restrict__ Y, int row_base) {
    const int lane = threadIdx.x & 63, head = blockIdx.y * 4 + (threadIdx.x >> 6); const int row = row_base + blockIdx.x * 64 + lane;
    float q[64], acc[64];
#pragma unroll
    for (int d = 0; d < 64; ++d) { q[d] = bf2f(Z[(size_t)row * PROJ + ZQA + head * 64 + d]) * 0.125f; acc[d] = 0.f; }
    float m = -1e30f, l = 0.f;
    auto step = [&](int krow, float bias) {
        const bf16_t* kp = Z + (size_t)krow * PROJ + ZKA + head * 64; const bf16_t* vp = Z + (size_t)krow * PROJ + ZVA + head * 64;
        float s = bias;
#pragma unroll
        for (int d = 0; d < 64; ++d) s += q[d] * bf2f(kp[d]);
        if (s > m) { const float f = __expf(m - s); l *= f;
#pragma unroll
            for (int d = 0; d < 64; ++d) acc[d] *= f;
            m = s; }
        const float p = __expf(s - m); l += p;
#pragma unroll
        for (int d = 0; d < 64; ++d) acc[d] += p * bf2f(vp[d]);
    };
    for (int c = 0; c < C; ++c) step(L + c, 0.f);
    if (row < L) {
        const int r = row >> 6, col = row & 63; int r0 = r - 4; r0 = r0 < 0 ? 0 : (r0 > 248 ? 248 : r0); int c0 = col - 8; c0 = c0 < 0 ? 0 : (c0 > 48 ? 48 : c0);
        for (int i = 0; i < 8; ++i) for (int j = 0; j < 16; ++j) { const int dr = r0 + i - r + 7, dc = c0 + j - col + 15; step((r0 + i) * 64 + c0 + j, rpb[(head * 15 + dr) * 31 + dc]); }
    }
    const float il = 1.f / l;
#pragma unroll
    for (int d = 0; d < 64; ++d) Y[(size_t)row * 1536 + head * 64 + d] = f2bf(acc[d] * il);
}

__global__ void __launch_bounds__(256) k_da(const bf16_t* __restrict__ Z, const float* __restrict__ lamp, const float* __restrict__ subg, float one_minus_li, bf16_t* __restrict__ Y, int row_base, int key_lo, int key_hi) {
    extern __shared__ float sm[];
    const int lane = threadIdx.x & 63, w = __builtin_amdgcn_readfirstlane(threadIdx.x >> 6), cmap = w & 1, half = w >> 1, head = blockIdx.y;
    const int row = row_base + blockIdx.x * 64 + lane;
    float q[64], acc[64];
#pragma unroll
    for (int d = 0; d < 64; ++d) { q[d] = bf2f(Z[(size_t)row * PROJ + ZQB + head * 128 + cmap * 64 + d]); acc[d] = 0.f; }
    float m = -1e30f, l = 0.f;
    for (int kr = key_lo; kr < key_hi; ++kr) {
        const bf16_t* kp = Z + (size_t)kr * PROJ + ZKB + head * 128 + cmap * 64; const bf16_t* vp = Z + (size_t)kr * PROJ + ZVB + head * 128 + half * 64;
        float s = 0.f;
#pragma unroll
        for (int d = 0; d < 64; ++d) s += q[d] * bf2f(kp[d]);
        if (s > m) { const float f = exp2f(m - s); l *= f;
#pragma unroll
            for (int d = 0; d < 64; ++d) acc[d] *= f;
            m = s; }
        const float p = exp2f(s - m); l += p;
#pragma unroll
        for (int d = 0; d < 64; ++d) acc[d] += p * bf2f(vp[d]);
    }
    const float il = 1.f / l;
#pragma unroll
    for (int d = 0; d < 64; ++d) sm[(w * 64 + lane) * 64 + d] = acc[d] * il;
    __syncthreads();
    const float lam = lamp[0]; float o[32]; float ss = 0.f;
#pragma unroll
    for (int i = 0; i < 32; ++i) { const int dv = w * 32 + i, hf = dv >> 6, dd = dv & 63; const float a0 = sm[((hf * 2 + 0) * 64 + lane) * 64 + dd], a1 = sm[((hf * 2 + 1) * 64 + lane) * 64 + dd]; o[i] = a0 - lam * a1; ss += o[i] * o[i]; }
    __syncthreads();
    sm[lane * 4 + w] = ss;
    __syncthreads();
    const float tot = sm[lane * 4] + sm[lane * 4 + 1] + sm[lane * 4 + 2] + sm[lane * 4 + 3];
    const float rs = rsqrtf(tot * (1.f / 128.f) + EPS) * one_minus_li;
#pragma unroll
    for (int i = 0; i < 32; ++i) { const int dv = w * 32 + i; Y[(size_t)row * 1536 + 512 + head * 128 + dv] = f2bf(o[i] * rs * subg[dv]); }
}

__global__ void k_gm_stats(const bf16_t* __restrict__ Z, float* __restrict__ gst, int nrows) {
    const int row = blockIdx.x * 4 + (threadIdx.x >> 6), lane = threadIdx.x & 63; if (row >= nrows) return;
    float v[8]; float s = 0.f;
#pragma unroll
    for (int i = 0; i < 8; ++i) { v[i] = bf2f(Z[(size_t)row * PROJ + ZV + lane * 8 + i]); s += v[i]; }
    const float mean = wave_sum(s) * (1.f / 512.f); float q = 0.f;
#pragma unroll
    for (int i = 0; i < 8; ++i) { const float d = v[i] - mean; q += d * d; }
    const float var = wave_sum(q) * (1.f / 512.f);
    if (lane == 0) { gst[row * 2] = mean; gst[row * 2 + 1] = rsqrtf(var + EPS); }
}
__global__ void k_gm_mix(const bf16_t* __restrict__ Z, const float* __restrict__ gst, const float* __restrict__ ln_g, const float* __restrict__ ln_b, const float* __restrict__ w_s, const float* __restrict__ b_s, bf16_t* __restrict__ Y, int nrows) {
    const size_t gid = (size_t)blockIdx.x * blockDim.x + threadIdx.x; const int row = (int)(gid / 512), ch = (int)(gid % 512); if (row >= nrows) return;
    const int chunk = row >> 7, p = row & 127, g = ch >> 7; const float lg = ln_g[ch], lb = ln_b[ch];
    float acc = 0.f;
    for (int qq = 0; qq < 128; ++qq) { const int r2 = chunk * 128 + qq; const float vn = (bf2f(Z[(size_t)r2 * PROJ + ZV + ch]) - gst[r2 * 2]) * gst[r2 * 2 + 1] * lg + lb; acc += w_s[(g * 128 + p) * 128 + qq] * vn; }
    acc += b_s[g * 128 + p];
    Y[(size_t)row * 1536 + 1024 + ch] = f2bf(bf2f(Z[(size_t)row * PROJ + ZU + ch]) * acc);
}

__global__ void k_h2(const float* __restrict__ xl, const float* __restrict__ xc, const float* __restrict__ g, const float* __restrict__ mod, const float* __restrict__ w_r, bf16_t* __restrict__ H2, float* __restrict__ aff, int nrows) {
    const int row = blockIdx.x * 4 + (threadIdx.x >> 6), lane = threadIdx.x & 63; if (row >= nrows) return;
    const float* x = row < L ? xl + (size_t)row * D : xc + (size_t)(row - L) * D; const float* m = mod + (row < L ? 0 : 6144);
    float v[16]; float s = 0.f;
#pragma unroll
    for (int j = 0; j < 4; ++j) { const float4 t = *(const float4*)(x + j * 256 + lane * 4); v[4 * j] = t.x; v[4 * j + 1] = t.y; v[4 * j + 2] = t.z; v[4 * j + 3] = t.w; s += t.x * t.x + t.y * t.y + t.z * t.z + t.w * t.w; }
    const float rs = rsqrtf(wave_sum(s) * (1.f / D) + EPS);
    float lg[16];
#pragma unroll
    for (int e = 0; e < 16; ++e) lg[e] = 0.f;
#pragma unroll
    for (int j = 0; j < 4; ++j)
#pragma unroll
        for (int i = 0; i < 4; ++i) { const int d = j * 256 + lane * 4 + i; const float h = v[4 * j + i] * rs * g[d] * (1.f + m[4096 + d]) + m[3072 + d]; H2[(size_t)row * D + d] = f2bf(h);
            const float4* wr = (const float4*)(w_r + (size_t)d * 16);
#pragma unroll
            for (int e4 = 0; e4 < 4; ++e4) { const float4 w4 = wr[e4]; lg[4 * e4] += h * w4.x; lg[4 * e4 + 1] += h * w4.y; lg[4 * e4 + 2] += h * w4.z; lg[4 * e4 + 3] += h * w4.w; } }
    float mx = -1e30f;
#pragma unroll
    for (int e = 0; e < 16; ++e) { lg[e] = wave_sum(lg[e]); mx = fmaxf(mx, lg[e]); }
    float den = 0.f;
#pragma unroll
    for (int e = 0; e < 16; ++e) { lg[e] = expf(lg[e] - mx); den += lg[e]; }
    if (lane < 16) { float r = 0.f;
#pragma unroll
        for (int e = 0; e < 16; ++e) r = (lane == e) ? lg[e] : r;
        aff[(size_t)row * 16 + lane] = r / den; }
}
__global__ void __launch_bounds__(1024) k_select(const float* __restrict__ aff, int* __restrict__ idx, float* __restrict__ gate, int* __restrict__ inv, int do_ctx) {
    __shared__ int red[32]; __shared__ int sc_gt[1024], sc_eq[1024];
    const int e = blockIdx.x, set = blockIdx.y, t = threadIdx.x;
    const int n = set == 0 ? L : C, base = set == 0 ? 0 : L, cap = set == 0 ? CAPL : CAPC, sbase = set == 0 ? 0 : CAPL, per = set == 0 ? 16 : 1;
    if (set == 1) { for (int s = CAPL + (do_ctx ? CAPC : 0) + t; s < SLOTS; s += 1024) { idx[e * SLOTS + s] = 0; gate[e * SLOTS + s] = 0.f; } if (!do_ctx) return; }
    const bool act = t * per < n;
    unsigned v[16];
    for (int i = 0; i < per; ++i) v[i] = act ? __float_as_uint(aff[(size_t)(base + t * per + i) * 16 + e]) : 0u;
    unsigned T = 0u;
    for (int bit = 31; bit >= 0; --bit) {
        const unsigned cand = T | (1u << bit); int cnt = 0;
        for (int i = 0; i < per; ++i) cnt += (act && v[i] >= cand) ? 1 : 0;
        for (int o = 1; o < 64; o <<= 1) cnt += __shfl_xor(cnt, o);
        __syncthreads(); if ((t & 63) == 0) red[t >> 6] = cnt; __syncthreads();
        int tot = 0; for (int i = 0; i < 16; ++i) tot += red[i];
        if (tot >= cap) T = cand;
    }
    int gtc = 0, eqc = 0;
    for (int i = 0; i < per; ++i) { gtc += (act && v[i] > T) ? 1 : 0; eqc += (act && v[i] == T) ? 1 : 0; }
    __syncthreads(); sc_gt[t] = gtc; sc_eq[t] = eqc; __syncthreads();
    for (int o = 1; o < 1024; o <<= 1) { const int a = t >= o ? sc_gt[t - o] : 0, b = t >= o ? sc_eq[t - o] : 0; __syncthreads(); sc_gt[t] += a; sc_eq[t] += b; __syncthreads(); }
    const int tot_gt = sc_gt[1023]; const int need = cap - tot_gt;
    int gt_before = sc_gt[t] - gtc, eq_before = sc_eq[t] - eqc;
    if (act) for (int i = 0; i < per; ++i) {
        const int tok = base + t * per + i; int slot = -1;
        if (v[i] > T) { slot = gt_before + (eq_before < need ? eq_before : need); ++gt_before; }
        else if (v[i] == T) { if (eq_before < need) slot = gt_before + eq_before; ++eq_before; }
        if (slot >= 0) { idx[e * SLOTS + sbase + slot] = tok; gate[e * SLOTS + sbase + slot] = __uint_as_float(v[i]); }
        inv[(size_t)tok * 16 + e] = slot >= 0 ? sbase + slot : -1;
    }
}
__global__ void k_silu_mul(const bf16_t* __restrict__ raw, bf16_t* __restrict__ hid, size_t total) {
    const size_t gid = (size_t)blockIdx.x * blockDim.x + threadIdx.x; if (gid >= total) return;
    const size_t r = gid / FF; const int f = (int)(gid % FF); const bf16_t* p = raw + r * 2048 + 256 * (f / 128) + (f % 128);
    const float a = bf2f(p[0]), b = bf2f(p[128]); hid[gid] = f2bf(a / (1.f + __expf(-a)) * b);
}
__global__ void k_combine(float* __restrict__ xl, float* __restrict__ xc, const bf16_t* __restrict__ YE, const int* __restrict__ inv, const float* __restrict__ mod, int nrows,
                          int final_mode, const float* __restrict__ gn, const float* __restrict__ modn, bf16_t* __restrict__ H, float* __restrict__ out) {
    const int row = blockIdx.x * 4 + (threadIdx.x >> 6), lane = threadIdx.x & 63; if (row >= nrows) return;
    float* x = row < L ? xl + (size_t)row * D : xc + (size_t)(row - L) * D; const float* m = mod + (row < L ? 0 : 6144);
    float v[16];
#pragma unroll
    for (int j = 0; j < 4; ++j) { const float4 t = *(const float4*)(x + j * 256 + lane * 4); v[4 * j] = t.x; v[4 * j + 1] = t.y; v[4 * j + 2] = t.z; v[4 * j + 3] = t.w; }
    float a[16];
#pragma unroll
    for (int i = 0; i < 16; ++i) a[i] = 0.f;
    for (int e = 0; e < 16; ++e) { const int s = inv[(size_t)row * 16 + e]; if (s < 0) continue; const bf16_t* y = YE + ((size_t)e * SLOTS + s) * D;
#pragma unroll
        for (int j = 0; j < 4; ++j) { const uint2 u = *(const uint2*)(y + j * 256 + lane * 4); a[4 * j] += __uint_as_float(u.x << 16); a[4 * j + 1] += __uint_as_float(u.x & 0xffff0000u); a[4 * j + 2] += __uint_as_float(u.y << 16); a[4 * j + 3] += __uint_as_float(u.y & 0xffff0000u); } }
    float s = 0.f;
#pragma unroll
    for (int j = 0; j < 4; ++j)
#pragma unroll
        for (int i = 0; i < 4; ++i) { const int d = j * 256 + lane * 4 + i; v[4 * j + i] += m[5120 + d] * a[4 * j + i]; s += v[4 * j + i] * v[4 * j + i]; }
    const float rs = rsqrtf(wave_sum(s) * (1.f / D) + EPS);
    if (final_mode) {
#pragma unroll
        for (int j = 0; j < 4; ++j) { float4 o; const int d = j * 256 + lane * 4; o.x = v[4 * j] * rs * gn[d]; o.y = v[4 * j + 1] * rs * gn[d + 1]; o.z = v[4 * j + 2] * rs * gn[d + 2]; o.w = v[4 * j + 3] * rs * gn[d + 3]; *(float4*)(out + (size_t)row * D + d) = o; }
    } else {
        const float* mn = modn + (row < L ? 0 : 6144);
#pragma unroll
        for (int j = 0; j < 4; ++j) { const int d = j * 256 + lane * 4; *(float4*)(x + d) = make_float4(v[4 * j], v[4 * j + 1], v[4 * j + 2], v[4 * j + 3]);
#pragma unroll
            for (int i = 0; i < 4; ++i) H[(size_t)row * D + d + i] = f2bf(v[4 * j + i] * rs * gn[d + i] * (1.f + mn[1024 + d + i]) + mn[d + i]); }
    }
}

extern "C" void kernel_launch(void* const* d_in, const int* in_sizes, int n_in, void* d_out, int out_size, void* d_ws, size_t ws_size, hipStream_t stream) {
    if (ws_size < WS_END) { fprintf(stderr, "kernel_launch: workspace too small: %zu < %zu\n", ws_size, (size_t)WS_END); return; }
    const float* x = (const float*)d_in[0]; const float* c = (const float*)d_in[1]; const float* ctx = (const float*)d_in[2]; const float* cctx = (const float*)d_in[3];
    const float* w_ada = (const float*)d_in[4]; const float* b_ada = (const float*)d_in[5]; const float* g1 = (const float*)d_in[6]; const float* g2 = (const float*)d_in[7];
    const float* w_in = (const float*)d_in[8]; const float* rpb = (const float*)d_in[9];
    const float* subg = (const float*)d_in[14]; const float* ln_g = (const float*)d_in[15]; const float* ln_b = (const float*)d_in[16]; const float* w_s = (const float*)d_in[17]; const float* b_s = (const float*)d_in[18];
    const float* w_br = (const float*)d_in[19]; const float* w_out = (const float*)d_in[20]; const float* w_r = (const float*)d_in[21];
    const float* w_e1 = (const float*)d_in[22]; const float* w_e3 = (const float*)d_in[23]; const float* w_e2 = (const float*)d_in[24]; const float* g_final = (const float*)d_in[25];
    char* ws = (char*)d_ws; float* out = (float*)d_out;
    float* MOD = (float*)(ws + OFF_MOD); float* ROPE = (float*)(ws + OFF_ROPE); float* LAM = (float*)(ws + OFF_LAM); float* GST = (float*)(ws + OFF_GST);
    float* AFF = (float*)(ws + OFF_AFF); int* INV = (int*)(ws + OFF_INV); int* IDX = (int*)(ws + OFF_IDX); float* GATE = (float*)(ws + OFF_GATE);
    float* XC = (float*)(ws + WS_XC);
    bf16_t* WIN = (bf16_t*)(ws + WS_WIN); bf16_t* WBR = (bf16_t*)(ws + WS_WBR); bf16_t* WOUT = (bf16_t*)(ws + WS_WOUT); bf16_t* W13 = (bf16_t*)(ws + WS_W13); bf16_t* W2 = (bf16_t*)(ws + WS_W2);
    bf16_t* H = (bf16_t*)(ws + WS_H); bf16_t* Y = (bf16_t*)(ws + WS_Y); bf16_t* Z = (bf16_t*)(ws + WS_Z);
    bf16_t* MB = H; bf16_t* H2 = Y; bf16_t* HIDRAW = (bf16_t*)(ws + WS_Z + ZO_HIDRAW); bf16_t* HID = (bf16_t*)(ws + WS_Z + ZO_HID); bf16_t* YE = (bf16_t*)(ws + WS_Z + ZO_YE);

    const dim3 tb(32, 8);
    k_wt<<<dim3(PROJ / 32, D / 32, 2), tb, 0, stream>>>(w_in, WIN, D, PROJ, 0, (size_t)D * PROJ, (size_t)PROJ * D);
    k_wt<<<dim3(D / 32, 512 / 32, 6), tb, 0, stream>>>(w_br, WBR, 512, D, 0, (size_t)512 * D, (size_t)D * 512);
    k_wt<<<dim3(D / 32, D / 32, 2), tb, 0, stream>>>(w_out, WOUT, D, D, 0, (size_t)D * D, (size_t)D * D);
    k_wt<<<dim3(FF / 32, D / 32, 32), tb, 0, stream>>>(w_e1, W13, D, FF, 1, (size_t)D * FF, (size_t)2048 * D);
    k_wt<<<dim3(FF / 32, D / 32, 32), tb, 0, stream>>>(w_e3, W13, D, FF, 2, (size_t)D * FF, (size_t)2048 * D);
    k_wt<<<dim3(D / 32, FF / 32, 32), tb, 0, stream>>>(w_e2, W2, FF, D, 0, (size_t)FF * D, (size_t)D * FF);
    k_mod<<<(2 * 6144 + 255) / 256, 256, 0, stream>>>(c, cctx, w_ada, b_ada, MOD);
    k_misc<<<(320 * 16 + 255) / 256, 256, 0, stream>>>(ROPE, LAM, (const float*)d_in[10], (const float*)d_in[11], (const float*)d_in[12], (const float*)d_in[13]);
    k_h1<<<R / 4, 256, 0, stream>>>(x, ctx, g1, MOD, 0, 1024, H, R);

    for (int l = 0; l < 2; ++l) {
        const bool last = (l == 1); const int NR = last ? L : R;
        const float* mod = MOD + (size_t)l * 2 * 6144;
        const float* xl_old = l == 0 ? x : out; const float* xc_old = l == 0 ? ctx : XC;
        k_gemm<EStore><<<dim3(PROJ / 64, R / 64, 1), 256, 0, stream>>>(H, D, 0, nullptr, 0, WIN + (size_t)l * PROJ * D, 0, D, EStore{Z, (size_t)PROJ, 0});
        k_zfix<<<(unsigned)(((size_t)R * PROJ + 255) / 256), 256, 0, stream>>>(Z, ROPE, R);
        k_na<<<dim3(NR / 64, 2), 256, 0, stream>>>(Z, rpb + (size_t)l * 8 * 15 * 31, Y, 0);
        const float li = 0.8f - 0.6f * expf(-0.3f * (float)l);
        k_da<<<dim3(L / 64, 4), 256, 4 * 64 * 64 * 4, stream>>>(Z, LAM + l, subg + l * 128, 1.f - li, Y, 0, 0, R);
        if (!last) k_da<<<dim3(C / 64, 4), 256, 4 * 64 * 64 * 4, stream>>>(Z, LAM + l, subg + l * 128, 1.f - li, Y, L, L, R);
        k_gm_stats<<<NR / 4, 256, 0, stream>>>(Z, GST, NR);
        k_gm_mix<<<(unsigned)(((size_t)NR * 512 + 255) / 256), 256, 0, stream>>>(Z, GST, ln_g + l * 512, ln_b + l * 512, w_s + (size_t)l * 4 * 128 * 128, b_s + l * 512, Y, NR);
        for (int j = 0; j < 3; ++j)
            k_gemm<EMerge><<<dim3(D / 64, NR / 64, 1), 256, 0, stream>>>(Y + j * 512, 1536, 0, nullptr, 0, WBR + ((size_t)l * 3 + j) * D * 512, 0, 512, EMerge{MB, Z, j});
        k_gemm<EResid><<<dim3(D / 64, NR / 64, 1), 256, 0, stream>>>(MB, D, 0, nullptr, 0, WOUT + (size_t)l * D * D, 0, D, EResid{xl_old, xc_old, out, XC, mod, 2048});
        k_h2<<<NR / 4, 256, 0, stream>>>(out, XC, g2 + l * D, mod, w_r + (size_t)l * D * 16, H2, AFF, NR);
        k_select<<<dim3(16, 2), 1024, 0, stream>>>(AFF, IDX, GATE, INV, last ? 0 : 1);
        const int MS = last ? CAPL : SLOTS;
        k_gemm<EStore><<<dim3(2048 / 64, MS / 64, 16), 256, 0, stream>>>(H2, D, 0, IDX, SLOTS, W13 + (size_t)l * 16 * 2048 * D, (size_t)2048 * D, D, EStore{HIDRAW, (size_t)2048, (size_t)SLOTS * 2048});
        k_silu_mul<<<(unsigned)(((size_t)16 * SLOTS * FF + 255) / 256), 256, 0, stream>>>(HIDRAW, HID, (size_t)16 * SLOTS * FF);
        k_gemm<EYe><<<dim3(D / 64, MS / 64, 16), 256, 0, stream>>>(HID, FF, (size_t)SLOTS * FF, nullptr, 0, W2 + (size_t)l * 16 * D * FF, (size_t)D * FF, FF, EYe{YE, GATE});
        k_combine<<<NR / 4, 256, 0, stream>>>(out, XC, YE, INV, mod, NR, last ? 1 : 0, last ? g_final : g1 + D, MOD + (size_t)2 * 6144, H, out);
    }
}
```

```cpp
#include <hip/hip_runtime.h>
#include <cstdint>
#include <cstdio>

typedef unsigned short bf16_t;
__device__ __forceinline__ float bf2f(bf16_t b) { return __uint_as_float(((unsigned)b) << 16); }
__device__ __forceinline__ bf16_t f2bf(float f) { unsigned u = __float_as_uint(f); return (bf16_t)((u + 0x7fffu + ((u >> 16) & 1u)) >> 16); }
__device__ __forceinline__ unsigned pk2(float lo, float hi) { return (unsigned)f2bf(lo) | ((unsigned)f2bf(hi) << 16); }

constexpr int D = 1024, L = 16384, C = 256, R = L + C, PROJ = 7168, NE = 16, FF = 1024;
constexpr int CAPL = 2048, CAPC = 32, SLOTS = 2304;
constexpr float EPS = 1e-6f;
constexpr float C2 = 0.125f * 1.4426950408889634f;
constexpr int PROJZ = 5632;
constexpr int ZKA = 0, ZVA = 512, ZQA = 1024, ZU = 1536, ZV = 2048, ZG = 2560;
constexpr size_t HB = (size_t)R * 128;
constexpr size_t YP = (size_t)R * 512;

constexpr size_t MiB = 1u << 20;
constexpr size_t WS_CTL = 0, CTL_ZERO_BYTES = 1 * MiB;
constexpr size_t OFF_MOD = 1 * MiB;
constexpr size_t OFF_ROPE = 1 * MiB + 256 * 1024;
constexpr size_t OFF_LAM = 1 * MiB + 320 * 1024;
constexpr size_t OFF_GST = 1 * MiB + 384 * 1024;
constexpr size_t OFF_AFF = 2 * MiB;
constexpr size_t OFF_INV = 3 * MiB + 256 * 1024;
constexpr size_t OFF_IDX = 4 * MiB + 512 * 1024;
constexpr size_t OFF_GATE = 4 * MiB + 768 * 1024;
constexpr size_t WS_XC = 5 * MiB;
constexpr size_t WS_WIN = 6 * MiB;
constexpr size_t WS_WBR = 34 * MiB;
constexpr size_t WS_WOUT = 40 * MiB;
constexpr size_t WS_W13 = 44 * MiB;
constexpr size_t WS_W2 = 172 * MiB;
constexpr size_t WS_H = 236 * MiB;
constexpr size_t WS_Y = 269 * MiB;
constexpr size_t WS_Z = 318 * MiB;
constexpr size_t QKV_STRIDE = 33 * MiB / 2;
constexpr size_t WS_QB = 497 * MiB, WS_KB = WS_QB + QKV_STRIDE, WS_VB = WS_QB + 2 * QKV_STRIDE;
constexpr size_t WS_END = 546 * MiB;
constexpr size_t ZO_HID = 72 * MiB;
constexpr size_t ZO_YE = 0;

__device__ __forceinline__ float gelu_tanh(float x) { const float y = 1.5957691216057308f * (x + 0.044715f * x * x * x); return x / (1.f + __expf(-y)); }
__device__ __forceinline__ float sigmoidf_(float x) { return 1.f / (1.f + __expf(-x)); }
__device__ __forceinline__ float siluf_(float x) { return x / (1.f + __expf(-x)); }
__device__ __forceinline__ float wave_sum(float v) {
#pragma unroll
    for (int o = 1; o < 64; o <<= 1) v += __shfl_xor(v, o);
    return v;
}

enum { K_P0 = 0, K_H1 = 1, K_G1 = 2, K_MIX = 3, K_M1 = 4, K_M2 = 5, K_R = 6, K_S = 7, K_E1 = 8, K_E2 = 9, K_CB = 10 };

namespace pg8 {
#define PG8_LAS __attribute__((address_space(3)))
typedef unsigned short bf16_t;
typedef short bf16x8 __attribute__((ext_vector_type(8)));
typedef float f32x4 __attribute__((ext_vector_type(4)));
typedef unsigned u32x4 __attribute__((ext_vector_type(4)));
constexpr int BM = 256, BK = 64, HALF = 128, HTB = HALF * BK * 2  , STAGE_BYTES = 8 * HTB, NXCD = 8, WGM = 8;

__host__ __device__ __forceinline__ int lds_byte(int r, int c) { const int st = (r >> 4) * 2 + (c >> 5), rr = r & 15, cc = c & 31, ob = rr * 64 + cc * 2; return st * 1024 + (ob ^ (((ob >> 9) & 1) << 5)); }
__host__ __device__ __forceinline__ void stage_rc(int b, int& R, int& C) { const int st = b / 1024, sb = b % 1024, swz = sb ^ (((sb >> 9) & 1) << 5); R = (st >> 1) * 16 + swz / 64; C = (st & 1) * 32 + (swz % 64) / 2; }
__host__ __device__ __forceinline__ int perm32(int rho) { const int n = rho >> 4, i = rho & 15; return 8 * (i >> 2) + 4 * n + (i & 3); }

struct Unit { int pm, pn; };
struct Gemm { const bf16_t* A; const bf16_t* Bt; int M, N, K; };

struct StaticOrder {
    int nM, nN, nwg, G, c;
    __host__ __device__ void init(int M, int N, int G_, int c_) { nM = M / BM; nN = N / BM; nwg = nM * nN; G = G_; c = c_; }
    __host__ __device__ bool next(int i, Unit& u) const {
        const long L = (long)i * G + c; if (L >= nwg) return false;
        int wgid = (int)L; { const int q = nwg / NXCD, r = nwg % NXCD, xcd = wgid % NXCD, off = wgid / NXCD; wgid = (xcd < r ? xcd * (q + 1) : r * (q + 1) + (xcd - r) * q) + off; }
        const int nig = WGM * nN, gid = wgid / nig, fm = gid * WGM, gsz = (nM - fm) < WGM ? (nM - fm) : WGM;
        u.pm = fm + ((wgid % nig) % gsz); u.pn = (wgid % nig) / gsz; return true;
    }
    __device__ __forceinline__ void a_ready(const Unit&) const {}
    __device__ __forceinline__ void done(const Unit&) const {}
};

__device__ __forceinline__ unsigned cvt_pk_bf16(float lo, float hi) { unsigned r; asm volatile("v_cvt_pk_bf16_f32 %0, %1, %2" : "=v"(r) : "v"(lo), "v"(hi)); return r; }
typedef float f32x2 __attribute__((ext_vector_type(2)));
template <class Epi, class Sched>
__device__ __forceinline__ void gemm_phase(PG8_LAS unsigned char* lds, const Gemm g, const Sched& S, const Epi& E, const bool PERM, const bool GATHER, const int tid_in) {
    constexpr bool ALIGN_EPI = true, SP2 = true;
    int tid_ = tid_in; asm volatile("" : "+v"(tid_));
    const int tid = tid_, wid = __builtin_amdgcn_readfirstlane(tid >> 6), lane = tid & 63, wr = wid >> 2, wc = wid & 3, fr = lane & 15, fq = lane >> 4;
    const int K = g.K, nt = K / BK;
    unsigned voffA[2], voffB[2];
#pragma unroll
    for (int i = 0; i < 2; ++i) { int R, C; stage_rc(tid * 16 + i * 8192, R, C); const int Rb = PERM ? ((R & ~31) + perm32(R & 31)) : R;
        voffA[i] = (unsigned)(R * K + C) * 2u; voffB[i] = (unsigned)(Rb * K + C) * 2u; }
    unsigned vc0[2], vc1[2], vn0[2], vn1[2];
#pragma unroll
    for (int i = 0; i < 2; ++i) { vc0[i] = vc1[i] = vn0[i] = vn1[i] = voffA[i]; }
#define PG8_GLOAD(dst0, dst1, u) do { if (GATHER) { const int* gi_ = S.rows(u); int t_ = tid; asm volatile("" : "+v"(t_)); _Pragma("unroll") for (int i = 0; i < 2; ++i) { int R_, C_; stage_rc(t_ * 16 + i * 8192, R_, C_); \
        dst0[i] = (unsigned)gi_[R_] * (unsigned)(K * 2) + (unsigned)(C_ * 2); dst1[i] = (unsigned)gi_[R_ + HALF] * (unsigned)(K * 2) + (unsigned)(C_ * 2); } } } while (0)
    const size_t kstep = (size_t)(BK * 2);
    const size_t hstep = (size_t)HALF * K * 2;
    const size_t tstep = 2 * hstep; const size_t hstepA = GATHER ? 0 : hstep, tstepA = GATHER ? 0 : tstep;
    const unsigned ldsw = (unsigned)wid * 1024u;
    const int aoff = lds_byte(wr * 64 + fr, fq * 8), boff = lds_byte(wc * 32 + fr, fq * 8);
#define PG8_SA(b, h) (((b) * 2 + (h)) * HTB)
#define PG8_SB(b, h) ((4 + (b) * 2 + (h)) * HTB)
#define PG8_STAGE(bufoff, gbase, voff) do { _Pragma("unroll") for (int _i = 0; _i < 2; ++_i) \
        __builtin_amdgcn_global_load_lds((const unsigned*)((const char*)(gbase) + (voff)[_i]), (PG8_LAS unsigned*)(lds + (bufoff) + ldsw + _i * 8192), 16, 0, 0); } while (0)
#define PG8_LDA(dst, b, h) do { _Pragma("unroll") for (int m = 0; m < 4; ++m) _Pragma("unroll") for (int k = 0; k < 2; ++k) dst[m][k] = *(const PG8_LAS bf16x8*)(lds + PG8_SA(b, h) + aoff + m * 2048 + k * 1024); } while (0)
#define PG8_LDB(dst, b, h) do { _Pragma("unroll") for (int n = 0; n < 2; ++n) _Pragma("unroll") for (int k = 0; k < 2; ++k) dst[n][k] = *(const PG8_LAS bf16x8*)(lds + PG8_SB(b, h) + boff + n * 2048 + k * 1024); } while (0)
#define PG8_MMA(ai, bj, At, Bt) do { __builtin_amdgcn_s_setprio(1); _Pragma("unroll") for (int m = 0; m < 4; ++m) _Pragma("unroll") for (int n = 0; n < 2; ++n) _Pragma("unroll") for (int k = 0; k < 2; ++k) \
        acc[ai][bj][m][n] = __builtin_amdgcn_mfma_f32_16x16x32_bf16(Bt[n][k], At[m][k], acc[ai][bj][m][n], 0, 0, 0); __builtin_amdgcn_s_setprio(0); } while (0)
#define PG8_WAIT_V(n) asm volatile("s_waitcnt vmcnt(" #n ")" ::: "memory")
#define PG8_WAIT_L(n) asm volatile("s_waitcnt lgkmcnt(" #n ")" ::: "memory")
#define PG8_BAR __builtin_amdgcn_s_barrier()
#define PG8_SCHED __builtin_amdgcn_sched_barrier(0)
    Unit cur, nxt; int ui = 0;
    if (!S.next(0, cur)) return;
    f32x4 acc[2][2][4][2];
#pragma unroll
    for (int a = 0; a < 2; ++a)
#pragma unroll
        for (int b = 0; b < 2; ++b)
#pragma unroll
            for (int m = 0; m < 4; ++m)
#pragma unroll
                for (int n = 0; n < 2; ++n) acc[a][b][m][n] = (f32x4){0.f, 0.f, 0.f, 0.f};
    bf16x8 At[4][2], B0[2][2], B1[2][2];
    const char* cA = (const char*)g.A + (size_t)cur.pm * tstepA; const char* cB = (const char*)g.Bt + (size_t)cur.pn * tstep;
    S.a_ready(cur); PG8_GLOAD(vc0, vc1, cur);
    if constexpr (SP2) {
        PG8_STAGE(PG8_SB(0, 0), cB, voffB); PG8_STAGE(PG8_SB(0, 1), cB + hstep, voffB); PG8_STAGE(PG8_SA(0, 0), cA, vc0); PG8_STAGE(PG8_SA(0, 1), cA + hstepA, vc1);
        if (wr == 1) PG8_BAR;
        PG8_WAIT_V(2); PG8_BAR;
        PG8_STAGE(PG8_SB(1, 0), cB + kstep, voffB); PG8_STAGE(PG8_SA(1, 0), cA + kstep, vc0); PG8_STAGE(PG8_SB(1, 1), cB + hstep + kstep, voffB);
        PG8_WAIT_V(6); PG8_BAR;
    }
    for (;;) {
        const bool has_next = S.next(ui + 1, nxt);
        const char* nA = has_next ? (const char*)g.A + (size_t)nxt.pm * tstepA : cA; const char* nB = has_next ? (const char*)g.Bt + (size_t)nxt.pn * tstep : cB;
        if (GATHER) { if (has_next) PG8_GLOAD(vn0, vn1, nxt); else { _Pragma("unroll") for (int i = 0; i < 2; ++i) { vn0[i] = vc0[i]; vn1[i] = vc1[i]; } } }
        for (int t = 0; t < nt; t += 2) {
            const bool last = (t == nt - 2);
            unsigned m0[2], m1[2];
#pragma unroll
            for (int i = 0; i < 2; ++i) { m0[i] = (GATHER && last) ? vn0[i] : vc0[i]; m1[i] = (GATHER && last) ? vn1[i] : vc1[i]; }
            const char* a1 = cA + (size_t)(t + 1) * kstep;
            const char* a2 = last ? nA : cA + (size_t)(t + 2) * kstep; const char* b2 = last ? nB : cB + (size_t)(t + 2) * kstep;
            const char* a3 = a2 + kstep; const char* b3 = b2 + kstep;
            if (last && has_next) S.a_ready(nxt);
            if constexpr (SP2) {
            PG8_LDB(B0, 0, 0); PG8_LDB(B1, 0, 1); PG8_SCHED; PG8_LDA(At, 0, 0); PG8_STAGE(PG8_SA(1, 1), a1 + hstepA, vc1);
            PG8_WAIT_V(8); PG8_WAIT_L(0); PG8_BAR; PG8_MMA(0, 0, At, B0); PG8_MMA(0, 1, At, B1); PG8_BAR; PG8_SCHED;
            PG8_LDA(At, 0, 1); PG8_STAGE(PG8_SB(0, 0), b2, voffB); PG8_STAGE(PG8_SB(0, 1), b2 + hstep, voffB); PG8_STAGE(PG8_SA(0, 0), a2, m0);
            PG8_WAIT_V(8); PG8_WAIT_L(0); PG8_BAR; PG8_MMA(1, 0, At, B0); PG8_MMA(1, 1, At, B1); PG8_BAR; PG8_SCHED;
            PG8_LDB(B0, 1, 0); PG8_LDB(B1, 1, 1); PG8_SCHED; PG8_LDA(At, 1, 0); PG8_STAGE(PG8_SA(0, 1), a2 + hstepA, m1);
            PG8_WAIT_V(8); PG8_WAIT_L(0); PG8_BAR; PG8_MMA(0, 0, At, B0); PG8_MMA(0, 1, At, B1); PG8_BAR; PG8_SCHED;
            PG8_LDA(At, 1, 1); PG8_STAGE(PG8_SB(1, 0), b3, voffB); PG8_STAGE(PG8_SB(1, 1), b3 + hstep, voffB); PG8_STAGE(PG8_SA(1, 0), a3, m0);
            PG8_WAIT_V(8); PG8_WAIT_L(0); PG8_BAR; PG8_MMA(1, 0, At, B0); PG8_MMA(1, 1, At, B1); PG8_BAR; PG8_SCHED;
            } else { static_assert(SP2, "only the SP2 loop is kept"); }
        }
        if constexpr (ALIGN_EPI) { if (wr == 0) PG8_BAR; }
        if constexpr (!Epi::AFTER_DRAIN) { E(acc, cur, wr, wc, fr, fq); S.done(cur); }
        if (!has_next) break;
#pragma unroll
        for (int a = 0; a < 2; ++a)
#pragma unroll
            for (int b = 0; b < 2; ++b)
#pragma unroll
                for (int m = 0; m < 4; ++m)
#pragma unroll
                    for (int n = 0; n < 2; ++n) acc[a][b][m][n] = (f32x4){0.f, 0.f, 0.f, 0.f};
        cur = nxt; cA = nA; cB = nB; ++ui;
#pragma unroll
        for (int i = 0; i < 2; ++i) { vc0[i] = vn0[i]; vc1[i] = vn1[i]; }
        if constexpr (ALIGN_EPI) { if (wr == 1) PG8_BAR; }
    }
    PG8_WAIT_V(0);
    if constexpr (!ALIGN_EPI) { if (wr == 0) PG8_BAR; }
    PG8_BAR;
    if constexpr (Epi::AFTER_DRAIN) { E.fused(acc, cur, wr, wc, fr, fq, lds, wid, lane); S.done(cur); }
#undef PG8_GLOAD
#undef PG8_SA
#undef PG8_SB
#undef PG8_STAGE
#undef PG8_LDA
#undef PG8_LDB
#undef PG8_MMA
#undef PG8_WAIT_V
#undef PG8_WAIT_L
#undef PG8_BAR
#undef PG8_SCHED
}
}

typedef pg8::f32x4 f32x4; typedef pg8::u32x4 u32x4; typedef pg8::Unit Unit;
typedef float f32x16 __attribute__((ext_vector_type(16)));
typedef short bf16x8 __attribute__((ext_vector_type(8)));
typedef unsigned u32x2 __attribute__((ext_vector_type(2)));

struct EpiZ { static constexpr bool PERM = true, AFTER_DRAIN = false;
    bf16_t* Z; const float* rope; unsigned char* qkv;
    __device__ __forceinline__ void operator()(const f32x4 (&acc)[2][2][4][2], const Unit& u, int wr, int wc, int fr, int fq) const {
        const int row0 = u.pm * 256 + wr * 64 + fr, col0 = u.pn * 256 + wc * 32 + 8 * fq, pn = u.pn;
        const int type = (pn == 4 || pn == 5) ? 1 : (pn == 10 || pn == 11) ? 2 : (pn >= 12 && pn < 16) ? 3 : (pn >= 16) ? 4 : 0;
        const int colhalf = wc & 1; const float* rc = rope + (colhalf ? 8192 : 0) + 8 * (fq & 1); const float* rs = rc + (colhalf ? 1024 : 4096);
#pragma unroll
        for (int ai = 0; ai < 2; ++ai)
#pragma unroll
            for (int m = 0; m < 4; ++m) { const int row = row0 + ai * 128 + m * 16;
                const int cq = (pn & 1) * 256 + wc * 32 + 8 * fq;
                bf16_t* rowp; size_t bjstep = 128;
                if (type == 1 || type == 2 || pn == 6 || pn == 7) { const int sel = type == 2 ? 0 : type == 1 ? 1 : 2; bf16_t* hb = (bf16_t*)(qkv + (size_t)sel * QKV_STRIDE); rowp = hb + (size_t)(cq >> 7) * HB + (size_t)row * 128 + (cq & 127); bjstep = HB; }
                else { const int zc = pn < 4 ? pn * 256 : pn < 10 ? ZQA + (pn - 8) * 256 : pn < 16 ? ZU + (pn - 12) * 256 : ZG + (pn - 16) * 256; rowp = Z + (size_t)row * PROJZ + zc + wc * 32 + 8 * fq; }
                float cs[8], sn[8];
                if (type == 1 || type == 2) { const int pos = colhalf ? (row & 63) : (row >> 6);
                    const f32x4 c0 = *(const f32x4*)(rc + pos * 16), c1 = *(const f32x4*)(rc + pos * 16 + 4), s0 = *(const f32x4*)(rs + pos * 16), s1 = *(const f32x4*)(rs + pos * 16 + 4);
#pragma unroll
                    for (int e = 0; e < 4; ++e) { cs[e] = c0[e]; cs[4 + e] = c1[e]; sn[e] = fq < 2 ? -s0[e] : s0[e]; sn[4 + e] = fq < 2 ? -s1[e] : s1[e]; } }
#pragma unroll
                for (int bj = 0; bj < 2; ++bj) { float v[8];
#pragma unroll
                    for (int e = 0; e < 4; ++e) { v[e] = acc[ai][bj][m][0][e]; v[4 + e] = acc[ai][bj][m][1][e]; }
                    if (type == 1 || type == 2) { const float sc = type == 2 ? C2 : 1.f;
#pragma unroll
                        for (int e = 0; e < 8; ++e) { const float p = __shfl_xor(v[e], 32); v[e] = (v[e] * cs[e] + p * sn[e]) * sc; } }
                    else if (type == 3) {
#pragma unroll
                        for (int e = 0; e < 8; ++e) v[e] = gelu_tanh(v[e]); }
                    else if (type == 4) {
#pragma unroll
                        for (int e = 0; e < 8; ++e) v[e] = sigmoidf_(v[e]); }
                    u32x4 w; w.x = pk2(v[0], v[1]); w.y = pk2(v[2], v[3]); w.z = pk2(v[4], v[5]); w.w = pk2(v[6], v[7]);
                    *(u32x4*)(rowp + bj * bjstep) = w; } }
    }
};
__device__ __forceinline__ void unpack8(const u32x4 w, float (&f)[8]) {
    f[0] = __uint_as_float(w.x << 16); f[1] = __uint_as_float(w.x & 0xffff0000u); f[2] = __uint_as_float(w.y << 16); f[3] = __uint_as_float(w.y & 0xffff0000u);
    f[4] = __uint_as_float(w.z << 16); f[5] = __uint_as_float(w.z & 0xffff0000u); f[6] = __uint_as_float(w.w << 16); f[7] = __uint_as_float(w.w & 0xffff0000u);
}
struct EpiMerge { static constexpr bool PERM = true, AFTER_DRAIN = false;
    bf16_t* Mb; const bf16_t* Z;
    __device__ __forceinline__ void operator()(const f32x4 (&acc)[2][2][4][2], const Unit& u, int wr, int wc, int fr, int fq) const {
        const int j = u.pn >> 2, pm = u.pm - 65 * j, pn = u.pn & 3;
        const int row0 = pm * 256 + wr * 64 + fr, col0 = pn * 256 + wc * 32 + 8 * fq;
#pragma unroll
        for (int ai = 0; ai < 2; ++ai)
#pragma unroll
            for (int m = 0; m < 4; ++m) { const int row = row0 + ai * 128 + m * 16;
#pragma unroll
                for (int bj = 0; bj < 2; ++bj) { const int col = col0 + bj * 128; bf16_t* mp = Mb + (size_t)row * D + col;
                    float g[8], p[8]; unpack8(*(const u32x4*)(Z + (size_t)row * PROJZ + ZG + j * 1024 + col), g);
                    if (j > 0) unpack8(*(const u32x4*)mp, p); else {
#pragma unroll
                        for (int e = 0; e < 8; ++e) p[e] = 0.f; }
                    float v[8];
#pragma unroll
                    for (int e = 0; e < 4; ++e) { v[e] = p[e] + g[e] * acc[ai][bj][m][0][e]; v[4 + e] = p[4 + e] + g[4 + e] * acc[ai][bj][m][1][e]; }
                    u32x4 w; w.x = pk2(v[0], v[1]); w.y = pk2(v[2], v[3]); w.z = pk2(v[4], v[5]); w.w = pk2(v[6], v[7]);
                    *(u32x4*)mp = w; } }
    }
};
struct EpiResid { static constexpr bool PERM = false, AFTER_DRAIN = false;
    const float* xold; float* xnew; const float* gt;
    __device__ __forceinline__ void operator()(const f32x4 (&acc)[2][2][4][2], const Unit& u, int wr, int wc, int fr, int fq) const {
        const int row0 = u.pm * 256 + wr * 64 + fr, col0 = u.pn * 256 + wc * 32 + 4 * fq;
        f32x4 gv[2][2];
#pragma unroll
        for (int bj = 0; bj < 2; ++bj)
#pragma unroll
            for (int n = 0; n < 2; ++n) gv[bj][n] = *(const f32x4*)(gt + col0 + bj * 128 + n * 16);
#pragma unroll
        for (int ai = 0; ai < 2; ++ai)
#pragma unroll
            for (int m = 0; m < 4; ++m) { const size_t off = (size_t)(row0 + ai * 128 + m * 16) * D + col0;
#pragma unroll
                for (int bj = 0; bj < 2; ++bj)
#pragma unroll
                    for (int n = 0; n < 2; ++n) { const f32x4 xo = *(const f32x4*)(xold + off + bj * 128 + n * 16); *(f32x4*)(xnew + off + bj * 128 + n * 16) = xo + gv[bj][n] * acc[ai][bj][m][n]; } }
    }
};
struct EpiHid { static constexpr bool PERM = true, AFTER_DRAIN = false;
    bf16_t* HID;
    __device__ __forceinline__ void operator()(const f32x4 (&acc)[2][2][4][2], const Unit& u, int wr, int wc, int fr, int fq) const {
        const int row0 = u.pm * 256 + wr * 64 + fr, col0 = (u.pn & 7) * 128 + wc * 32 + 8 * fq;
#pragma unroll
        for (int ai = 0; ai < 2; ++ai)
#pragma unroll
            for (int m = 0; m < 4; ++m) { float v[8];
#pragma unroll
                for (int e = 0; e < 4; ++e) { v[e] = siluf_(acc[ai][0][m][0][e]) * acc[ai][1][m][0][e]; v[4 + e] = siluf_(acc[ai][0][m][1][e]) * acc[ai][1][m][1][e]; }
                u32x4 w; w.x = pk2(v[0], v[1]); w.y = pk2(v[2], v[3]); w.z = pk2(v[4], v[5]); w.w = pk2(v[6], v[7]);
                *(u32x4*)(HID + (size_t)(row0 + ai * 128 + m * 16) * FF + col0) = w; }
    }
};
struct EpiYe { static constexpr bool PERM = true, AFTER_DRAIN = false;
    bf16_t* YE; const float* gate;
    __device__ __forceinline__ void operator()(const f32x4 (&acc)[2][2][4][2], const Unit& u, int wr, int wc, int fr, int fq) const {
        const int row0 = u.pm * 256 + wr * 64 + fr, col0 = (u.pn & 3) * 256 + wc * 32 + 8 * fq;
#pragma unroll
        for (int ai = 0; ai < 2; ++ai)
#pragma unroll
            for (int m = 0; m < 4; ++m) { const int row = row0 + ai * 128 + m * 16; const float gsc = gate[row];
#pragma unroll
                for (int bj = 0; bj < 2; ++bj) { const f32x4 a = acc[ai][bj][m][0] * gsc, b = acc[ai][bj][m][1] * gsc;
                    u32x4 w; w.x = pk2(a[0], a[1]); w.y = pk2(a[2], a[3]); w.z = pk2(b[0], b[1]); w.w = pk2(b[2], b[3]);
                    *(u32x4*)(YE + (size_t)row * D + col0 + bj * 128) = w; } }
    }
};
struct UEpi { static constexpr bool AFTER_DRAIN = false; int kind, l; unsigned char* ws; float* out; const float* xold;
    __device__ __forceinline__ void operator()(const f32x4 (&acc)[2][2][4][2], const Unit& u, int wr, int wc, int fr, int fq) const {
        asm volatile("" : "+v"(fr), "+v"(fq));
        unsigned char* ws = this->ws; float* out = this->out; const float* xold = this->xold; asm volatile("" : "+s"(ws), "+s"(out), "+s"(xold));
        if (kind == K_G1) { const EpiZ e{(bf16_t*)(ws + WS_Z), (const float*)(ws + OFF_ROPE), ws + WS_QB}; e(acc, u, wr, wc, fr, fq); }
        else if (kind == K_M1) { const EpiMerge e{(bf16_t*)(ws + WS_H), (const bf16_t*)(ws + WS_Z)}; e(acc, u, wr, wc, fr, fq); }
        else if (kind == K_M2) { const EpiResid e{xold, out, (const float*)(ws + OFF_MOD) + (size_t)l * 2 * 6144 + 2048}; e(acc, u, wr, wc, fr, fq); }
        else if (kind == K_E1) { const EpiHid e{(bf16_t*)(ws + WS_Z + ZO_HID)}; e(acc, u, wr, wc, fr, fq); }
        else { const EpiYe e{(bf16_t*)(ws + WS_Z + ZO_YE), (const float*)(ws + OFF_GATE)}; e(acc, u, wr, wc, fr, fq); }
    }
};
struct USched { int kind, c, G; const int* idx;
    __device__ __forceinline__ void a_ready(const Unit&) const {} __device__ __forceinline__ void done(const Unit&) const {}
    __device__ __forceinline__ const int* rows(const Unit& u) const { return idx + u.pm * 256; }
    __device__ __forceinline__ bool next(int i, Unit& u) const {
        if (kind == K_G1) {
            constexpr int nM = L / 256, nN = PROJ / 256, nwg = nM * nN; const long Lx = (long)i * G + c; if (Lx >= nwg) return false;
            int wgid = (int)Lx; { const int q = nwg / 8, r = nwg % 8, xcd = wgid % 8, off = wgid / 8; wgid = (xcd < r ? xcd * (q + 1) : r * (q + 1) + (xcd - r) * q) + off; }
            const int nig = 8 * nN, gid = wgid / nig, fm = gid * 8, gsz = (nM - fm) < 8 ? (nM - fm) : 8; u.pm = fm + ((wgid % nig) % gsz); u.pn = (wgid % nig) / gsz; return true; }
        if (kind == K_M1) { const int rnd = i / 3, j = i - 3 * rnd; const int t = rnd * G + c; if (t >= 256) return false;
            const int T = (t & 7) * 32 + (t >> 3); u.pm = 65 * j + (T >> 2); u.pn = 4 * j + (T & 3); return true; }
        if (kind == K_M2) { const int t = i * G + c; if (t >= 256) return false; const int T = (t & 7) * 32 + (t >> 3); u.pm = T >> 2; u.pn = T & 3; return true; }
        if (kind == K_E1) { const int t = i * G + c; if (t >= 1024) return false; const int x = t & 7, q = t >> 3;
            const int e = 2 * x + (q >> 6), ui = q & 63; u.pm = 9 * e + (ui >> 3); u.pn = 8 * e + (ui & 7); return true; }
        { const int t = i * G + c; if (t >= 512) return false; const int x = t & 7, q = t >> 3;
            const int e = 2 * x + (q >> 5), ui = q & 31; u.pm = 9 * e + (ui >> 2); u.pn = 4 * e + (ui & 3); return true; }
    }
};

template <int NB>
__device__ __forceinline__ void wgemm_tile(const bf16_t* arow, const bf16_t* brow0, const bf16_t* brow1, int K, f32x16 (&acc)[NB]) {
#pragma unroll
    for (int b = 0; b < NB; ++b)
#pragma unroll
        for (int i = 0; i < 16; ++i) acc[b][i] = 0.f;
#pragma unroll 4
    for (int k0 = 0; k0 < K; k0 += 16) {
        const bf16x8 a = *(const bf16x8*)(arow + k0); const bf16x8 b0 = *(const bf16x8*)(brow0 + k0);
        acc[0] = __builtin_amdgcn_mfma_f32_32x32x16_bf16(b0, a, acc[0], 0, 0, 0);
        if constexpr (NB == 2) { const bf16x8 b1 = *(const bf16x8*)(brow1 + k0); acc[1] = __builtin_amdgcn_mfma_f32_32x32x16_bf16(b1, a, acc[1], 0, 0, 0); }
    }
}


#define GAS __attribute__((address_space(1)))
#define LAS __attribute__((address_space(3)))
typedef GAS unsigned gu32;
#define RLX_AGENT __ATOMIC_RELAXED, __HIP_MEMORY_SCOPE_AGENT
#define LDS_WAIT() asm volatile("s_waitcnt lgkmcnt(0)" ::: "memory")
#define VM_WAIT() asm volatile("s_waitcnt vmcnt(0)" ::: "memory")
#define XB_TMO      128
#define XB_XCNT(j)  (256  + 64 * (j))
#define XB_XSUB(j)  (1280 + 64 * (j))
#define XB_XGEN(j)  (2304 + 64 * (j))
#define XB_TOP      3328
#define XB_TOPGEN   3392
#define XCD_BAR_WORDS 3456
#define XB_SPIN_CAP (1u << 24)

__device__ __forceinline__ unsigned xb_ld(unsigned* p)              { return __hip_atomic_load(p, __ATOMIC_RELAXED, __HIP_MEMORY_SCOPE_AGENT); }
__device__ __forceinline__ unsigned xb_add(unsigned* p, unsigned v) { return __hip_atomic_fetch_add(p, v, __ATOMIC_RELAXED, __HIP_MEMORY_SCOPE_AGENT); }
__device__ __forceinline__ unsigned xb_xcc_id() { return (unsigned)__builtin_amdgcn_s_getreg((3 << 11) | 20) & 0xFu; }
#define XB_SPIN(cond, bar) do { unsigned _sp = 0; while (cond) { __builtin_amdgcn_s_sleep(1); \
    if ((++_sp & 255u) == 0u) { if (xb_ld(&(bar)[XB_TMO])) break; if (_sp > XB_SPIN_CAP) { atomicAdd(&(bar)[XB_TMO], 1u); break; } } } } while (0)

struct XcdBarrier {
    unsigned* bar; unsigned x;
    volatile LAS unsigned* st;
};

__device__ __forceinline__ XcdBarrier xcd_barrier_post(unsigned* bar, volatile LAS unsigned* st) {
    XcdBarrier b; b.bar = bar; b.x = xb_xcc_id(); b.st = st;
    if (threadIdx.x == 0) (void)xb_add(&bar[XB_XCNT(b.x)], 1u);
    return b;
}
__device__ __forceinline__ void xcd_barrier_complete(unsigned* bar, unsigned x, unsigned& nloc, unsigned& nx) {
    const unsigned G = gridDim.x * gridDim.y * gridDim.z;
    unsigned sum, cnt, mine, sp = 0u;
    for (;;) {
        sum = 0u; cnt = 0u; mine = 0u;
#pragma unroll
        for (unsigned j = 0; j < 16; ++j) { const unsigned c = xb_ld(&bar[XB_XCNT(j)]); sum += c; cnt += (c > 0u) ? 1u : 0u; mine = (j == x) ? c : mine; }
        if (sum == G) break;
        __builtin_amdgcn_s_sleep(1);
        if ((++sp & 255u) == 0u) { if (xb_ld(&bar[XB_TMO])) break; if (sp > XB_SPIN_CAP) { atomicAdd(&bar[XB_TMO], 1u); break; } }
    }
    nloc = mine > 0u ? mine : 1u; nx = cnt > 0u ? cnt : 1u;
}

__device__ __forceinline__ void xcd_barrier(const XcdBarrier& b, const int tid) {
    asm volatile("s_waitcnt vmcnt(0)" ::: "memory");
    __syncthreads();
    if (tid == 0) {
        unsigned* bar = b.bar;
        __builtin_amdgcn_s_waitcnt(0);
        unsigned nloc = b.st[0], nx = b.st[1];
        if (nloc == 0u) { xcd_barrier_complete(bar, b.x, nloc, nx); b.st[0] = nloc; b.st[1] = nx; }
        const unsigned old = xb_add(&bar[XB_XSUB(b.x)], 1u);
        const unsigned gen = old / nloc;
        if (old + 1u == (gen + 1u) * nloc) {
            __builtin_amdgcn_fence(__ATOMIC_RELEASE, "agent");
            asm volatile("s_waitcnt vmcnt(0)" ::: "memory");
            const unsigned og = xb_add(&bar[XB_TOP], 1u);
            const unsigned tg = og / nx;
            if (og + 1u == (tg + 1u) * nx) xb_add(&bar[XB_TOPGEN], 1u);
            else XB_SPIN(xb_ld(&bar[XB_TOPGEN]) == tg, bar);
            __builtin_amdgcn_fence(__ATOMIC_ACQUIRE, "agent");
            xb_add(&bar[XB_XGEN(b.x)], 1u);
            asm volatile("s_waitcnt vmcnt(0)" ::: "memory");
        } else {
            XB_SPIN(xb_ld(&bar[XB_XGEN(b.x)]) == gen, bar);
            __builtin_amdgcn_fence(__ATOMIC_ACQUIRE, "agent");
            asm volatile("s_waitcnt vmcnt(0)" ::: "memory");
        }
    }
    __syncthreads();
}


namespace da {
typedef short s16x4 __attribute__((ext_vector_type(4)));
constexpr int STAGE = 32768, NST = 3, WSF_OFF = NST * STAGE;
constexpr float THR = 8.f;
__device__ __forceinline__ int crow(int r, int hi) { return (r & 3) + 8 * (r >> 2) + 4 * hi; }
__device__ __forceinline__ s16x4 vtr(const LAS unsigned char* p) { return __builtin_bit_cast(s16x4, __builtin_amdgcn_ds_read_tr16_b64_v4i16((LAS s16x4*)p)); }
__device__ __forceinline__ float max3f(float a, float b, float c) { return fmaxf(fmaxf(a, b), c); }
__device__ __forceinline__ unsigned cvtpk(float lo, float hi) { typedef float f2 __attribute__((ext_vector_type(2))); typedef __bf16 b2 __attribute__((ext_vector_type(2))); f2 v = {lo, hi}; b2 b = __builtin_convertvector(v, b2); return __builtin_bit_cast(unsigned, b); }

__device__ __forceinline__ void issue_tile(LAS unsigned char* lds, const bf16_t* Kh, const bf16_t* Vh, int key0, int stage, int wave, int lane) {
#pragma unroll
    for (int i = 0; i < 2; ++i) { const int p = 2 * wave + i, c = p >> 3, j = p & 7;
        __builtin_amdgcn_global_load_lds((const unsigned*)(Kh + (size_t)(key0 + lane) * 128 + c * 64 + j * 8), (LAS unsigned*)(lds + stage * STAGE + p * 1024), 16, 0, 0); }
#pragma unroll
    for (int i = 0; i < 2; ++i) { const int p = 2 * wave + i, db = p >> 2, kg = p & 3;
        __builtin_amdgcn_global_load_lds((const unsigned*)(Vh + (size_t)(key0 + 16 * kg + (lane >> 2)) * 128 + db * 32 + (lane & 3) * 8), (LAS unsigned*)(lds + stage * STAGE + 16384 + p * 1024), 16, 0, 0); }
}
__device__ __forceinline__ void qkt(f32x16& p0, f32x16& p1, const LAS unsigned char* kb, const bf16x8 (&qf)[4]) {
#pragma unroll
    for (int i = 0; i < 16; ++i) { p0[i] = 0.f; p1[i] = 0.f; }
#pragma unroll
    for (int d0 = 0; d0 < 4; ++d0) { const bf16x8 b0 = *(const LAS bf16x8*)(kb + d0 * 2048), b1 = *(const LAS bf16x8*)(kb + d0 * 2048 + 512);
        p0 = __builtin_amdgcn_mfma_f32_32x32x16_bf16(b0, qf[d0], p0, 0, 0, 0); p1 = __builtin_amdgcn_mfma_f32_32x32x16_bf16(b1, qf[d0], p1, 0, 0, 0); }
}
__device__ __forceinline__ void pv(f32x16 (&o)[4], const LAS unsigned char* vp, const bf16x8 (&pa)[4]) {
#pragma unroll
    for (int d0 = 0; d0 < 4; ++d0)
#pragma unroll
        for (int ks = 0; ks < 4; ++ks) { const s16x4 lo = vtr(vp + d0 * 4096 + ks * 1024), h8 = vtr(vp + d0 * 4096 + ks * 1024 + 512);
            const bf16x8 vf = {lo[0], lo[1], lo[2], lo[3], h8[0], h8[1], h8[2], h8[3]};
            o[d0] = __builtin_amdgcn_mfma_f32_32x32x16_bf16(pa[ks], vf, o[d0], 0, 0, 0); }
}
__device__ __forceinline__ void softmax_tile(f32x16& p0, f32x16& p1, float& mhat, float& lsum, f32x16 (&o)[4], LAS float* wsf, int r32, int hi, bf16x8 (&pa)[4]) {
    float a = max3f(p0[0], p0[1], p1[0]), b = max3f(p0[2], p0[3], p1[1]); a = max3f(a, p1[2], p1[3]);
#pragma unroll
    for (int r = 4; r < 16; r += 4) { a = max3f(a, p0[r], p0[r + 1]); b = max3f(b, p0[r + 2], p0[r + 3]); a = max3f(a, p1[r], p1[r + 1]); b = max3f(b, p1[r + 2], p1[r + 3]); }
    float rm = fmaxf(a, b);
    { const auto rr = __builtin_amdgcn_permlane32_swap(__float_as_uint(rm), __float_as_uint(rm), false, false); rm = fmaxf(__uint_as_float(rr[0]), __uint_as_float(rr[1])); }
    if (__any(rm > mhat + THR)) {
        const float nm = fmaxf(mhat, rm), f = __builtin_amdgcn_exp2f(mhat - nm); lsum *= f; mhat = nm;
        if (hi == 0) wsf[r32] = f;
#pragma unroll
        for (int g = 0; g < 4; ++g) { const f32x4 fr = *(const LAS f32x4*)(wsf + 8 * g + 4 * hi);
#pragma unroll
            for (int i = 0; i < 4; ++i)
#pragma unroll
                for (int d0 = 0; d0 < 4; ++d0) o[d0][4 * g + i] *= fr[i]; }
    }
    float s0 = 0.f, s1 = 0.f;
#pragma unroll
    for (int r = 0; r < 16; ++r) { p0[r] = __builtin_amdgcn_exp2f(p0[r] - mhat); p1[r] = __builtin_amdgcn_exp2f(p1[r] - mhat); s0 += p0[r]; s1 += p1[r]; }
    lsum += s0 + s1;
    u32x4 w;
    w.x = cvtpk(p0[0], p0[1]); w.y = cvtpk(p0[2], p0[3]); w.z = cvtpk(p0[4], p0[5]); w.w = cvtpk(p0[6], p0[7]); pa[0] = __builtin_bit_cast(bf16x8, w);
    w.x = cvtpk(p0[8], p0[9]); w.y = cvtpk(p0[10], p0[11]); w.z = cvtpk(p0[12], p0[13]); w.w = cvtpk(p0[14], p0[15]); pa[1] = __builtin_bit_cast(bf16x8, w);
    w.x = cvtpk(p1[0], p1[1]); w.y = cvtpk(p1[2], p1[3]); w.z = cvtpk(p1[4], p1[5]); w.w = cvtpk(p1[6], p1[7]); pa[2] = __builtin_bit_cast(bf16x8, w);
    w.x = cvtpk(p1[8], p1[9]); w.y = cvtpk(p1[10], p1[11]); w.z = cvtpk(p1[12], p1[13]); w.w = cvtpk(p1[14], p1[15]); pa[3] = __builtin_bit_cast(bf16x8, w);
}
#define DA_SYNC() do { asm volatile("s_waitcnt vmcnt(0) lgkmcnt(0)" ::: "memory"); __builtin_amdgcn_s_barrier(); asm volatile("" ::: "memory"); } while (0)
__device__ __forceinline__ void unit(LAS unsigned char* lds, const bf16_t* QBh, const bf16_t* KBh, const bf16_t* VBh, int q0, int kbase, int NT, float lam, const float* subg, float oscale, bf16_t* Yh, int wave, int lane) {
    const int c = wave >> 2, s = wave & 3, r32 = lane & 31, hi = lane >> 5;
    LAS float* wsf = (LAS float*)(lds + WSF_OFF) + wave * 64;
    issue_tile(lds, KBh, VBh, kbase, 0, wave, lane);
    if (NT > 1) issue_tile(lds, KBh, VBh, kbase + 64, 1, wave, lane);
    bf16x8 qf[4];
#pragma unroll
    for (int d0 = 0; d0 < 4; ++d0) qf[d0] = *(const bf16x8*)(QBh + (size_t)(q0 + s * 32 + r32) * 128 + c * 64 + d0 * 16 + hi * 8);
    f32x16 o[4];
#pragma unroll
    for (int d0 = 0; d0 < 4; ++d0)
#pragma unroll
        for (int i = 0; i < 16; ++i) o[d0][i] = 0.f;
    float mhat = -1e30f, lsum = 0.f;
    const int koff = c * 8192 + hi * 1024 + r32 * 16, voff = 16384 + ((lane >> 4) & 1) * 32 + (lane & 3) * 8 + (4 * hi + ((lane & 15) >> 2)) * 64;
    DA_SYNC();
    f32x16 pa0, pa1, pb0, pb1; bf16x8 pa[4];
    qkt(pa0, pa1, lds + koff, qf);
    int st = 0;
    for (int t = 0; t < NT; t += 2) {
        { if (t > 0) DA_SYNC();
          const int st1 = st == 2 ? 0 : st + 1, st2 = st1 == 2 ? 0 : st1 + 1;
          if (t + 2 < NT) issue_tile(lds, KBh, VBh, kbase + (t + 2) * 64, st2, wave, lane);
          if (t + 1 < NT) qkt(pb0, pb1, lds + st1 * STAGE + koff, qf);
          softmax_tile(pa0, pa1, mhat, lsum, o, wsf, r32, hi, pa);
          pv(o, lds + st * STAGE + voff, pa); st = st1; }
        if (t + 1 >= NT) break;
        { DA_SYNC();
          const int st1 = st == 2 ? 0 : st + 1, st2 = st1 == 2 ? 0 : st1 + 1;
          if (t + 3 < NT) issue_tile(lds, KBh, VBh, kbase + (t + 3) * 64, st2, wave, lane);
          if (t + 2 < NT) qkt(pa0, pa1, lds + st1 * STAGE + koff, qf);
          softmax_tile(pb0, pb1, mhat, lsum, o, wsf, r32, hi, pa);
          pv(o, lds + st * STAGE + voff, pa); st = st1; }
    }
    { const auto rr = __builtin_amdgcn_permlane32_swap(__float_as_uint(lsum), __float_as_uint(lsum), false, false); lsum = __uint_as_float(rr[0]) + __uint_as_float(rr[1]); }
    if (hi == 0) wsf[r32] = 1.f / lsum;
#pragma unroll
    for (int g = 0; g < 4; ++g) { const f32x4 fr = *(const LAS f32x4*)(wsf + 8 * g + 4 * hi);
#pragma unroll
        for (int i = 0; i < 4; ++i)
#pragma unroll
            for (int d0 = 0; d0 < 4; ++d0) o[d0][4 * g + i] *= fr[i]; }
    DA_SYNC();
    LAS float* X = (LAS float*)lds + s * 4096;
    if (c == 1) {
#pragma unroll
        for (int d0 = 0; d0 < 4; ++d0)
#pragma unroll
            for (int i = 0; i < 16; ++i) X[(d0 * 16 + i) * 64 + lane] = o[d0][i]; }
    DA_SYNC();
    if (c == 0) {
        float ss[16];
#pragma unroll
        for (int i = 0; i < 16; ++i) ss[i] = 0.f;
#pragma unroll
        for (int d0 = 0; d0 < 4; ++d0)
#pragma unroll
            for (int i = 0; i < 16; ++i) { const float d = o[d0][i] - lam * X[(d0 * 16 + i) * 64 + lane]; o[d0][i] = d; ss[i] += d * d; }
#pragma unroll
        for (int i = 0; i < 16; ++i) { float v = ss[i]; v += __shfl_xor(v, 1); v += __shfl_xor(v, 2); v += __shfl_xor(v, 4); v += __shfl_xor(v, 8); v += __shfl_xor(v, 16); ss[i] = rsqrtf(v * (1.f / 128.f) + EPS) * oscale; }
        float gsub[4];
#pragma unroll
        for (int d0 = 0; d0 < 4; ++d0) gsub[d0] = subg[d0 * 32 + r32];
#pragma unroll
        for (int i = 0; i < 16; ++i) { bf16_t* yr = Yh + (size_t)(q0 + s * 32 + crow(i, hi)) * 512 + r32;
#pragma unroll
            for (int d0 = 0; d0 < 4; ++d0) yr[d0 * 32] = f2bf(o[d0][i] * ss[i] * gsub[d0]); }
    }
    DA_SYNC();
}
}


constexpr int NWAVES = 8, NTHREADS = 512;
constexpr int RING_BYTES = 131072, LDSCTL_OFF = RING_BYTES, MISC_OFF = LDSCTL_OFF + 320, LDS_BYTES = 147456;
constexpr int CW_BAR = 4096;
constexpr int N_PHASES = 20;
#ifndef PH_MASK
#define PH_MASK 0xFFFF
#endif
#define PH_ON(k) ((PH_MASK >> (k)) & 1)

__device__ __forceinline__ void p0_transpose_item(const float* W, int K, int N, bf16_t* WT, int mode, LAS float* scr, int item, int lane) {
    const int nblk = N / 32, kb = item / nblk, nb = item % nblk, k0 = 64 * kb, n0 = 32 * nb;
#pragma unroll 8
    for (int i = 0; i < 32; ++i) { const int kk = 2 * i + (lane >> 5); scr[kk * 33 + (lane & 31)] = W[(size_t)(k0 + kk) * N + n0 + (lane & 31)]; }
    LDS_WAIT(); asm volatile("" ::: "memory");
    const int c = lane & 7;
#pragma unroll
    for (int j = 0; j < 4; ++j) { const int n = (lane >> 3) + 8 * j; const LAS float* s = scr + (8 * c) * 33 + n; const int nn = n0 + n;
        const int row = mode == 0 ? nn : (256 * (nn >> 7) + (nn & 127) + (mode == 2 ? 128 : 0));
        u32x4 o; o.x = pk2(s[0 * 33], s[1 * 33]); o.y = pk2(s[2 * 33], s[3 * 33]); o.z = pk2(s[4 * 33], s[5 * 33]); o.w = pk2(s[6 * 33], s[7 * 33]);
        *(GAS u32x4*)(WT + (size_t)row * K + k0 + 8 * c) = o; }
    LDS_WAIT(); asm volatile("" ::: "memory");
}
__device__ __forceinline__ void norm_mod_row(const float* x, const float* g, const float* sh, const float* sc, bf16_t* o, int lane) {
    f32x4 v[4]; float s = 0.f;
#pragma unroll
    for (int j = 0; j < 4; ++j) { v[j] = *(const f32x4*)(x + j * 256 + lane * 4); s += (v[j][0] * v[j][0] + v[j][1] * v[j][1]) + (v[j][2] * v[j][2] + v[j][3] * v[j][3]); }
    const float rs = rsqrtf(wave_sum(s) * (1.f / D) + EPS);
#pragma unroll
    for (int j = 0; j < 4; ++j) { const int d = j * 256 + lane * 4; const f32x4 gg = *(const f32x4*)(g + d), a = *(const f32x4*)(sc + d), b = *(const f32x4*)(sh + d);
        const f32x4 h = v[j] * rs * gg * (a + 1.f) + b; u32x2 w; w.x = pk2(h[0], h[1]); w.y = pk2(h[2], h[3]); *(u32x2*)(o + d) = w; }
}

#define IN(i) (args.in[(i) + zero])
struct Args { const float* in[26]; float* out; unsigned char* ws; int ph_lo, ph_hi, li, pad; };

__global__ void __launch_bounds__(NTHREADS, 2) mk_fwd(Args args) {
    extern __shared__ __attribute__((aligned(16))) unsigned char lds_raw[];
    LAS unsigned char* lds = (LAS unsigned char*)lds_raw;
    volatile LAS unsigned* MISC = (volatile LAS unsigned*)(lds + MISC_OFF);
    const int tid0 = threadIdx.x, wave = __builtin_amdgcn_readfirstlane(tid0 >> 6);
    const int G = gridDim.x, bid = blockIdx.x, gw = bid * NWAVES + wave, NGW = G * NWAVES;
    for (int u = tid0; u < (LDS_BYTES - LDSCTL_OFF) / 4; u += NTHREADS) ((LAS unsigned*)(lds + LDSCTL_OFF))[u] = 0u;
    __syncthreads();
    XcdBarrier bar = xcd_barrier_post((unsigned*)(args.ws + WS_CTL) + CW_BAR + args.li * XCD_BAR_WORDS, MISC + 8);

    for (int ph = args.ph_lo; ph < args.ph_hi; ++ph) {
        int zero = 0; asm volatile("" : "+s"(zero));
        unsigned char* ws = args.ws + zero;
        const float* x_in = IN(0); const float* ctx_in = IN(2); float* out = args.out + zero;
        float* MOD = (float*)(ws + OFF_MOD); float* ROPE = (float*)(ws + OFF_ROPE); float* LAM = (float*)(ws + OFF_LAM);
        float* AFF = (float*)(ws + OFF_AFF); int* INV = (int*)(ws + OFF_INV); int* IDX = (int*)(ws + OFF_IDX); float* GATE = (float*)(ws + OFF_GATE); float* XC = (float*)(ws + WS_XC);
        bf16_t* WIN = (bf16_t*)(ws + WS_WIN); bf16_t* WBR = (bf16_t*)(ws + WS_WBR); bf16_t* WOUT = (bf16_t*)(ws + WS_WOUT); bf16_t* W13 = (bf16_t*)(ws + WS_W13); bf16_t* W2 = (bf16_t*)(ws + WS_W2);
        bf16_t* H = (bf16_t*)(ws + WS_H); bf16_t* Y = (bf16_t*)(ws + WS_Y); bf16_t* Z = (bf16_t*)(ws + WS_Z);
        bf16_t* MB = H; bf16_t* H2 = Y; bf16_t* HID = (bf16_t*)(ws + WS_Z + ZO_HID); bf16_t* YE = (bf16_t*)(ws + WS_Z + ZO_YE);

        const int l = ph < 2 ? 0 : (ph - 2) / 9, kind = ph < 2 ? ph : 2 + (ph - 2) % 9; const bool last = (l == 1);
        const float* mod = MOD + (size_t)l * 2 * 6144;
        if (kind == K_G1 || kind == K_M1 || kind == K_M2 || kind == K_E1 || kind == K_E2) {
            pg8::Gemm g; g.M = 0; g.N = 0;
            if (kind == K_G1) { g.A = H; g.Bt = WIN + (size_t)l * PROJ * D; g.K = D; }
            else if (kind == K_M1) { g.A = Y; g.Bt = WBR + (size_t)l * 3 * D * 512; g.K = 512; }
            else if (kind == K_M2) { g.A = MB; g.Bt = WOUT + (size_t)l * D * D; g.K = D; }
            else if (kind == K_E1) { g.A = H2; g.Bt = W13 + (size_t)l * 16 * 2048 * D; g.K = D; }
            else { g.A = HID; g.Bt = W2 + (size_t)l * 16 * D * FF; g.K = FF; }
            const USched S{kind, bid, G, IDX}; const UEpi E{kind, l, ws, out, l == 0 ? x_in : out};
            int wv_ = wave; asm volatile("" : "+s"(wv_)); const int tidg = wv_ * 64 + (int)__builtin_amdgcn_mbcnt_hi(~0u, __builtin_amdgcn_mbcnt_lo(~0u, 0u));
            if ((PH_MASK >> kind) & 1) pg8::gemm_phase<UEpi, USched>(lds, g, S, E, kind != K_M2, kind == K_E1, tidg);
        }
        int lane = (int)__builtin_amdgcn_mbcnt_hi(~0u, __builtin_amdgcn_mbcnt_lo(~0u, 0u)); asm volatile("" : "+v"(lane)); const int tid = wave * 64 + lane, r32 = lane & 31, hh = lane >> 5;
        if (PH_ON(K_P0) && kind == K_P0) {
            for (int it = bid; it < 192; it += G) { const int ll = it / 96, n0 = (it % 96) * 64; const float* w = IN(4) + (size_t)ll * D * 6144 + n0 + lane; const float* c = IN(1); const float* cc = IN(3);
                float a0 = 0.f, a1 = 0.f;
#pragma unroll 8
                for (int k = wave * 128; k < wave * 128 + 128; ++k) { const float wv = w[(size_t)k * 6144]; a0 += siluf_(c[k]) * wv; a1 += siluf_(cc[k]) * wv; }
                LAS float* red = (LAS float*)lds; red[(wave * 2 + 0) * 64 + lane] = a0; red[(wave * 2 + 1) * 64 + lane] = a1; __syncthreads();
                if (wave < 2) { float s = 0.f;
#pragma unroll
                    for (int q = 0; q < 8; ++q) s += red[(q * 2 + wave) * 64 + lane];
                    MOD[(size_t)(ll * 2 + wave) * 6144 + n0 + lane] = s + IN(5)[ll * 6144 + n0 + lane]; }
                __syncthreads(); }
            if (bid == G - 1) {
                for (int t = tid; t < 320 * 16; t += NTHREADS) { const int pos = t / 16, j = t % 16; const float inv = powf(10000.f, -(float)(2 * j) / 32.f);
                    if (pos < 256) { const float a = (float)pos * inv; ROPE[pos * 16 + j] = cosf(a); ROPE[4096 + pos * 16 + j] = sinf(a); }
                    else { const int p = pos - 256; const float a = (float)p * inv; ROPE[8192 + p * 16 + j] = cosf(a); ROPE[8192 + 1024 + p * 16 + j] = sinf(a); } }
                if (tid < 2) { float s1 = 0.f, s2 = 0.f; for (int i = 0; i < 64; ++i) { s1 += IN(10)[tid * 64 + i] * IN(11)[tid * 64 + i]; s2 += IN(12)[tid * 64 + i] * IN(13)[tid * 64 + i]; }
                    LAM[tid] = expf(s1) - expf(s2) + (0.8f - 0.6f * expf(-0.3f * (float)tid)); }
            }
            LAS float* scr = (LAS float*)(lds + wave * 16384);
            for (int it = gw; it < 58880; it += NGW) { int r = it;
                if (r < 7168) { const int z = r / 3584; p0_transpose_item(IN(8) + (size_t)z * D * PROJ, D, PROJ, WIN + (size_t)z * PROJ * D, 0, scr, r % 3584, lane); continue; } r -= 7168;
                if (r < 1536) { const int z = r / 256; p0_transpose_item(IN(19) + (size_t)z * 512 * D, 512, D, WBR + (size_t)z * D * 512, 0, scr, r % 256, lane); continue; } r -= 1536;
                if (r < 1024) { const int z = r / 512; p0_transpose_item(IN(20) + (size_t)z * D * D, D, D, WOUT + (size_t)z * D * D, 0, scr, r % 512, lane); continue; } r -= 1024;
                if (r < 16384) { const int z = r / 512; p0_transpose_item(IN(22) + (size_t)z * D * FF, D, FF, W13 + (size_t)z * 2048 * D, 1, scr, r % 512, lane); continue; } r -= 16384;
                if (r < 16384) { const int z = r / 512; p0_transpose_item(IN(23) + (size_t)z * D * FF, D, FF, W13 + (size_t)z * 2048 * D, 2, scr, r % 512, lane); continue; } r -= 16384;
                { const int z = r / 512; p0_transpose_item(IN(24) + (size_t)z * FF * D, FF, D, W2 + (size_t)z * D * FF, 0, scr, r % 512, lane); }
            }
        } else if (PH_ON(K_H1) && kind == K_H1) {
            for (int row = gw; row < R; row += NGW) { const float* xr = row < L ? x_in + (size_t)row * D : ctx_in + (size_t)(row - L) * D; const float* m = MOD + (row < L ? 0 : 6144);
                norm_mod_row(xr, IN(6), m, m + 1024, H + (size_t)row * D, lane); }
        } else if (PH_ON(K_G1) && kind == K_G1) {
            const int ntn = (last ? 2048 : PROJ) / 32;
            for (int it = gw; it < 8 * ntn; it += NGW) { const int mt = it & 7, nt = it >> 3; f32x16 acc[1];
                wgemm_tile<1>(H + (size_t)(L + mt * 32 + r32) * D + 8 * hh, WIN + (size_t)l * PROJ * D + (size_t)(nt * 32 + r32) * D + 8 * hh, nullptr, D, acc);
                const int row = L + mt * 32 + r32; const int nb = nt * 32;
                const int type = (nb >= 2560 && nb < 3072) ? 2 : (nb >= 3072 && nb < 4096) ? 3 : (nb >= 4096) ? 4 : 0;
                bf16_t* dst;
                if ((nb >= 1024 && nb < 2048) || (nb >= 2560 && nb < 3072)) { const int sel = nb < 1536 ? 1 : nb < 2048 ? 2 : 0; bf16_t* hb = (bf16_t*)(ws + WS_QB + (size_t)sel * QKV_STRIDE); const int cq = nb & 511; dst = hb + (size_t)(cq >> 7) * HB + (size_t)row * 128 + (cq & 127); }
                else { const int zc = nb < 1024 ? nb : nb < 2560 ? ZQA + (nb - 2048) : nb < 4096 ? ZU + (nb - 3072) : ZG + (nb - 4096); dst = Z + (size_t)row * PROJZ + zc; }
#pragma unroll
                for (int g4 = 0; g4 < 4; ++g4) { float v[4];
#pragma unroll
                    for (int i = 0; i < 4; ++i) { float t = acc[0][4 * g4 + i]; t = type == 2 ? t * C2 : type == 3 ? gelu_tanh(t) : type == 4 ? sigmoidf_(t) : t; v[i] = t; }
                    u32x2 w; w.x = pk2(v[0], v[1]); w.y = pk2(v[2], v[3]); *(u32x2*)(dst + 8 * g4 + 4 * hh) = w; } }
        } else if (PH_ON(K_MIX) && kind == K_MIX) {
            const float lam = LAM[l], oscale = 1.f - (0.8f - 0.6f * expf(-0.3f * (float)l));
            bf16_t* QB = (bf16_t*)(ws + WS_QB); bf16_t* KB = (bf16_t*)(ws + WS_KB); bf16_t* VB = (bf16_t*)(ws + WS_VB);
            const int nlat = (512 - bid + G - 1) / G, nctx = (!last && bid < 8) ? (8 - bid + G - 1) / G : 0;
            for (int ui = 0; ui < nlat + nctx; ++ui) { int h, q0, kbase, NT;
                if (ui < nlat) { const int uu = bid + ui * G, x = uu & 7, b = (uu >> 3) & 31, i = uu >> 8; h = x >> 1; q0 = (((x & 1) * 32 + b) * 2 + i) * 128; kbase = 0; NT = R / 64; }
                else { const int uu = bid + (ui - nlat) * G; h = uu >> 1; q0 = L + (uu & 1) * 128; kbase = L; NT = C / 64; }
                da::unit(lds, QB + (size_t)h * HB, KB + (size_t)h * HB, VB + (size_t)h * HB, q0, kbase, NT, lam, IN(14) + l * 128, oscale, Y + YP + h * 128, wave, lane); }
        } else if (PH_ON(K_M1) && kind == K_M1) {
            if (!last) for (int it = gw; it < 8 * 32; it += NGW) { const int mt = it & 7, nt = it >> 3; const int row = L + mt * 32 + r32; float m4[4][4];
#pragma unroll
                for (int g4 = 0; g4 < 4; ++g4)
#pragma unroll
                    for (int i = 0; i < 4; ++i) m4[g4][i] = 0.f;
                for (int j = 0; j < 3; ++j) { f32x16 acc[1];
                    wgemm_tile<1>(Y + (size_t)j * YP + (size_t)row * 512 + 8 * hh, WBR + ((size_t)l * 3 + j) * D * 512 + (size_t)(nt * 32 + r32) * 512 + 8 * hh, nullptr, 512, acc);
#pragma unroll
                    for (int g4 = 0; g4 < 4; ++g4) { const u32x2 gw2 = *(const u32x2*)(Z + (size_t)row * PROJZ + ZG + j * 1024 + nt * 32 + 8 * g4 + 4 * hh);
                        m4[g4][0] += __uint_as_float(gw2.x << 16) * acc[0][4 * g4]; m4[g4][1] += __uint_as_float(gw2.x & 0xffff0000u) * acc[0][4 * g4 + 1];
                        m4[g4][2] += __uint_as_float(gw2.y << 16) * acc[0][4 * g4 + 2]; m4[g4][3] += __uint_as_float(gw2.y & 0xffff0000u) * acc[0][4 * g4 + 3]; } }
#pragma unroll
                for (int g4 = 0; g4 < 4; ++g4) { u32x2 w; w.x = pk2(m4[g4][0], m4[g4][1]); w.y = pk2(m4[g4][2], m4[g4][3]); *(u32x2*)(MB + (size_t)row * D + nt * 32 + 8 * g4 + 4 * hh) = w; } }
        } else if (PH_ON(K_M2) && kind == K_M2) {
            const float* xl_old = l == 0 ? x_in : out; const float* xc_old = l == 0 ? ctx_in : XC;
            if (!last) for (int it = gw; it < 8 * 32; it += NGW) { const int mt = it & 7, nt = it >> 3; const int rc = mt * 32 + r32; f32x16 acc[1];
                wgemm_tile<1>(MB + (size_t)(L + rc) * D + 8 * hh, WOUT + (size_t)l * D * D + (size_t)(nt * 32 + r32) * D + 8 * hh, nullptr, D, acc);
#pragma unroll
                for (int g4 = 0; g4 < 4; ++g4) { const int n = nt * 32 + 8 * g4 + 4 * hh; const f32x4 xo = *(const f32x4*)(xc_old + (size_t)rc * D + n), gt = *(const f32x4*)(mod + 6144 + 2048 + n);
                    f32x4 a; a[0] = acc[0][4 * g4]; a[1] = acc[0][4 * g4 + 1]; a[2] = acc[0][4 * g4 + 2]; a[3] = acc[0][4 * g4 + 3]; *(f32x4*)(XC + (size_t)rc * D + n) = xo + gt * a; } }
        } else if (PH_ON(K_R) && kind == K_R) {
            const int NR = last ? L : R; const float* g2 = IN(7) + l * D; const float* w_r = IN(21) + (size_t)l * D * 16;
            for (int row = gw; row < NR; row += NGW) {
                const float* x = row < L ? out + (size_t)row * D : XC + (size_t)(row - L) * D; const float* m = mod + (row < L ? 0 : 6144);
                f32x4 v[4]; float s = 0.f;
#pragma unroll
                for (int j = 0; j < 4; ++j) { v[j] = *(const f32x4*)(x + j * 256 + lane * 4); s += (v[j][0] * v[j][0] + v[j][1] * v[j][1]) + (v[j][2] * v[j][2] + v[j][3] * v[j][3]); }
                const float rs = rsqrtf(wave_sum(s) * (1.f / D) + EPS);
                float lg[16];
#pragma unroll
                for (int e = 0; e < 16; ++e) lg[e] = 0.f;
#pragma unroll
                for (int j = 0; j < 4; ++j) { const int d = j * 256 + lane * 4; const f32x4 gg = *(const f32x4*)(g2 + d), a = *(const f32x4*)(m + 4096 + d), b = *(const f32x4*)(m + 3072 + d);
                    const f32x4 h = v[j] * rs * gg * (a + 1.f) + b; u32x2 w; w.x = pk2(h[0], h[1]); w.y = pk2(h[2], h[3]); *(u32x2*)(H2 + (size_t)row * D + d) = w;
#pragma unroll
                    for (int i = 0; i < 4; ++i) { const f32x4* wr = (const f32x4*)(w_r + (size_t)(d + i) * 16);
#pragma unroll
                        for (int e4 = 0; e4 < 4; ++e4) { const f32x4 w4 = wr[e4]; lg[4 * e4] += h[i] * w4[0]; lg[4 * e4 + 1] += h[i] * w4[1]; lg[4 * e4 + 2] += h[i] * w4[2]; lg[4 * e4 + 3] += h[i] * w4[3]; } } }
                float mx = -1e30f;
#pragma unroll
                for (int e = 0; e < 16; ++e) { lg[e] = wave_sum(lg[e]); mx = fmaxf(mx, lg[e]); }
                float den = 0.f;
#pragma unroll
                for (int e = 0; e < 16; ++e) { lg[e] = expf(lg[e] - mx); den += lg[e]; }
                float rv = 0.f;
#pragma unroll
                for (int e = 0; e < 16; ++e) rv = (lane == e) ? lg[e] : rv;
                if (lane < 16) AFF[(size_t)row * 16 + lane] = rv / den;
            }
        } else if (PH_ON(K_S) && kind == K_S) {
            LAS int* red = (LAS int*)lds; LAS int* sc_gt = red + 16; LAS int* sc_eq = sc_gt + NTHREADS;
            for (int it = bid; it < 32; it += G) { const int e = it & 15, set = it >> 4;
                const int n = set == 0 ? L : C, base = set == 0 ? 0 : L, cap = set == 0 ? CAPL : CAPC, sbase = set == 0 ? 0 : CAPL, per = set == 0 ? 32 : 1;
                if (set == 1) { for (int s = CAPL + (last ? 0 : CAPC) + tid; s < SLOTS; s += NTHREADS) { IDX[e * SLOTS + s] = 0; GATE[e * SLOTS + s] = 0.f; } if (last) continue; }
                const bool act = tid * per < n; const float* ap = AFF + (size_t)(base + tid * per) * 16 + e;
                unsigned T = 0u;
                for (int bit = 30; bit >= 0; --bit) { const unsigned cand = T | (1u << bit); int cnt = 0;
                    if (act) for (int i = 0; i < per; ++i) cnt += (__float_as_uint(ap[(size_t)i * 16]) >= cand) ? 1 : 0;
                    cnt = (int)wave_sum((float)cnt);
                    __syncthreads(); if (lane == 0) red[wave] = cnt; __syncthreads();
                    int tot = 0;
#pragma unroll
                    for (int i = 0; i < NWAVES; ++i) tot += red[i];
                    if (tot >= cap) T = cand; }
                int gtc = 0, eqc = 0;
                if (act) for (int i = 0; i < per; ++i) { const unsigned v = __float_as_uint(ap[(size_t)i * 16]); gtc += v > T ? 1 : 0; eqc += v == T ? 1 : 0; }
                __syncthreads(); sc_gt[tid] = gtc; sc_eq[tid] = eqc; __syncthreads();
                for (int o = 1; o < NTHREADS; o <<= 1) { const int a = tid >= o ? sc_gt[tid - o] : 0, b = tid >= o ? sc_eq[tid - o] : 0; __syncthreads(); sc_gt[tid] += a; sc_eq[tid] += b; __syncthreads(); }
                const int need = cap - sc_gt[NTHREADS - 1]; int gt_before = sc_gt[tid] - gtc, eq_before = sc_eq[tid] - eqc;
                if (act) for (int i = 0; i < per; ++i) { const int tok = base + tid * per + i; const unsigned v = __float_as_uint(ap[(size_t)i * 16]); int slot = -1;
                    if (v > T) { slot = gt_before + (eq_before < need ? eq_before : need); ++gt_before; }
                    else if (v == T) { if (eq_before < need) slot = gt_before + eq_before; ++eq_before; }
                    if (slot >= 0) { IDX[e * SLOTS + sbase + slot] = tok; GATE[e * SLOTS + sbase + slot] = __uint_as_float(v); }
                    INV[(size_t)tok * 16 + e] = slot >= 0 ? sbase + slot : -1; }
                __syncthreads(); }
        } else if (PH_ON(K_E1) && kind == K_E1) {
            if (!last) for (int it = gw; it < 16 * 32; it += NGW) { const int e = it >> 5, nt = it & 31, p = nt >> 2, c4 = nt & 3; f32x16 acc[2];
                const int tok = IDX[e * SLOTS + CAPL + r32]; const bf16_t* b0 = W13 + ((size_t)l * 16 + e) * 2048 * D + (size_t)(256 * p + 32 * c4 + r32) * D + 8 * hh;
                wgemm_tile<2>(H2 + (size_t)tok * D + 8 * hh, b0, b0 + (size_t)128 * D, D, acc);
#pragma unroll
                for (int g4 = 0; g4 < 4; ++g4) { float v[4];
#pragma unroll
                    for (int i = 0; i < 4; ++i) v[i] = siluf_(acc[0][4 * g4 + i]) * acc[1][4 * g4 + i];
                    u32x2 w; w.x = pk2(v[0], v[1]); w.y = pk2(v[2], v[3]); *(u32x2*)(HID + ((size_t)e * SLOTS + CAPL + r32) * FF + 128 * p + 32 * c4 + 8 * g4 + 4 * hh) = w; } }
        } else if (PH_ON(K_E2) && kind == K_E2) {
            if (!last) for (int it = gw; it < 16 * 32; it += NGW) { const int e = it >> 5, nt = it & 31; f32x16 acc[1]; const size_t row = (size_t)e * SLOTS + CAPL + r32;
                wgemm_tile<1>(HID + row * FF + 8 * hh, W2 + ((size_t)l * 16 + e) * D * FF + (size_t)(nt * 32 + r32) * FF + 8 * hh, nullptr, FF, acc);
                const float gsc = GATE[row];
#pragma unroll
                for (int g4 = 0; g4 < 4; ++g4) { u32x2 w; w.x = pk2(acc[0][4 * g4] * gsc, acc[0][4 * g4 + 1] * gsc); w.y = pk2(acc[0][4 * g4 + 2] * gsc, acc[0][4 * g4 + 3] * gsc);
                    *(u32x2*)(YE + row * D + nt * 32 + 8 * g4 + 4 * hh) = w; } }
        } else if (PH_ON(K_CB) && kind == K_CB) {
            const int NR = last ? L : R; const float* gn = last ? IN(25) : IN(6) + D; const float* modn = MOD + (size_t)2 * 6144;
            for (int row = gw; row < NR; row += NGW) {
                float* x = row < L ? out + (size_t)row * D : XC + (size_t)(row - L) * D; const float* m = mod + (row < L ? 0 : 6144);
                f32x4 v[4], a[4];
#pragma unroll
                for (int j = 0; j < 4; ++j) { v[j] = *(const f32x4*)(x + j * 256 + lane * 4); a[j] = (f32x4){0.f, 0.f, 0.f, 0.f}; }
                for (int e = 0; e < 16; ++e) { const int s = INV[(size_t)row * 16 + e]; if (s < 0) continue; const bf16_t* y = YE + ((size_t)e * SLOTS + s) * D;
#pragma unroll
                    for (int j = 0; j < 4; ++j) { const u32x2 u = *(const u32x2*)(y + j * 256 + lane * 4); a[j][0] += __uint_as_float(u.x << 16); a[j][1] += __uint_as_float(u.x & 0xffff0000u); a[j][2] += __uint_as_float(u.y << 16); a[j][3] += __uint_as_float(u.y & 0xffff0000u); } }
                float s = 0.f;
#pragma unroll
                for (int j = 0; j < 4; ++j) { const f32x4 gt = *(const f32x4*)(m + 5120 + j * 256 + lane * 4); v[j] = v[j] + gt * a[j]; s += (v[j][0] * v[j][0] + v[j][1] * v[j][1]) + (v[j][2] * v[j][2] + v[j][3] * v[j][3]); }
                const float rs = rsqrtf(wave_sum(s) * (1.f / D) + EPS);
                if (last) {
#pragma unroll
                    for (int j = 0; j < 4; ++j) { const int d = j * 256 + lane * 4; *(f32x4*)(out + (size_t)row * D + d) = v[j] * rs * *(const f32x4*)(gn + d); }
                } else { const float* mn = modn + (row < L ? 0 : 6144);
#pragma unroll
                    for (int j = 0; j < 4; ++j) { const int d = j * 256 + lane * 4; *(f32x4*)(x + d) = v[j];
                        const f32x4 h = v[j] * rs * *(const f32x4*)(gn + d) * (*(const f32x4*)(mn + 1024 + d) + 1.f) + *(const f32x4*)(mn + d); u32x2 w; w.x = pk2(h[0], h[1]); w.y = pk2(h[2], h[3]); *(u32x2*)(H + (size_t)row * D + d) = w; } }
            }
        }
        if (ph + 1 < args.ph_hi) xcd_barrier(bar, tid);
    }
}

__global__ void __launch_bounds__(256) k_na(const bf16_t* __restrict__ Z, const float* __restrict__ rpb, bf16_t* __restrict__ Y, int row_base) {
    const int lane = threadIdx.x & 63, head = blockIdx.y * 4 + (threadIdx.x >> 6); const int row = row_base + blockIdx.x * 64 + lane;
    float q[64], acc[64];
#pragma unroll
    for (int d = 0; d < 64; ++d) { q[d] = bf2f(Z[(size_t)row * PROJZ + ZQA + head * 64 + d]) * 0.125f; acc[d] = 0.f; }
    float m = -1e30f, l = 0.f;
    auto step = [&](int krow, float bias) {
        const bf16_t* kp = Z + (size_t)krow * PROJZ + ZKA + head * 64; const bf16_t* vp = Z + (size_t)krow * PROJZ + ZVA + head * 64;
        float s = bias;
#pragma unroll
        for (int d = 0; d < 64; ++d) s += q[d] * bf2f(kp[d]);
        if (s > m) { const float f = __expf(m - s); l *= f;
#pragma unroll
            for (int d = 0; d < 64; ++d) acc[d] *= f;
            m = s; }
        const float p = __expf(s - m); l += p;
#pragma unroll
        for (int d = 0; d < 64; ++d) acc[d] += p * bf2f(vp[d]);
    };
    for (int c = 0; c < C; ++c) step(L + c, 0.f);
    if (row < L) {
        const int r = row >> 6, col = row & 63; int r0 = r - 4; r0 = r0 < 0 ? 0 : (r0 > 248 ? 248 : r0); int c0 = col - 8; c0 = c0 < 0 ? 0 : (c0 > 48 ? 48 : c0);
        for (int i = 0; i < 8; ++i) for (int j = 0; j < 16; ++j) { const int dr = r0 + i - r + 7, dc = c0 + j - col + 15; step((r0 + i) * 64 + c0 + j, rpb[(head * 15 + dr) * 31 + dc]); }
    }
    const float il = 1.f / l;
#pragma unroll
    for (int d = 0; d < 64; ++d) Y[(size_t)row * 512 + head * 64 + d] = f2bf(acc[d] * il);
}

__global__ void __launch_bounds__(256) k_da(const bf16_t* __restrict__ QB, const bf16_t* __restrict__ KB, const bf16_t* __restrict__ VB, const float* __restrict__ lamp, const float* __restrict__ subg, float one_minus_li, bf16_t* __restrict__ Y, int row_base, int key_lo, int key_hi) {
    extern __shared__ float sm[];
    const int lane = threadIdx.x & 63, w = __builtin_amdgcn_readfirstlane(threadIdx.x >> 6), cmap = w & 1, half = w >> 1, head = blockIdx.y;
    const int row = row_base + blockIdx.x * 64 + lane;
    float q[64], acc[64];
#pragma unroll
    for (int d = 0; d < 64; ++d) { q[d] = bf2f(QB[(size_t)head * HB + (size_t)row * 128 + cmap * 64 + d]); acc[d] = 0.f; }
    float m = -1e30f, l = 0.f;
    for (int kr = key_lo; kr < key_hi; ++kr) {
        const bf16_t* kp = KB + (size_t)head * HB + (size_t)kr * 128 + cmap * 64; const bf16_t* vp = VB + (size_t)head * HB + (size_t)kr * 128 + half * 64;
        float s = 0.f;
#pragma unroll
        for (int d = 0; d < 64; ++d) s += q[d] * bf2f(kp[d]);
        if (s > m) { const float f = exp2f(m - s); l *= f;
#pragma unroll
            for (int d = 0; d < 64; ++d) acc[d] *= f;
            m = s; }
        const float p = exp2f(s - m); l += p;
#pragma unroll
        for (int d = 0; d < 64; ++d) acc[d] += p * bf2f(vp[d]);
    }
    const float il = 1.f / l;
#pragma unroll
    for (int d = 0; d < 64; ++d) sm[(w * 64 + lane) * 64 + d] = acc[d] * il;
    __syncthreads();
    const float lam = lamp[0]; float o[32]; float ss = 0.f;
#pragma unroll
    for (int i = 0; i < 32; ++i) { const int dv = w * 32 + i, hf = dv >> 6, dd = dv & 63; const float a0 = sm[((hf * 2 + 0) * 64 + lane) * 64 + dd], a1 = sm[((hf * 2 + 1) * 64 + lane) * 64 + dd]; o[i] = a0 - lam * a1; ss += o[i] * o[i]; }
    __syncthreads();
    sm[lane * 4 + w] = ss;
    __syncthreads();
    const float tot = sm[lane * 4] + sm[lane * 4 + 1] + sm[lane * 4 + 2] + sm[lane * 4 + 3];
    const float rs = rsqrtf(tot * (1.f / 128.f) + EPS) * one_minus_li;
#pragma unroll
    for (int i = 0; i < 32; ++i) { const int dv = w * 32 + i; Y[YP + (size_t)row * 512 + head * 128 + dv] = f2bf(o[i] * rs * subg[dv]); }
}

__global__ void k_gm_stats(const bf16_t* __restrict__ Z, float* __restrict__ gst, int nrows) {
    const int row = blockIdx.x * 4 + (threadIdx.x >> 6), lane = threadIdx.x & 63; if (row >= nrows) return;
    float v[8]; float s = 0.f;
#pragma unroll
    for (int i = 0; i < 8; ++i) { v[i] = bf2f(Z[(size_t)row * PROJZ + ZV + lane * 8 + i]); s += v[i]; }
    const float mean = wave_sum(s) * (1.f / 512.f); float q = 0.f;
#pragma unroll
    for (int i = 0; i < 8; ++i) { const float d = v[i] - mean; q += d * d; }
    const float var = wave_sum(q) * (1.f / 512.f);
    if (lane == 0) { gst[row * 2] = mean; gst[row * 2 + 1] = rsqrtf(var + EPS); }
}
__global__ void k_gm_mix(const bf16_t* __restrict__ Z, const float* __restrict__ gst, const float* __restrict__ ln_g, const float* __restrict__ ln_b, const float* __restrict__ w_s, const float* __restrict__ b_s, bf16_t* __restrict__ Y, int nrows) {
    const size_t gid = (size_t)blockIdx.x * blockDim.x + threadIdx.x; const int row = (int)(gid / 512), ch = (int)(gid % 512); if (row >= nrows) return;
    const int chunk = row >> 7, p = row & 127, g = ch >> 7; const float lg = ln_g[ch], lb = ln_b[ch];
    float acc = 0.f;
    for (int qq = 0; qq < 128; ++qq) { const int r2 = chunk * 128 + qq; const float vn = (bf2f(Z[(size_t)r2 * PROJZ + ZV + ch]) - gst[r2 * 2]) * gst[r2 * 2 + 1] * lg + lb; acc += w_s[(g * 128 + p) * 128 + qq] * vn; }
    acc += b_s[g * 128 + p];
    Y[2 * YP + (size_t)row * 512 + ch] = f2bf(bf2f(Z[(size_t)row * PROJZ + ZU + ch]) * acc);
}


#ifndef FAST_TAIL
#define FAST_TAIL 1
#endif
static void launch_mk(const Args& base, int lo, int hi, int li, int grid, hipStream_t stream) {
    Args a = base; a.ph_lo = lo; a.ph_hi = hi; a.li = li;
    hipLaunchKernelGGL(mk_fwd, dim3(grid), dim3(NTHREADS), LDS_BYTES, stream, a);
}
extern "C" void kernel_launch(void* const* d_in, const int* in_sizes, int n_in, void* d_out, int out_size, void* d_ws, size_t ws_size, hipStream_t stream) {
    static int grid = 0;
    if (grid == 0) {
        if (n_in != 26 || ws_size < WS_END) { fprintf(stderr, "kernel_launch: bad arguments (n_in %d, ws %zu < %zu)\n", n_in, ws_size, (size_t)WS_END); grid = -1; return; }
        int dev = 0, cus = 0;
        if (hipGetDevice(&dev) != hipSuccess || hipDeviceGetAttribute(&cus, hipDeviceAttributeMultiprocessorCount, dev) != hipSuccess) { grid = -1; return; }
        if (hipFuncSetAttribute((const void*)mk_fwd, hipFuncAttributeMaxDynamicSharedMemorySize, LDS_BYTES) != hipSuccess) { fprintf(stderr, "kernel_launch: hipFuncSetAttribute failed\n"); grid = -1; return; }
        grid = cus;
    }
    if (grid < 0) return;
    (void)hipMemsetAsync((char*)d_ws + WS_CTL, 0, CTL_ZERO_BYTES, stream);
    Args base{};
    for (int i = 0; i < 26; ++i) base.in[i] = (const float*)d_in[i];
    base.out = (float*)d_out; base.ws = (unsigned char*)d_ws;
    const float* rpb = (const float*)d_in[9]; const float* subg = (const float*)d_in[14]; const float* ln_g = (const float*)d_in[15]; const float* ln_b = (const float*)d_in[16];
    const float* w_s = (const float*)d_in[17]; const float* b_s = (const float*)d_in[18]; const float* g1 = (const float*)d_in[6]; const float* g2 = (const float*)d_in[7];
    const float* w_r = (const float*)d_in[21]; const float* g_final = (const float*)d_in[25]; const float* x = (const float*)d_in[0]; const float* ctx = (const float*)d_in[2];
    char* ws = (char*)d_ws; float* out = (float*)d_out;
    float* MOD = (float*)(ws + OFF_MOD); float* LAM = (float*)(ws + OFF_LAM); float* GST = (float*)(ws + OFF_GST);
    float* AFF = (float*)(ws + OFF_AFF); int* INV = (int*)(ws + OFF_INV); int* IDX = (int*)(ws + OFF_IDX); float* GATE = (float*)(ws + OFF_GATE); float* XC = (float*)(ws + WS_XC);
    bf16_t* WBR = (bf16_t*)(ws + WS_WBR); bf16_t* WOUT = (bf16_t*)(ws + WS_WOUT); bf16_t* W13 = (bf16_t*)(ws + WS_W13); bf16_t* W2 = (bf16_t*)(ws + WS_W2);
    bf16_t* Y = (bf16_t*)(ws + WS_Y); bf16_t* Z = (bf16_t*)(ws + WS_Z); bf16_t* QB = (bf16_t*)(ws + WS_QB); bf16_t* KB = (bf16_t*)(ws + WS_KB); bf16_t* VB = (bf16_t*)(ws + WS_VB);
    int li = 0;
    launch_mk(base, 0, 2, li++, grid, stream);
    for (int l = 0; l < 2; ++l) {
        const bool last = (l == 1); const int NR = last ? L : R; const int pb = 2 + 9 * l;
        const float* mod = MOD + (size_t)l * 2 * 6144;
        launch_mk(base, pb + 0, pb + 1, li++, grid, stream);
        k_na<<<dim3(NR / 64, 2), 256, 0, stream>>>(Z, rpb + (size_t)l * 8 * 15 * 31, Y, 0);
        k_gm_stats<<<NR / 4, 256, 0, stream>>>(Z, GST, NR);
        k_gm_mix<<<(unsigned)(((size_t)NR * 512 + 255) / 256), 256, 0, stream>>>(Z, GST, ln_g + l * 512, ln_b + l * 512, w_s + (size_t)l * 4 * 128 * 128, b_s + l * 512, Y, NR);
        launch_mk(base, pb + 1, pb + 9, li++, grid, stream);
    }
}
```

```cpp
#include <hip/hip_runtime.h>
#include <cstdint>
#include <cstdio>

typedef unsigned short bf16_t;
__device__ __forceinline__ float bf2f(bf16_t b) { return __uint_as_float(((unsigned)b) << 16); }
__device__ __forceinline__ bf16_t f2bf(float f) { unsigned u = __float_as_uint(f); return (bf16_t)((u + 0x7fffu + ((u >> 16) & 1u)) >> 16); }
__device__ __forceinline__ unsigned pk2(float lo, float hi) { return (unsigned)f2bf(lo) | ((unsigned)f2bf(hi) << 16); }

constexpr int D = 1024, L = 16384, C = 256, R = L + C, PROJ = 7168, NE = 16, FF = 1024;
constexpr int CAPL = 2048, CAPC = 32, SLOTS = 2304;
constexpr float EPS = 1e-6f;
constexpr float C2 = 0.125f * 1.4426950408889634f;
constexpr int PROJZ = 5632;
constexpr int ZKA = 0, ZVA = 512, ZQA = 1024, ZU = 1536, ZV = 2048, ZG = 2560;
constexpr size_t HB = (size_t)R * 128;
constexpr size_t YP = (size_t)R * 512;

constexpr size_t MiB = 1u << 20;
constexpr size_t WS_CTL = 0, CTL_ZERO_BYTES = 1 * MiB;
constexpr size_t OFF_MOD = 1 * MiB;
constexpr size_t OFF_ROPE = 1 * MiB + 256 * 1024;
constexpr size_t OFF_LAM = 1 * MiB + 320 * 1024;
constexpr size_t OFF_GST = 1 * MiB + 384 * 1024;
constexpr size_t OFF_AFF = 2 * MiB;
constexpr size_t OFF_INV = 3 * MiB + 256 * 1024;
constexpr size_t OFF_IDX = 4 * MiB + 512 * 1024;
constexpr size_t OFF_GATE = 4 * MiB + 768 * 1024;
constexpr size_t WS_XC = 5 * MiB;
constexpr size_t WS_WIN = 6 * MiB;
constexpr size_t WS_WBR = 34 * MiB;
constexpr size_t WS_WOUT = 40 * MiB;
constexpr size_t WS_W13 = 44 * MiB;
constexpr size_t WS_W2 = 172 * MiB;
constexpr size_t WS_H = 236 * MiB;
constexpr size_t WS_Y = 269 * MiB;
constexpr size_t WS_Z = 318 * MiB;
constexpr size_t QKV_STRIDE = 33 * MiB / 2;
constexpr size_t WS_QB = 497 * MiB, WS_KB = WS_QB + QKV_STRIDE, WS_VB = WS_QB + 2 * QKV_STRIDE;
constexpr size_t WS_END = 546 * MiB;
constexpr size_t ZO_HID = 72 * MiB;
constexpr size_t ZO_YE = 0;

__device__ __forceinline__ float gelu_tanh(float x) { const float y = 1.5957691216057308f * (x + 0.044715f * x * x * x); return x / (1.f + __expf(-y)); }
__device__ __forceinline__ float sigmoidf_(float x) { return 1.f / (1.f + __expf(-x)); }
__device__ __forceinline__ float siluf_(float x) { return x / (1.f + __expf(-x)); }
__device__ __forceinline__ float wave_sum(float v) {
#pragma unroll
    for (int o = 1; o < 64; o <<= 1) v += __shfl_xor(v, o);
    return v;
}

enum { K_P0 = 0, K_H1 = 1, K_G1 = 2, K_MIX = 3, K_M1 = 4, K_M2 = 5, K_R = 6, K_S = 7, K_E1 = 8, K_E2 = 9, K_CB = 10 };

namespace pg8 {
#define PG8_LAS __attribute__((address_space(3)))
typedef unsigned short bf16_t;
typedef short bf16x8 __attribute__((ext_vector_type(8)));
typedef float f32x4 __attribute__((ext_vector_type(4)));
typedef unsigned u32x4 __attribute__((ext_vector_type(4)));
constexpr int BM = 256, BK = 64, HALF = 128, HTB = HALF * BK * 2  , STAGE_BYTES = 8 * HTB, NXCD = 8, WGM = 8;

__host__ __device__ __forceinline__ int lds_byte(int r, int c) { const int st = (r >> 4) * 2 + (c >> 5), rr = r & 15, cc = c & 31, ob = rr * 64 + cc * 2; return st * 1024 + (ob ^ (((ob >> 9) & 1) << 5)); }
__host__ __device__ __forceinline__ void stage_rc(int b, int& R, int& C) { const int st = b / 1024, sb = b % 1024, swz = sb ^ (((sb >> 9) & 1) << 5); R = (st >> 1) * 16 + swz / 64; C = (st & 1) * 32 + (swz % 64) / 2; }
__host__ __device__ __forceinline__ int perm32(int rho) { const int n = rho >> 4, i = rho & 15; return 8 * (i >> 2) + 4 * n + (i & 3); }

struct Unit { int pm, pn; };
struct Gemm { const bf16_t* A; const bf16_t* Bt; int M, N, K; };

struct StaticOrder {
    int nM, nN, nwg, G, c;
    __host__ __device__ void init(int M, int N, int G_, int c_) { nM = M / BM; nN = N / BM; nwg = nM * nN; G = G_; c = c_; }
    __host__ __device__ bool next(int i, Unit& u) const {
        const long L = (long)i * G + c; if (L >= nwg) return false;
        int wgid = (int)L; { const int q = nwg / NXCD, r = nwg % NXCD, xcd = wgid % NXCD, off = wgid / NXCD; wgid = (xcd < r ? xcd * (q + 1) : r * (q + 1) + (xcd - r) * q) + off; }
        const int nig = WGM * nN, gid = wgid / nig, fm = gid * WGM, gsz = (nM - fm) < WGM ? (nM - fm) : WGM;
        u.pm = fm + ((wgid % nig) % gsz); u.pn = (wgid % nig) / gsz; return true;
    }
    __device__ __forceinline__ void a_ready(const Unit&) const {}
    __device__ __forceinline__ void done(const Unit&) const {}
};

__device__ __forceinline__ unsigned cvt_pk_bf16(float lo, float hi) { unsigned r; asm volatile("v_cvt_pk_bf16_f32 %0, %1, %2" : "=v"(r) : "v"(lo), "v"(hi)); return r; }
typedef float f32x2 __attribute__((ext_vector_type(2)));
template <class Epi, class Sched>
__device__ __forceinline__ void gemm_phase(PG8_LAS unsigned char* lds, const Gemm g, const Sched& S, const Epi& E, const bool PERM, const bool GATHER, const int tid_in) {
    constexpr bool ALIGN_EPI = true, SP2 = true;
    int tid_ = tid_in; asm volatile("" : "+v"(tid_));
    const int tid = tid_, wid = __builtin_amdgcn_readfirstlane(tid >> 6), lane = tid & 63, wr = wid >> 2, wc = wid & 3, fr = lane & 15, fq = lane >> 4;
    const int K = g.K, nt = K / BK;
    unsigned voffA[2], voffB[2];
#pragma unroll
    for (int i = 0; i < 2; ++i) { int R, C; stage_rc(tid * 16 + i * 8192, R, C); const int Rb = PERM ? ((R & ~31) + perm32(R & 31)) : R;
        voffA[i] = (unsigned)(R * K + C) * 2u; voffB[i] = (unsigned)(Rb * K + C) * 2u; }
    unsigned vc0[2], vc1[2], vn0[2], vn1[2];
#pragma unroll
    for (int i = 0; i < 2; ++i) { vc0[i] = vc1[i] = vn0[i] = vn1[i] = voffA[i]; }
#define PG8_GLOAD(dst0, dst1, u) do { if (GATHER) { const int* gi_ = S.rows(u); int t_ = tid; asm volatile("" : "+v"(t_)); _Pragma("unroll") for (int i = 0; i < 2; ++i) { int R_, C_; stage_rc(t_ * 16 + i * 8192, R_, C_); \
        dst0[i] = (unsigned)gi_[R_] * (unsigned)(K * 2) + (unsigned)(C_ * 2); dst1[i] = (unsigned)gi_[R_ + HALF] * (unsigned)(K * 2) + (unsigned)(C_ * 2); } } } while (0)
    const size_t kstep = (size_t)(BK * 2);
    const size_t hstep = (size_t)HALF * K * 2;
    const size_t tstep = 2 * hstep; const size_t hstepA = GATHER ? 0 : hstep, tstepA = GATHER ? 0 : tstep;
    const unsigned ldsw = (unsigned)wid * 1024u;
    const int aoff = lds_byte(wr * 64 + fr, fq * 8), boff = lds_byte(wc * 32 + fr, fq * 8);
#define PG8_SA(b, h) (((b) * 2 + (h)) * HTB)
#define PG8_SB(b, h) ((4 + (b) * 2 + (h)) * HTB)
#define PG8_STAGE(bufoff, gbase, voff) do { _Pragma("unroll") for (int _i = 0; _i < 2; ++_i) \
        __builtin_amdgcn_global_load_lds((const unsigned*)((const char*)(gbase) + (voff)[_i]), (PG8_LAS unsigned*)(lds + (bufoff) + ldsw + _i * 8192), 16, 0, 0); } while (0)
#define PG8_LDA(dst, b, h) do { _Pragma("unroll") for (int m = 0; m < 4; ++m) _Pragma("unroll") for (int k = 0; k < 2; ++k) dst[m][k] = *(const PG8_LAS bf16x8*)(lds + PG8_SA(b, h) + aoff + m * 2048 + k * 1024); } while (0)
#define PG8_LDB(dst, b, h) do { _Pragma("unroll") for (int n = 0; n < 2; ++n) _Pragma("unroll") for (int k = 0; k < 2; ++k) dst[n][k] = *(const PG8_LAS bf16x8*)(lds + PG8_SB(b, h) + boff + n * 2048 + k * 1024); } while (0)
#define PG8_MMA(ai, bj, At, Bt) do { __builtin_amdgcn_s_setprio(1); _Pragma("unroll") for (int m = 0; m < 4; ++m) _Pragma("unroll") for (int n = 0; n < 2; ++n) _Pragma("unroll") for (int k = 0; k < 2; ++k) \
        acc[ai][bj][m][n] = __builtin_amdgcn_mfma_f32_16x16x32_bf16(Bt[n][k], At[m][k], acc[ai][bj][m][n], 0, 0, 0); __builtin_amdgcn_s_setprio(0); } while (0)
#define PG8_WAIT_V(n) asm volatile("s_waitcnt vmcnt(" #n ")" ::: "memory")
#define PG8_WAIT_L(n) asm volatile("s_waitcnt lgkmcnt(" #n ")" ::: "memory")
#define PG8_BAR __builtin_amdgcn_s_barrier()
#define PG8_SCHED __builtin_amdgcn_sched_barrier(0)
    Unit cur, nxt; int ui = 0;
    if (!S.next(0, cur)) return;
    f32x4 acc[2][2][4][2];
#pragma unroll
    for (int a = 0; a < 2; ++a)
#pragma unroll
        for (int b = 0; b < 2; ++b)
#pragma unroll
            for (int m = 0; m < 4; ++m)
#pragma unroll
                for (int n = 0; n < 2; ++n) acc[a][b][m][n] = (f32x4){0.f, 0.f, 0.f, 0.f};
    bf16x8 At[4][2], B0[2][2], B1[2][2];
    const char* cA = (const char*)g.A + (size_t)cur.pm * tstepA; const char* cB = (const char*)g.Bt + (size_t)cur.pn * tstep;
    S.a_ready(cur); PG8_GLOAD(vc0, vc1, cur);
    if constexpr (SP2) {
        PG8_STAGE(PG8_SB(0, 0), cB, voffB); PG8_STAGE(PG8_SB(0, 1), cB + hstep, voffB); PG8_STAGE(PG8_SA(0, 0), cA, vc0); PG8_STAGE(PG8_SA(0, 1), cA + hstepA, vc1);
        if (wr == 1) PG8_BAR;
        PG8_WAIT_V(2); PG8_BAR;
        PG8_STAGE(PG8_SB(1, 0), cB + kstep, voffB); PG8_STAGE(PG8_SA(1, 0), cA + kstep, vc0); PG8_STAGE(PG8_SB(1, 1), cB + hstep + kstep, voffB);
        PG8_WAIT_V(6); PG8_BAR;
    }
    for (;;) {
        const bool has_next = S.next(ui + 1, nxt);
        const char* nA = has_next ? (const char*)g.A + (size_t)nxt.pm * tstepA : cA; const char* nB = has_next ? (const char*)g.Bt + (size_t)nxt.pn * tstep : cB;
        if (GATHER) { if (has_next) PG8_GLOAD(vn0, vn1, nxt); else { _Pragma("unroll") for (int i = 0; i < 2; ++i) { vn0[i] = vc0[i]; vn1[i] = vc1[i]; } } }
        for (int t = 0; t < nt; t += 2) {
            const bool last = (t == nt - 2);
            unsigned m0[2], m1[2];
#pragma unroll
            for (int i = 0; i < 2; ++i) { m0[i] = (GATHER && last) ? vn0[i] : vc0[i]; m1[i] = (GATHER && last) ? vn1[i] : vc1[i]; }
            const char* a1 = cA + (size_t)(t + 1) * kstep;
            const char* a2 = last ? nA : cA + (size_t)(t + 2) * kstep; const char* b2 = last ? nB : cB + (size_t)(t + 2) * kstep;
            const char* a3 = a2 + kstep; const char* b3 = b2 + kstep;
            if (last && has_next) S.a_ready(nxt);
            if constexpr (SP2) {
            PG8_LDB(B0, 0, 0); PG8_LDB(B1, 0, 1); PG8_SCHED; PG8_LDA(At, 0, 0); PG8_STAGE(PG8_SA(1, 1), a1 + hstepA, vc1);
            PG8_WAIT_V(8); PG8_WAIT_L(0); PG8_BAR; PG8_MMA(0, 0, At, B0); PG8_MMA(0, 1, At, B1); PG8_BAR; PG8_SCHED;
            PG8_LDA(At, 0, 1); PG8_STAGE(PG8_SB(0, 0), b2, voffB); PG8_STAGE(PG8_SB(0, 1), b2 + hstep, voffB); PG8_STAGE(PG8_SA(0, 0), a2, m0);
            PG8_WAIT_V(8); PG8_WAIT_L(0); PG8_BAR; PG8_MMA(1, 0, At, B0); PG8_MMA(1, 1, At, B1); PG8_BAR; PG8_SCHED;
            PG8_LDB(B0, 1, 0); PG8_LDB(B1, 1, 1); PG8_SCHED; PG8_LDA(At, 1, 0); PG8_STAGE(PG8_SA(0, 1), a2 + hstepA, m1);
            PG8_WAIT_V(8); PG8_WAIT_L(0); PG8_BAR; PG8_MMA(0, 0, At, B0); PG8_MMA(0, 1, At, B1); PG8_BAR; PG8_SCHED;
            PG8_LDA(At, 1, 1); PG8_STAGE(PG8_SB(1, 0), b3, voffB); PG8_STAGE(PG8_SB(1, 1), b3 + hstep, voffB); PG8_STAGE(PG8_SA(1, 0), a3, m0);
            PG8_WAIT_V(8); PG8_WAIT_L(0); PG8_BAR; PG8_MMA(1, 0, At, B0); PG8_MMA(1, 1, At, B1); PG8_BAR; PG8_SCHED;
            } else { static_assert(SP2, "only the SP2 loop is kept"); }
        }
        if constexpr (ALIGN_EPI) { if (wr == 0) PG8_BAR; }
        if constexpr (!Epi::AFTER_DRAIN) { E(acc, cur, wr, wc, fr, fq); S.done(cur); }
        if (!has_next) break;
#pragma unroll
        for (int a = 0; a < 2; ++a)
#pragma unroll
            for (int b = 0; b < 2; ++b)
#pragma unroll
                for (int m = 0; m < 4; ++m)
#pragma unroll
                    for (int n = 0; n < 2; ++n) acc[a][b][m][n] = (f32x4){0.f, 0.f, 0.f, 0.f};
        cur = nxt; cA = nA; cB = nB; ++ui;
#pragma unroll
        for (int i = 0; i < 2; ++i) { vc0[i] = vn0[i]; vc1[i] = vn1[i]; }
        if constexpr (ALIGN_EPI) { if (wr == 1) PG8_BAR; }
    }
    PG8_WAIT_V(0);
    if constexpr (!ALIGN_EPI) { if (wr == 0) PG8_BAR; }
    PG8_BAR;
    if constexpr (Epi::AFTER_DRAIN) { E.fused(acc, cur, wr, wc, fr, fq, lds, wid, lane); S.done(cur); }
#undef PG8_GLOAD
#undef PG8_SA
#undef PG8_SB
#undef PG8_STAGE
#undef PG8_LDA
#undef PG8_LDB
#undef PG8_MMA
#undef PG8_WAIT_V
#undef PG8_WAIT_L
#undef PG8_BAR
#undef PG8_SCHED
}
}

typedef pg8::f32x4 f32x4; typedef pg8::u32x4 u32x4; typedef pg8::Unit Unit;
typedef float f32x16 __attribute__((ext_vector_type(16)));
typedef short bf16x8 __attribute__((ext_vector_type(8)));
typedef unsigned u32x2 __attribute__((ext_vector_type(2)));

struct EpiZ { static constexpr bool PERM = true, AFTER_DRAIN = false;
    bf16_t* Z; const float* rope; unsigned char* qkv;
    __device__ __forceinline__ void operator()(const f32x4 (&acc)[2][2][4][2], const Unit& u, int wr, int wc, int fr, int fq) const {
        const int row0 = u.pm * 256 + wr * 64 + fr, col0 = u.pn * 256 + wc * 32 + 8 * fq, pn = u.pn;
        const int type = (pn == 4 || pn == 5) ? 1 : (pn == 10 || pn == 11) ? 2 : (pn >= 12 && pn < 16) ? 3 : (pn >= 16) ? 4 : 0;
        const int colhalf = wc & 1; const float* rc = rope + (colhalf ? 8192 : 0) + 8 * (fq & 1); const float* rs = rc + (colhalf ? 1024 : 4096);
#pragma unroll
        for (int ai = 0; ai < 2; ++ai)
#pragma unroll
            for (int m = 0; m < 4; ++m) { const int row = row0 + ai * 128 + m * 16;
                const int cq = (pn & 1) * 256 + wc * 32 + 8 * fq;
                bf16_t* rowp; size_t bjstep = 128;
                if (type == 1 || type == 2 || pn == 6 || pn == 7) { const int sel = type == 2 ? 0 : type == 1 ? 1 : 2; bf16_t* hb = (bf16_t*)(qkv + (size_t)sel * QKV_STRIDE); rowp = hb + (size_t)(cq >> 7) * HB + (size_t)row * 128 + (cq & 127); bjstep = HB; }
                else { const int zc = pn < 4 ? pn * 256 : pn < 10 ? ZQA + (pn - 8) * 256 : pn < 16 ? ZU + (pn - 12) * 256 : ZG + (pn - 16) * 256; rowp = Z + (size_t)row * PROJZ + zc + wc * 32 + 8 * fq; }
                float cs[8], sn[8];
                if (type == 1 || type == 2) { const int pos = colhalf ? (row & 63) : (row >> 6);
                    const f32x4 c0 = *(const f32x4*)(rc + pos * 16), c1 = *(const f32x4*)(rc + pos * 16 + 4), s0 = *(const f32x4*)(rs + pos * 16), s1 = *(const f32x4*)(rs + pos * 16 + 4);
#pragma unroll
                    for (int e = 0; e < 4; ++e) { cs[e] = c0[e]; cs[4 + e] = c1[e]; sn[e] = fq < 2 ? -s0[e] : s0[e]; sn[4 + e] = fq < 2 ? -s1[e] : s1[e]; } }
#pragma unroll
                for (int bj = 0; bj < 2; ++bj) { float v[8];
#pragma unroll
                    for (int e = 0; e < 4; ++e) { v[e] = acc[ai][bj][m][0][e]; v[4 + e] = acc[ai][bj][m][1][e]; }
                    if (type == 1 || type == 2) { const float sc = type == 2 ? C2 : 1.f;
#pragma unroll
                        for (int e = 0; e < 8; ++e) { const float p = __shfl_xor(v[e], 32); v[e] = (v[e] * cs[e] + p * sn[e]) * sc; } }
                    else if (type == 3) {
#pragma unroll
                        for (int e = 0; e < 8; ++e) v[e] = gelu_tanh(v[e]); }
                    else if (type == 4) {
#pragma unroll
                        for (int e = 0; e < 8; ++e) v[e] = sigmoidf_(v[e]); }
                    u32x4 w; w.x = pk2(v[0], v[1]); w.y = pk2(v[2], v[3]); w.z = pk2(v[4], v[5]); w.w = pk2(v[6], v[7]);
                    *(u32x4*)(rowp + bj * bjstep) = w; } }
    }
};
__device__ __forceinline__ void unpack8(const u32x4 w, float (&f)[8]) {
    f[0] = __uint_as_float(w.x << 16); f[1] = __uint_as_float(w.x & 0xffff0000u); f[2] = __uint_as_float(w.y << 16); f[3] = __uint_as_float(w.y & 0xffff0000u);
    f[4] = __uint_as_float(w.z << 16); f[5] = __uint_as_float(w.z & 0xffff0000u); f[6] = __uint_as_float(w.w << 16); f[7] = __uint_as_float(w.w & 0xffff0000u);
}
struct EpiMerge { static constexpr bool PERM = true, AFTER_DRAIN = false;
    bf16_t* Mb; const bf16_t* Z;
    __device__ __forceinline__ void operator()(const f32x4 (&acc)[2][2][4][2], const Unit& u, int wr, int wc, int fr, int fq) const {
        const int j = u.pn >> 2, pm = u.pm - 65 * j, pn = u.pn & 3;
        const int row0 = pm * 256 + wr * 64 + fr, col0 = pn * 256 + wc * 32 + 8 * fq;
#pragma unroll
        for (int ai = 0; ai < 2; ++ai)
#pragma unroll
            for (int m = 0; m < 4; ++m) { const int row = row0 + ai * 128 + m * 16;
#pragma unroll
                for (int bj = 0; bj < 2; ++bj) { const int col = col0 + bj * 128; bf16_t* mp = Mb + (size_t)row * D + col;
                    float g[8], p[8]; unpack8(*(const u32x4*)(Z + (size_t)row * PROJZ + ZG + j * 1024 + col), g);
                    if (j > 0) unpack8(*(const u32x4*)mp, p); else {
#pragma unroll
                        for (int e = 0; e < 8; ++e) p[e] = 0.f; }
                    float v[8];
#pragma unroll
                    for (int e = 0; e < 4; ++e) { v[e] = p[e] + g[e] * acc[ai][bj][m][0][e]; v[4 + e] = p[4 + e] + g[4 + e] * acc[ai][bj][m][1][e]; }
                    u32x4 w; w.x = pk2(v[0], v[1]); w.y = pk2(v[2], v[3]); w.z = pk2(v[4], v[5]); w.w = pk2(v[6], v[7]);
                    *(u32x4*)mp = w; } }
    }
};
struct EpiResid { static constexpr bool PERM = false, AFTER_DRAIN = false;
    const float* xold; float* xnew; const float* gt;
    __device__ __forceinline__ void operator()(const f32x4 (&acc)[2][2][4][2], const Unit& u, int wr, int wc, int fr, int fq) const {
        const int row0 = u.pm * 256 + wr * 64 + fr, col0 = u.pn * 256 + wc * 32 + 4 * fq;
        f32x4 gv[2][2];
#pragma unroll
        for (int bj = 0; bj < 2; ++bj)
#pragma unroll
            for (int n = 0; n < 2; ++n) gv[bj][n] = *(const f32x4*)(gt + col0 + bj * 128 + n * 16);
#pragma unroll
        for (int ai = 0; ai < 2; ++ai)
#pragma unroll
            for (int m = 0; m < 4; ++m) { const size_t off = (size_t)(row0 + ai * 128 + m * 16) * D + col0;
#pragma unroll
                for (int bj = 0; bj < 2; ++bj)
#pragma unroll
                    for (int n = 0; n < 2; ++n) { const f32x4 xo = *(const f32x4*)(xold + off + bj * 128 + n * 16); *(f32x4*)(xnew + off + bj * 128 + n * 16) = xo + gv[bj][n] * acc[ai][bj][m][n]; } }
    }
};
struct EpiHid { static constexpr bool PERM = true, AFTER_DRAIN = false;
    bf16_t* HID;
    __device__ __forceinline__ void operator()(const f32x4 (&acc)[2][2][4][2], const Unit& u, int wr, int wc, int fr, int fq) const {
        const int row0 = u.pm * 256 + wr * 64 + fr, col0 = (u.pn & 7) * 128 + wc * 32 + 8 * fq;
#pragma unroll
        for (int ai = 0; ai < 2; ++ai)
#pragma unroll
            for (int m = 0; m < 4; ++m) { float v[8];
#pragma unroll
                for (int e = 0; e < 4; ++e) { v[e] = siluf_(acc[ai][0][m][0][e]) * acc[ai][1][m][0][e]; v[4 + e] = siluf_(acc[ai][0][m][1][e]) * acc[ai][1][m][1][e]; }
                u32x4 w; w.x = pk2(v[0], v[1]); w.y = pk2(v[2], v[3]); w.z = pk2(v[4], v[5]); w.w = pk2(v[6], v[7]);
                *(u32x4*)(HID + (size_t)(row0 + ai * 128 + m * 16) * FF + col0) = w; }
    }
};
struct EpiYe { static constexpr bool PERM = true, AFTER_DRAIN = false;
    bf16_t* YE; const float* gate;
    __device__ __forceinline__ void operator()(const f32x4 (&acc)[2][2][4][2], const Unit& u, int wr, int wc, int fr, int fq) const {
        const int row0 = u.pm * 256 + wr * 64 + fr, col0 = (u.pn & 3) * 256 + wc * 32 + 8 * fq;
#pragma unroll
        for (int ai = 0; ai < 2; ++ai)
#pragma unroll
            for (int m = 0; m < 4; ++m) { const int row = row0 + ai * 128 + m * 16; const float gsc = gate[row];
#pragma unroll
                for (int bj = 0; bj < 2; ++bj) { const f32x4 a = acc[ai][bj][m][0] * gsc, b = acc[ai][bj][m][1] * gsc;
                    u32x4 w; w.x = pk2(a[0], a[1]); w.y = pk2(a[2], a[3]); w.z = pk2(b[0], b[1]); w.w = pk2(b[2], b[3]);
                    *(u32x4*)(YE + (size_t)row * D + col0 + bj * 128) = w; } }
    }
};
struct UEpi { static constexpr bool AFTER_DRAIN = false; int kind, l; unsigned char* ws; float* out; const float* xold;
    __device__ __forceinline__ void operator()(const f32x4 (&acc)[2][2][4][2], const Unit& u, int wr, int wc, int fr, int fq) const {
        asm volatile("" : "+v"(fr), "+v"(fq));
        unsigned char* ws = this->ws; float* out = this->out; const float* xold = this->xold; asm volatile("" : "+s"(ws), "+s"(out), "+s"(xold));
        if (kind == K_G1) { const EpiZ e{(bf16_t*)(ws + WS_Z), (const float*)(ws + OFF_ROPE), ws + WS_QB}; e(acc, u, wr, wc, fr, fq); }
        else if (kind == K_M1) { const EpiMerge e{(bf16_t*)(ws + WS_H), (const bf16_t*)(ws + WS_Z)}; e(acc, u, wr, wc, fr, fq); }
        else if (kind == K_M2) { const EpiResid e{xold, out, (const float*)(ws + OFF_MOD) + (size_t)l * 2 * 6144 + 2048}; e(acc, u, wr, wc, fr, fq); }
        else if (kind == K_E1) { const EpiHid e{(bf16_t*)(ws + WS_Z + ZO_HID)}; e(acc, u, wr, wc, fr, fq); }
        else { const EpiYe e{(bf16_t*)(ws + WS_Z + ZO_YE), (const float*)(ws + OFF_GATE)}; e(acc, u, wr, wc, fr, fq); }
    }
};
struct USched { int kind, c, G; const int* idx;
    __device__ __forceinline__ void a_ready(const Unit&) const {} __device__ __forceinline__ void done(const Unit&) const {}
    __device__ __forceinline__ const int* rows(const Unit& u) const { return idx + u.pm * 256; }
    __device__ __forceinline__ bool next(int i, Unit& u) const {
        if (kind == K_G1) {
            constexpr int nM = L / 256, nN = PROJ / 256, nwg = nM * nN; const long Lx = (long)i * G + c; if (Lx >= nwg) return false;
            int wgid = (int)Lx; { const int q = nwg / 8, r = nwg % 8, xcd = wgid % 8, off = wgid / 8; wgid = (xcd < r ? xcd * (q + 1) : r * (q + 1) + (xcd - r) * q) + off; }
            const int nig = 8 * nN, gid = wgid / nig, fm = gid * 8, gsz = (nM - fm) < 8 ? (nM - fm) : 8; u.pm = fm + ((wgid % nig) % gsz); u.pn = (wgid % nig) / gsz; return true; }
        if (kind == K_M1) { const int rnd = i / 3, j = i - 3 * rnd; const int t = rnd * G + c; if (t >= 256) return false;
            const int T = (t & 7) * 32 + (t >> 3); u.pm = 65 * j + (T >> 2); u.pn = 4 * j + (T & 3); return true; }
        if (kind == K_M2) { const int t = i * G + c; if (t >= 256) return false; const int T = (t & 7) * 32 + (t >> 3); u.pm = T >> 2; u.pn = T & 3; return true; }
        if (kind == K_E1) { const int t = i * G + c; if (t >= 1024) return false; const int x = t & 7, q = t >> 3;
            const int e = 2 * x + (q >> 6), ui = q & 63; u.pm = 9 * e + (ui >> 3); u.pn = 8 * e + (ui & 7); return true; }
        { const int t = i * G + c; if (t >= 512) return false; const int x = t & 7, q = t >> 3;
            const int e = 2 * x + (q >> 5), ui = q & 31; u.pm = 9 * e + (ui >> 2); u.pn = 4 * e + (ui & 3); return true; }
    }
};

template <int NB>
__device__ __forceinline__ void wgemm_tile(const bf16_t* arow, const bf16_t* brow0, const bf16_t* brow1, int K, f32x16 (&acc)[NB]) {
#pragma unroll
    for (int b = 0; b < NB; ++b)
#pragma unroll
        for (int i = 0; i < 16; ++i) acc[b][i] = 0.f;
#pragma unroll 4
    for (int k0 = 0; k0 < K; k0 += 16) {
        const bf16x8 a = *(const bf16x8*)(arow + k0); const bf16x8 b0 = *(const bf16x8*)(brow0 + k0);
        acc[0] = __builtin_amdgcn_mfma_f32_32x32x16_bf16(b0, a, acc[0], 0, 0, 0);
        if constexpr (NB == 2) { const bf16x8 b1 = *(const bf16x8*)(brow1 + k0); acc[1] = __builtin_amdgcn_mfma_f32_32x32x16_bf16(b1, a, acc[1], 0, 0, 0); }
    }
}


#define GAS __attribute__((address_space(1)))
#define LAS __attribute__((address_space(3)))
typedef GAS unsigned gu32;
#define RLX_AGENT __ATOMIC_RELAXED, __HIP_MEMORY_SCOPE_AGENT
#define LDS_WAIT() asm volatile("s_waitcnt lgkmcnt(0)" ::: "memory")
#define VM_WAIT() asm volatile("s_waitcnt vmcnt(0)" ::: "memory")
#define XB_TMO      128
#define XB_XCNT(j)  (256  + 64 * (j))
#define XB_XSUB(j)  (1280 + 64 * (j))
#define XB_XGEN(j)  (2304 + 64 * (j))
#define XB_TOP      3328
#define XB_TOPGEN   3392
#define XCD_BAR_WORDS 3456
#define XB_SPIN_CAP (1u << 24)

__device__ __forceinline__ unsigned xb_ld(unsigned* p)              { return __hip_atomic_load(p, __ATOMIC_RELAXED, __HIP_MEMORY_SCOPE_AGENT); }
__device__ __forceinline__ unsigned xb_add(unsigned* p, unsigned v) { return __hip_atomic_fetch_add(p, v, __ATOMIC_RELAXED, __HIP_MEMORY_SCOPE_AGENT); }
__device__ __forceinline__ unsigned xb_xcc_id() { return (unsigned)__builtin_amdgcn_s_getreg((3 << 11) | 20) & 0xFu; }
#define XB_SPIN(cond, bar) do { unsigned _sp = 0; while (cond) { __builtin_amdgcn_s_sleep(1); \
    if ((++_sp & 255u) == 0u) { if (xb_ld(&(bar)[XB_TMO])) break; if (_sp > XB_SPIN_CAP) { atomicAdd(&(bar)[XB_TMO], 1u); break; } } } } while (0)

struct XcdBarrier {
    unsigned* bar; unsigned x;
    volatile LAS unsigned* st;
};

__device__ __forceinline__ XcdBarrier xcd_barrier_post(unsigned* bar, volatile LAS unsigned* st) {
    XcdBarrier b; b.bar = bar; b.x = xb_xcc_id(); b.st = st;
    if (threadIdx.x == 0) (void)xb_add(&bar[XB_XCNT(b.x)], 1u);
    return b;
}
__device__ __forceinline__ void xcd_barrier_complete(unsigned* bar, unsigned x, unsigned& nloc, unsigned& nx) {
    const unsigned G = gridDim.x * gridDim.y * gridDim.z;
    unsigned sum, cnt, mine, sp = 0u;
    for (;;) {
        sum = 0u; cnt = 0u; mine = 0u;
#pragma unroll
        for (unsigned j = 0; j < 16; ++j) { const unsigned c = xb_ld(&bar[XB_XCNT(j)]); sum += c; cnt += (c > 0u) ? 1u : 0u; mine = (j == x) ? c : mine; }
        if (sum == G) break;
        __builtin_amdgcn_s_sleep(1);
        if ((++sp & 255u) == 0u) { if (xb_ld(&bar[XB_TMO])) break; if (sp > XB_SPIN_CAP) { atomicAdd(&bar[XB_TMO], 1u); break; } }
    }
    nloc = mine > 0u ? mine : 1u; nx = cnt > 0u ? cnt : 1u;
}

__device__ __forceinline__ void xcd_barrier(const XcdBarrier& b, const int tid) {
    asm volatile("s_waitcnt vmcnt(0)" ::: "memory");
    __syncthreads();
    if (tid == 0) {
        unsigned* bar = b.bar;
        __builtin_amdgcn_s_waitcnt(0);
        unsigned nloc = b.st[0], nx = b.st[1];
        if (nloc == 0u) { xcd_barrier_complete(bar, b.x, nloc, nx); b.st[0] = nloc; b.st[1] = nx; }
        const unsigned old = xb_add(&bar[XB_XSUB(b.x)], 1u);
        const unsigned gen = old / nloc;
        if (old + 1u == (gen + 1u) * nloc) {
            __builtin_amdgcn_fence(__ATOMIC_RELEASE, "agent");
            asm volatile("s_waitcnt vmcnt(0)" ::: "memory");
            const unsigned og = xb_add(&bar[XB_TOP], 1u);
            const unsigned tg = og / nx;
            if (og + 1u == (tg + 1u) * nx) xb_add(&bar[XB_TOPGEN], 1u);
            else XB_SPIN(xb_ld(&bar[XB_TOPGEN]) == tg, bar);
            __builtin_amdgcn_fence(__ATOMIC_ACQUIRE, "agent");
            xb_add(&bar[XB_XGEN(b.x)], 1u);
            asm volatile("s_waitcnt vmcnt(0)" ::: "memory");
        } else {
            XB_SPIN(xb_ld(&bar[XB_XGEN(b.x)]) == gen, bar);
            __builtin_amdgcn_fence(__ATOMIC_ACQUIRE, "agent");
            asm volatile("s_waitcnt vmcnt(0)" ::: "memory");
        }
    }
    __syncthreads();
}


namespace da {
typedef short s16x4 __attribute__((ext_vector_type(4)));
constexpr int STAGE = 32768, NST = 3, WSF_OFF = NST * STAGE;
constexpr float THR = 8.f;
__device__ __forceinline__ int crow(int r, int hi) { return (r & 3) + 8 * (r >> 2) + 4 * hi; }
__device__ __forceinline__ s16x4 vtr(const LAS unsigned char* p) { return __builtin_bit_cast(s16x4, __builtin_amdgcn_ds_read_tr16_b64_v4i16((LAS s16x4*)p)); }
__device__ __forceinline__ float max3f(float a, float b, float c) { return fmaxf(fmaxf(a, b), c); }
__device__ __forceinline__ unsigned cvtpk(float lo, float hi) { typedef float f2 __attribute__((ext_vector_type(2))); typedef __bf16 b2 __attribute__((ext_vector_type(2))); f2 v = {lo, hi}; b2 b = __builtin_convertvector(v, b2); return __builtin_bit_cast(unsigned, b); }

__device__ __forceinline__ void issue_tile(LAS unsigned char* lds, const bf16_t* Kh, const bf16_t* Vh, int key0, int stage, int wave, int lane) {
#pragma unroll
    for (int i = 0; i < 2; ++i) { const int p = 2 * wave + i, c = p >> 3, j = p & 7;
        __builtin_amdgcn_global_load_lds((const unsigned*)(Kh + (size_t)(key0 + lane) * 128 + c * 64 + j * 8), (LAS unsigned*)(lds + stage * STAGE + p * 1024), 16, 0, 0); }
#pragma unroll
    for (int i = 0; i < 2; ++i) { const int p = 2 * wave + i, db = p >> 2, kg = p & 3;
        __builtin_amdgcn_global_load_lds((const unsigned*)(Vh + (size_t)(key0 + 16 * kg + (lane >> 2)) * 128 + db * 32 + (lane & 3) * 8), (LAS unsigned*)(lds + stage * STAGE + 16384 + p * 1024), 16, 0, 0); }
}
__device__ __forceinline__ void qkt(f32x16& p0, f32x16& p1, const LAS unsigned char* kb, const bf16x8 (&qf)[4]) {
#pragma unroll
    for (int i = 0; i < 16; ++i) { p0[i] = 0.f; p1[i] = 0.f; }
#pragma unroll
    for (int d0 = 0; d0 < 4; ++d0) { const bf16x8 b0 = *(const LAS bf16x8*)(kb + d0 * 2048), b1 = *(const LAS bf16x8*)(kb + d0 * 2048 + 512);
        p0 = __builtin_amdgcn_mfma_f32_32x32x16_bf16(b0, qf[d0], p0, 0, 0, 0); p1 = __builtin_amdgcn_mfma_f32_32x32x16_bf16(b1, qf[d0], p1, 0, 0, 0); }
}
__device__ __forceinline__ void pv(f32x16 (&o)[4], const LAS unsigned char* vp, const bf16x8 (&pa)[4]) {
#pragma unroll
    for (int d0 = 0; d0 < 4; ++d0)
#pragma unroll
        for (int ks = 0; ks < 4; ++ks) { const s16x4 lo = vtr(vp + d0 * 4096 + ks * 1024), h8 = vtr(vp + d0 * 4096 + ks * 1024 + 512);
            const bf16x8 vf = {lo[0], lo[1], lo[2], lo[3], h8[0], h8[1], h8[2], h8[3]};
            o[d0] = __builtin_amdgcn_mfma_f32_32x32x16_bf16(pa[ks], vf, o[d0], 0, 0, 0); }
}
__device__ __forceinline__ void softmax_tile(f32x16& p0, f32x16& p1, float& mhat, float& lsum, f32x16 (&o)[4], LAS float* wsf, int r32, int hi, bf16x8 (&pa)[4]) {
    float a = max3f(p0[0], p0[1], p1[0]), b = max3f(p0[2], p0[3], p1[1]); a = max3f(a, p1[2], p1[3]);
#pragma unroll
    for (int r = 4; r < 16; r += 4) { a = max3f(a, p0[r], p0[r + 1]); b = max3f(b, p0[r + 2], p0[r + 3]); a = max3f(a, p1[r], p1[r + 1]); b = max3f(b, p1[r + 2], p1[r + 3]); }
    float rm = fmaxf(a, b);
    { const auto rr = __builtin_amdgcn_permlane32_swap(__float_as_uint(rm), __float_as_uint(rm), false, false); rm = fmaxf(__uint_as_float(rr[0]), __uint_as_float(rr[1])); }
    if (__any(rm > mhat + THR)) {
        const float nm = fmaxf(mhat, rm), f = __builtin_amdgcn_exp2f(mhat - nm); lsum *= f; mhat = nm;
        if (hi == 0) wsf[r32] = f;
#pragma unroll
        for (int g = 0; g < 4; ++g) { const f32x4 fr = *(const LAS f32x4*)(wsf + 8 * g + 4 * hi);
#pragma unroll
            for (int i = 0; i < 4; ++i)
#pragma unroll
                for (int d0 = 0; d0 < 4; ++d0) o[d0][4 * g + i] *= fr[i]; }
    }
    float s0 = 0.f, s1 = 0.f;
#pragma unroll
    for (int r = 0; r < 16; ++r) { p0[r] = __builtin_amdgcn_exp2f(p0[r] - mhat); p1[r] = __builtin_amdgcn_exp2f(p1[r] - mhat); s0 += p0[r]; s1 += p1[r]; }
    lsum += s0 + s1;
    u32x4 w;
    w.x = cvtpk(p0[0], p0[1]); w.y = cvtpk(p0[2], p0[3]); w.z = cvtpk(p0[4], p0[5]); w.w = cvtpk(p0[6], p0[7]); pa[0] = __builtin_bit_cast(bf16x8, w);
    w.x = cvtpk(p0[8], p0[9]); w.y = cvtpk(p0[10], p0[11]); w.z = cvtpk(p0[12], p0[13]); w.w = cvtpk(p0[14], p0[15]); pa[1] = __builtin_bit_cast(bf16x8, w);
    w.x = cvtpk(p1[0], p1[1]); w.y = cvtpk(p1[2], p1[3]); w.z = cvtpk(p1[4], p1[5]); w.w = cvtpk(p1[6], p1[7]); pa[2] = __builtin_bit_cast(bf16x8, w);
    w.x = cvtpk(p1[8], p1[9]); w.y = cvtpk(p1[10], p1[11]); w.z = cvtpk(p1[12], p1[13]); w.w = cvtpk(p1[14], p1[15]); pa[3] = __builtin_bit_cast(bf16x8, w);
}
#define DA_SYNC() do { asm volatile("s_waitcnt vmcnt(0) lgkmcnt(0)" ::: "memory"); __builtin_amdgcn_s_barrier(); asm volatile("" ::: "memory"); } while (0)
__device__ __forceinline__ void unit(LAS unsigned char* lds, const bf16_t* QBh, const bf16_t* KBh, const bf16_t* VBh, int q0, int kbase, int NT, float lam, const float* subg, float oscale, bf16_t* Yh, int wave, int lane) {
    const int c = wave >> 2, s = wave & 3, r32 = lane & 31, hi = lane >> 5;
    LAS float* wsf = (LAS float*)(lds + WSF_OFF) + wave * 64;
    issue_tile(lds, KBh, VBh, kbase, 0, wave, lane);
    if (NT > 1) issue_tile(lds, KBh, VBh, kbase + 64, 1, wave, lane);
    bf16x8 qf[4];
#pragma unroll
    for (int d0 = 0; d0 < 4; ++d0) qf[d0] = *(const bf16x8*)(QBh + (size_t)(q0 + s * 32 + r32) * 128 + c * 64 + d0 * 16 + hi * 8);
    f32x16 o[4];
#pragma unroll
    for (int d0 = 0; d0 < 4; ++d0)
#pragma unroll
        for (int i = 0; i < 16; ++i) o[d0][i] = 0.f;
    float mhat = -1e30f, lsum = 0.f;
    const int koff = c * 8192 + hi * 1024 + r32 * 16, voff = 16384 + ((lane >> 4) & 1) * 32 + (lane & 3) * 8 + (4 * hi + ((lane & 15) >> 2)) * 64;
    DA_SYNC();
    f32x16 pa0, pa1, pb0, pb1; bf16x8 pa[4];
    qkt(pa0, pa1, lds + koff, qf);
    int st = 0;
    for (int t = 0; t < NT; t += 2) {
        { if (t > 0) DA_SYNC();
          const int st1 = st == 2 ? 0 : st + 1, st2 = st1 == 2 ? 0 : st1 + 1;
          if (t + 2 < NT) issue_tile(lds, KBh, VBh, kbase + (t + 2) * 64, st2, wave, lane);
          if (t + 1 < NT) qkt(pb0, pb1, lds + st1 * STAGE + koff, qf);
          softmax_tile(pa0, pa1, mhat, lsum, o, wsf, r32, hi, pa);
          pv(o, lds + st * STAGE + voff, pa); st = st1; }
        if (t + 1 >= NT) break;
        { DA_SYNC();
          const int st1 = st == 2 ? 0 : st + 1, st2 = st1 == 2 ? 0 : st1 + 1;
          if (t + 3 < NT) issue_tile(lds, KBh, VBh, kbase + (t + 3) * 64, st2, wave, lane);
          if (t + 2 < NT) qkt(pa0, pa1, lds + st1 * STAGE + koff, qf);
          softmax_tile(pb0, pb1, mhat, lsum, o, wsf, r32, hi, pa);
          pv(o, lds + st * STAGE + voff, pa); st = st1; }
    }
    { const auto rr = __builtin_amdgcn_permlane32_swap(__float_as_uint(lsum), __float_as_uint(lsum), false, false); lsum = __uint_as_float(rr[0]) + __uint_as_float(rr[1]); }
    if (hi == 0) wsf[r32] = 1.f / lsum;
#pragma unroll
    for (int g = 0; g < 4; ++g) { const f32x4 fr = *(const LAS f32x4*)(wsf + 8 * g + 4 * hi);
#pragma unroll
        for (int i = 0; i < 4; ++i)
#pragma unroll
            for (int d0 = 0; d0 < 4; ++d0) o[d0][4 * g + i] *= fr[i]; }
    DA_SYNC();
    LAS float* X = (LAS float*)lds + s * 4096;
    if (c == 1) {
#pragma unroll
        for (int d0 = 0; d0 < 4; ++d0)
#pragma unroll
            for (int i = 0; i < 16; ++i) X[(d0 * 16 + i) * 64 + lane] = o[d0][i]; }
    DA_SYNC();
    if (c == 0) {
        float ss[16];
#pragma unroll
        for (int i = 0; i < 16; ++i) ss[i] = 0.f;
#pragma unroll
        for (int d0 = 0; d0 < 4; ++d0)
#pragma unroll
            for (int i = 0; i < 16; ++i) { const float d = o[d0][i] - lam * X[(d0 * 16 + i) * 64 + lane]; o[d0][i] = d; ss[i] += d * d; }
#pragma unroll
        for (int i = 0; i < 16; ++i) { float v = ss[i]; v += __shfl_xor(v, 1); v += __shfl_xor(v, 2); v += __shfl_xor(v, 4); v += __shfl_xor(v, 8); v += __shfl_xor(v, 16); ss[i] = rsqrtf(v * (1.f / 128.f) + EPS) * oscale; }
        float gsub[4];
#pragma unroll
        for (int d0 = 0; d0 < 4; ++d0) gsub[d0] = subg[d0 * 32 + r32];
#pragma unroll
        for (int i = 0; i < 16; ++i) { bf16_t* yr = Yh + (size_t)(q0 + s * 32 + crow(i, hi)) * 512 + r32;
#pragma unroll
            for (int d0 = 0; d0 < 4; ++d0) yr[d0 * 32] = f2bf(o[d0][i] * ss[i] * gsub[d0]); }
    }
    DA_SYNC();
}
}


namespace na {
using da::crow; using da::vtr; using da::cvtpk; using da::s16x4;
constexpr int NA_OFF = 132096, NA_WS = 2304;
constexpr float LOG2E = 1.4426950408889634f;
__device__ __forceinline__ void issue(LAS unsigned char* wl, const bf16_t* Zk  , const bf16_t* Zv, int lane) {
#pragma unroll
    for (int j = 0; j < 8; ++j) __builtin_amdgcn_global_load_lds((const unsigned*)(Zk + (size_t)lane * PROJZ + j * 8), (LAS unsigned*)(wl + j * 1024), 16, 0, 0);
#pragma unroll
    for (int p = 0; p < 8; ++p) { const int dh = p >> 2, kg = p & 3;
        __builtin_amdgcn_global_load_lds((const unsigned*)(Zv + (size_t)(16 * kg + (lane >> 2)) * PROJZ + dh * 32 + (lane & 3) * 8), (LAS unsigned*)(wl + 8192 + p * 1024), 16, 0, 0); }
}
__device__ __forceinline__ void unit(LAS unsigned char* lds, const bf16_t* Z, const float* rpb_h, int qrow0, int r, int h, bf16_t* Yh, int wave, int lane) {
    const int r32 = lane & 31, hi = lane >> 5;
    LAS unsigned char* wl = lds + wave * 16384;
    LAS float* bias2 = (LAS float*)(lds + NA_OFF + wave * NA_WS); LAS float* wsf = bias2 + 480;
    int r0 = 0;
    if (r >= 0) { r0 = r - 4; r0 = r0 < 0 ? 0 : (r0 > 248 ? 248 : r0);
        for (int i = lane; i < 480; i += 64) { const int dr = i >> 5, dc = i & 31; bias2[i] = dc < 31 ? rpb_h[dr * 31 + dc] * LOG2E : 0.f; } }
    const LAS unsigned char* kb = wl + hi * 1024 + r32 * 16; const LAS unsigned char* vp = wl + 8192 + ((lane >> 4) & 1) * 32 + (lane & 3) * 8 + (4 * hi + ((lane & 15) >> 2)) * 64;
    const int nt = r >= 0 ? 12 : 4;
#pragma unroll 1
    for (int qb = 0; qb < 2; ++qb) {
        bf16x8 qf[4];
#pragma unroll
        for (int d0 = 0; d0 < 4; ++d0) qf[d0] = *(const bf16x8*)(Z + (size_t)(qrow0 + 32 * qb + r32) * PROJZ + ZQA + h * 64 + d0 * 16 + hi * 8);
        f32x16 o[2]; float m = -1e30f, l = 0.f;
#pragma unroll
        for (int d0 = 0; d0 < 2; ++d0)
#pragma unroll
            for (int i = 0; i < 16; ++i) o[d0][i] = 0.f;
        const int qc = 32 * qb + r32; int c0 = qc - 8; c0 = c0 < 0 ? 0 : (c0 > 48 ? 48 : c0);
#pragma unroll 1
        for (int t = 0; t < nt; ++t) {
            const int krow0 = t < 4 ? L + 64 * t : (r0 + t - 4) * 64;
            asm volatile("s_waitcnt lgkmcnt(0)" ::: "memory");
            issue(wl, Z + (size_t)krow0 * PROJZ + ZKA + h * 64, Z + (size_t)krow0 * PROJZ + ZVA + h * 64, lane);
            asm volatile("s_waitcnt vmcnt(0)" ::: "memory");
            const int drow = t < 4 ? 0 : (r0 + t - 4 - r + 7) * 32;
            f32x16 p0, p1;
#pragma unroll
            for (int i = 0; i < 16; ++i) { p0[i] = 0.f; p1[i] = 0.f; }
#pragma unroll
            for (int d0 = 0; d0 < 4; ++d0) { const bf16x8 b0 = *(const LAS bf16x8*)(kb + d0 * 2048), b1 = *(const LAS bf16x8*)(kb + d0 * 2048 + 512);
                p0 = __builtin_amdgcn_mfma_f32_32x32x16_bf16(b0, qf[d0], p0, 0, 0, 0); p1 = __builtin_amdgcn_mfma_f32_32x32x16_bf16(b1, qf[d0], p1, 0, 0, 0); }
            if (t < 4) {
#pragma unroll
                for (int i = 0; i < 16; ++i) { p0[i] *= C2; p1[i] *= C2; }
            } else {
#pragma unroll
                for (int i = 0; i < 16; ++i) { const int k0 = crow(i, hi), k1 = k0 + 32;
                    const float b0v = bias2[drow + ((k0 - qc + 15) & 31)], b1v = bias2[drow + ((k1 - qc + 15) & 31)];
                    p0[i] = (k0 >= c0 && k0 < c0 + 16) ? p0[i] * C2 + b0v : -1e30f; p1[i] = (k1 >= c0 && k1 < c0 + 16) ? p1[i] * C2 + b1v : -1e30f; } }
            float rm = -1e30f;
#pragma unroll
            for (int i = 0; i < 16; ++i) rm = fmaxf(rm, fmaxf(p0[i], p1[i]));
            { const auto rr = __builtin_amdgcn_permlane32_swap(__float_as_uint(rm), __float_as_uint(rm), false, false); rm = fmaxf(__uint_as_float(rr[0]), __uint_as_float(rr[1])); }
            const float nm = fmaxf(m, rm), f = __builtin_amdgcn_exp2f(m - nm); m = nm; l *= f;
            if (hi == 0) wsf[r32] = f;
            float sum = 0.f;
#pragma unroll
            for (int i = 0; i < 16; ++i) { p0[i] = __builtin_amdgcn_exp2f(p0[i] - nm); p1[i] = __builtin_amdgcn_exp2f(p1[i] - nm); sum += p0[i] + p1[i]; }
            l += sum;
#pragma unroll
            for (int g = 0; g < 4; ++g) { const f32x4 fr = *(const LAS f32x4*)(wsf + 8 * g + 4 * hi);
#pragma unroll
                for (int i = 0; i < 4; ++i) { o[0][4 * g + i] *= fr[i]; o[1][4 * g + i] *= fr[i]; } }
            bf16x8 pa[4]; u32x4 w;
            w.x = cvtpk(p0[0], p0[1]); w.y = cvtpk(p0[2], p0[3]); w.z = cvtpk(p0[4], p0[5]); w.w = cvtpk(p0[6], p0[7]); pa[0] = __builtin_bit_cast(bf16x8, w);
            w.x = cvtpk(p0[8], p0[9]); w.y = cvtpk(p0[10], p0[11]); w.z = cvtpk(p0[12], p0[13]); w.w = cvtpk(p0[14], p0[15]); pa[1] = __builtin_bit_cast(bf16x8, w);
            w.x = cvtpk(p1[0], p1[1]); w.y = cvtpk(p1[2], p1[3]); w.z = cvtpk(p1[4], p1[5]); w.w = cvtpk(p1[6], p1[7]); pa[2] = __builtin_bit_cast(bf16x8, w);
            w.x = cvtpk(p1[8], p1[9]); w.y = cvtpk(p1[10], p1[11]); w.z = cvtpk(p1[12], p1[13]); w.w = cvtpk(p1[14], p1[15]); pa[3] = __builtin_bit_cast(bf16x8, w);
#pragma unroll
            for (int d0 = 0; d0 < 2; ++d0)
#pragma unroll
                for (int ks = 0; ks < 4; ++ks) { const s16x4 lo = vtr(vp + d0 * 4096 + ks * 1024), h8 = vtr(vp + d0 * 4096 + ks * 1024 + 512);
                    const bf16x8 vf = {lo[0], lo[1], lo[2], lo[3], h8[0], h8[1], h8[2], h8[3]};
                    o[d0] = __builtin_amdgcn_mfma_f32_32x32x16_bf16(pa[ks], vf, o[d0], 0, 0, 0); }
        }
        { const auto rr = __builtin_amdgcn_permlane32_swap(__float_as_uint(l), __float_as_uint(l), false, false); l = __uint_as_float(rr[0]) + __uint_as_float(rr[1]); }
        if (hi == 0) wsf[r32] = 1.f / l;
#pragma unroll
        for (int g = 0; g < 4; ++g) { const f32x4 fr = *(const LAS f32x4*)(wsf + 8 * g + 4 * hi);
#pragma unroll
            for (int i = 0; i < 4; ++i) { bf16_t* yr = Yh + (size_t)(qrow0 + 32 * qb + crow(4 * g + i, hi)) * 512 + r32;
                yr[0] = f2bf(o[0][4 * g + i] * fr[i]); yr[32] = f2bf(o[1][4 * g + i] * fr[i]); } }
    }
    asm volatile("s_waitcnt lgkmcnt(0)" ::: "memory");
}
}

namespace gm {
using da::crow; using da::vtr; using da::cvtpk; using da::s16x4;
__device__ __forceinline__ void unit(LAS unsigned char* lds, const bf16_t* Z, const float* ln_g, const float* ln_b, const float* w_s, const float* b_s, int row0, bf16_t* Yc, int wave, int lane) {
    const int r32 = lane & 31, hi = lane >> 5;
    { float lg[8], lb[8];
#pragma unroll
      for (int i = 0; i < 8; ++i) { lg[i] = ln_g[lane * 8 + i]; lb[i] = ln_b[lane * 8 + i]; }
      for (int tk = 0; tk < 16; ++tk) { const int row = row0 + wave * 16 + tk; float v[8]; unpack8(*(const u32x4*)(Z + (size_t)row * PROJZ + ZV + lane * 8), v);
          float s = 0.f;
#pragma unroll
          for (int i = 0; i < 8; ++i) s += v[i];
          const float mean = wave_sum(s) * (1.f / 512.f); float q = 0.f;
#pragma unroll
          for (int i = 0; i < 8; ++i) { v[i] -= mean; q += v[i] * v[i]; }
          const float rstd = rsqrtf(wave_sum(q) * (1.f / 512.f) + EPS);
          u32x4 w; w.x = pk2(v[0] * rstd * lg[0] + lb[0], v[1] * rstd * lg[1] + lb[1]); w.y = pk2(v[2] * rstd * lg[2] + lb[2], v[3] * rstd * lg[3] + lb[3]);
          w.z = pk2(v[4] * rstd * lg[4] + lb[4], v[5] * rstd * lg[5] + lb[5]); w.w = pk2(v[6] * rstd * lg[6] + lb[6], v[7] * rstd * lg[7] + lb[7]);
          *(LAS u32x4*)(lds + ((lane >> 2) * 8 + wave) * 1024 + tk * 64 + (lane & 3) * 16) = w; } }
    __syncthreads();
    const int pb = wave & 3, chh = wave >> 2;
    const LAS unsigned char* vp = lds + ((lane >> 4) & 1) * 32 + (lane & 3) * 8 + (4 * hi + ((lane & 15) >> 2)) * 64;
#pragma unroll 1
    for (int gg = 0; gg < 2; ++gg) { const int g = 2 * chh + gg; const float* wrow = w_s + ((size_t)g * 128 + 32 * pb + r32) * 128;
        bf16x8 a[8];
#pragma unroll
        for (int ks = 0; ks < 8; ++ks) { const f32x4 x0 = *(const f32x4*)(wrow + 16 * ks + 4 * hi), x1 = *(const f32x4*)(wrow + 16 * ks + 8 + 4 * hi);
            u32x4 w; w.x = cvtpk(x0[0], x0[1]); w.y = cvtpk(x0[2], x0[3]); w.z = cvtpk(x1[0], x1[1]); w.w = cvtpk(x1[2], x1[3]); a[ks] = __builtin_bit_cast(bf16x8, w); }
        float bsv[16];
#pragma unroll
        for (int i = 0; i < 16; ++i) bsv[i] = b_s[g * 128 + 32 * pb + crow(i, hi)];
#pragma unroll 1
        for (int c4 = 0; c4 < 4; ++c4) { const int cb = g * 4 + c4; f32x16 acc;
#pragma unroll
            for (int i = 0; i < 16; ++i) acc[i] = 0.f;
#pragma unroll
            for (int ks = 0; ks < 8; ++ks) { const s16x4 lo = vtr(vp + (cb * 8 + ks) * 1024), h8 = vtr(vp + (cb * 8 + ks) * 1024 + 512);
                const bf16x8 vf = {lo[0], lo[1], lo[2], lo[3], h8[0], h8[1], h8[2], h8[3]};
                acc = __builtin_amdgcn_mfma_f32_32x32x16_bf16(a[ks], vf, acc, 0, 0, 0); }
#pragma unroll
            for (int i = 0; i < 16; ++i) { const int row = row0 + 32 * pb + crow(i, hi), ch = cb * 32 + r32;
                Yc[(size_t)row * 512 + ch] = f2bf(bf2f(Z[(size_t)row * PROJZ + ZU + ch]) * (acc[i] + bsv[i])); } } }
    __syncthreads();
}
}


constexpr int NWAVES = 8, NTHREADS = 512;
constexpr int RING_BYTES = 131072, LDSCTL_OFF = RING_BYTES, MISC_OFF = LDSCTL_OFF + 320, LDS_BYTES = 163840;
constexpr int CW_BAR = 4096;
constexpr int N_PHASES = 20;
#ifndef PH_MASK
#define PH_MASK 0xFFFF
#endif
#define PH_ON(k) ((PH_MASK >> (k)) & 1)

__device__ __forceinline__ void p0_transpose_item(const float* W, int K, int N, bf16_t* WT, int mode, LAS float* scr, int item, int lane) {
    const int nblk = N / 32, kb = item / nblk, nb = item % nblk, k0 = 64 * kb, n0 = 32 * nb;
#pragma unroll 8
    for (int i = 0; i < 32; ++i) { const int kk = 2 * i + (lane >> 5); scr[kk * 33 + (lane & 31)] = W[(size_t)(k0 + kk) * N + n0 + (lane & 31)]; }
    LDS_WAIT(); asm volatile("" ::: "memory");
    const int c = lane & 7;
#pragma unroll
    for (int j = 0; j < 4; ++j) { const int n = (lane >> 3) + 8 * j; const LAS float* s = scr + (8 * c) * 33 + n; const int nn = n0 + n;
        const int row = mode == 0 ? nn : (256 * (nn >> 7) + (nn & 127) + (mode == 2 ? 128 : 0));
        u32x4 o; o.x = pk2(s[0 * 33], s[1 * 33]); o.y = pk2(s[2 * 33], s[3 * 33]); o.z = pk2(s[4 * 33], s[5 * 33]); o.w = pk2(s[6 * 33], s[7 * 33]);
        *(GAS u32x4*)(WT + (size_t)row * K + k0 + 8 * c) = o; }
    LDS_WAIT(); asm volatile("" ::: "memory");
}
__device__ __forceinline__ void norm_mod_row(const float* x, const float* g, const float* sh, const float* sc, bf16_t* o, int lane) {
    f32x4 v[4]; float s = 0.f;
#pragma unroll
    for (int j = 0; j < 4; ++j) { v[j] = *(const f32x4*)(x + j * 256 + lane * 4); s += (v[j][0] * v[j][0] + v[j][1] * v[j][1]) + (v[j][2] * v[j][2] + v[j][3] * v[j][3]); }
    const float rs = rsqrtf(wave_sum(s) * (1.f / D) + EPS);
#pragma unroll
    for (int j = 0; j < 4; ++j) { const int d = j * 256 + lane * 4; const f32x4 gg = *(const f32x4*)(g + d), a = *(const f32x4*)(sc + d), b = *(const f32x4*)(sh + d);
        const f32x4 h = v[j] * rs * gg * (a + 1.f) + b; u32x2 w; w.x = pk2(h[0], h[1]); w.y = pk2(h[2], h[3]); *(u32x2*)(o + d) = w; }
}

#define IN(i) (args.in[(i) + zero])
struct Args { const float* in[26]; float* out; unsigned char* ws; int ph_lo, ph_hi, li, pad; };

__global__ void __launch_bounds__(NTHREADS, 2) mk_fwd(Args args) {
    extern __shared__ __attribute__((aligned(16))) unsigned char lds_raw[];
    LAS unsigned char* lds = (LAS unsigned char*)lds_raw;
    volatile LAS unsigned* MISC = (volatile LAS unsigned*)(lds + MISC_OFF);
    const int tid0 = threadIdx.x, wave = __builtin_amdgcn_readfirstlane(tid0 >> 6);
    const int G = gridDim.x, bid = blockIdx.x, gw = bid * NWAVES + wave, NGW = G * NWAVES;
    for (int u = tid0; u < (LDS_BYTES - LDSCTL_OFF) / 4; u += NTHREADS) ((LAS unsigned*)(lds + LDSCTL_OFF))[u] = 0u;
    __syncthreads();
    XcdBarrier bar = xcd_barrier_post((unsigned*)(args.ws + WS_CTL) + CW_BAR + args.li * XCD_BAR_WORDS, MISC + 8);

    for (int ph = args.ph_lo; ph < args.ph_hi; ++ph) {
        int zero = 0; asm volatile("" : "+s"(zero));
        unsigned char* ws = args.ws + zero;
        const float* x_in = IN(0); const float* ctx_in = IN(2); float* out = args.out + zero;
        float* MOD = (float*)(ws + OFF_MOD); float* ROPE = (float*)(ws + OFF_ROPE); float* LAM = (float*)(ws + OFF_LAM);
        float* AFF = (float*)(ws + OFF_AFF); int* INV = (int*)(ws + OFF_INV); int* IDX = (int*)(ws + OFF_IDX); float* GATE = (float*)(ws + OFF_GATE); float* XC = (float*)(ws + WS_XC);
        bf16_t* WIN = (bf16_t*)(ws + WS_WIN); bf16_t* WBR = (bf16_t*)(ws + WS_WBR); bf16_t* WOUT = (bf16_t*)(ws + WS_WOUT); bf16_t* W13 = (bf16_t*)(ws + WS_W13); bf16_t* W2 = (bf16_t*)(ws + WS_W2);
        bf16_t* H = (bf16_t*)(ws + WS_H); bf16_t* Y = (bf16_t*)(ws + WS_Y); bf16_t* Z = (bf16_t*)(ws + WS_Z);
        bf16_t* MB = H; bf16_t* H2 = Y; bf16_t* HID = (bf16_t*)(ws + WS_Z + ZO_HID); bf16_t* YE = (bf16_t*)(ws + WS_Z + ZO_YE);

        const int l = ph < 2 ? 0 : (ph - 2) / 9, kind = ph < 2 ? ph : 2 + (ph - 2) % 9; const bool last = (l == 1);
        const float* mod = MOD + (size_t)l * 2 * 6144;
        if (kind == K_G1 || kind == K_M1 || kind == K_M2 || kind == K_E1 || kind == K_E2) {
            pg8::Gemm g; g.M = 0; g.N = 0;
            if (kind == K_G1) { g.A = H; g.Bt = WIN + (size_t)l * PROJ * D; g.K = D; }
            else if (kind == K_M1) { g.A = Y; g.Bt = WBR + (size_t)l * 3 * D * 512; g.K = 512; }
            else if (kind == K_M2) { g.A = MB; g.Bt = WOUT + (size_t)l * D * D; g.K = D; }
            else if (kind == K_E1) { g.A = H2; g.Bt = W13 + (size_t)l * 16 * 2048 * D; g.K = D; }
            else { g.A = HID; g.Bt = W2 + (size_t)l * 16 * D * FF; g.K = FF; }
            const USched S{kind, bid, G, IDX}; const UEpi E{kind, l, ws, out, l == 0 ? x_in : out};
            int wv_ = wave; asm volatile("" : "+s"(wv_)); const int tidg = wv_ * 64 + (int)__builtin_amdgcn_mbcnt_hi(~0u, __builtin_amdgcn_mbcnt_lo(~0u, 0u));
            if ((PH_MASK >> kind) & 1) pg8::gemm_phase<UEpi, USched>(lds, g, S, E, kind != K_M2, kind == K_E1, tidg);
        }
        int lane = (int)__builtin_amdgcn_mbcnt_hi(~0u, __builtin_amdgcn_mbcnt_lo(~0u, 0u)); asm volatile("" : "+v"(lane)); const int tid = wave * 64 + lane, r32 = lane & 31, hh = lane >> 5;
        if (PH_ON(K_P0) && kind == K_P0) {
            for (int it = bid; it < 192; it += G) { const int ll = it / 96, n0 = (it % 96) * 64; const float* w = IN(4) + (size_t)ll * D * 6144 + n0 + lane; const float* c = IN(1); const float* cc = IN(3);
                float a0 = 0.f, a1 = 0.f;
#pragma unroll 8
                for (int k = wave * 128; k < wave * 128 + 128; ++k) { const float wv = w[(size_t)k * 6144]; a0 += siluf_(c[k]) * wv; a1 += siluf_(cc[k]) * wv; }
                LAS float* red = (LAS float*)lds; red[(wave * 2 + 0) * 64 + lane] = a0; red[(wave * 2 + 1) * 64 + lane] = a1; __syncthreads();
                if (wave < 2) { float s = 0.f;
#pragma unroll
                    for (int q = 0; q < 8; ++q) s += red[(q * 2 + wave) * 64 + lane];
                    MOD[(size_t)(ll * 2 + wave) * 6144 + n0 + lane] = s + IN(5)[ll * 6144 + n0 + lane]; }
                __syncthreads(); }
            if (bid == G - 1) {
                for (int t = tid; t < 320 * 16; t += NTHREADS) { const int pos = t / 16, j = t % 16; const float inv = powf(10000.f, -(float)(2 * j) / 32.f);
                    if (pos < 256) { const float a = (float)pos * inv; ROPE[pos * 16 + j] = cosf(a); ROPE[4096 + pos * 16 + j] = sinf(a); }
                    else { const int p = pos - 256; const float a = (float)p * inv; ROPE[8192 + p * 16 + j] = cosf(a); ROPE[8192 + 1024 + p * 16 + j] = sinf(a); } }
                if (tid < 2) { float s1 = 0.f, s2 = 0.f; for (int i = 0; i < 64; ++i) { s1 += IN(10)[tid * 64 + i] * IN(11)[tid * 64 + i]; s2 += IN(12)[tid * 64 + i] * IN(13)[tid * 64 + i]; }
                    LAM[tid] = expf(s1) - expf(s2) + (0.8f - 0.6f * expf(-0.3f * (float)tid)); }
            }
            LAS float* scr = (LAS float*)(lds + wave * 16384);
            for (int it = gw; it < 58880; it += NGW) { int r = it;
                if (r < 7168) { const int z = r / 3584; p0_transpose_item(IN(8) + (size_t)z * D * PROJ, D, PROJ, WIN + (size_t)z * PROJ * D, 0, scr, r % 3584, lane); continue; } r -= 7168;
                if (r < 1536) { const int z = r / 256; p0_transpose_item(IN(19) + (size_t)z * 512 * D, 512, D, WBR + (size_t)z * D * 512, 0, scr, r % 256, lane); continue; } r -= 1536;
                if (r < 1024) { const int z = r / 512; p0_transpose_item(IN(20) + (size_t)z * D * D, D, D, WOUT + (size_t)z * D * D, 0, scr, r % 512, lane); continue; } r -= 1024;
                if (r < 16384) { const int z = r / 512; p0_transpose_item(IN(22) + (size_t)z * D * FF, D, FF, W13 + (size_t)z * 2048 * D, 1, scr, r % 512, lane); continue; } r -= 16384;
                if (r < 16384) { const int z = r / 512; p0_transpose_item(IN(23) + (size_t)z * D * FF, D, FF, W13 + (size_t)z * 2048 * D, 2, scr, r % 512, lane); continue; } r -= 16384;
                { const int z = r / 512; p0_transpose_item(IN(24) + (size_t)z * FF * D, FF, D, W2 + (size_t)z * D * FF, 0, scr, r % 512, lane); }
            }
        } else if (PH_ON(K_H1) && kind == K_H1) {
            for (int row = gw; row < R; row += NGW) { const float* xr = row < L ? x_in + (size_t)row * D : ctx_in + (size_t)(row - L) * D; const float* m = MOD + (row < L ? 0 : 6144);
                norm_mod_row(xr, IN(6), m, m + 1024, H + (size_t)row * D, lane); }
        } else if (PH_ON(K_G1) && kind == K_G1) {
            const int ntn = (last ? 2048 : PROJ) / 32;
            for (int it = gw; it < 8 * ntn; it += NGW) { const int mt = it & 7, nt = it >> 3; f32x16 acc[1];
                wgemm_tile<1>(H + (size_t)(L + mt * 32 + r32) * D + 8 * hh, WIN + (size_t)l * PROJ * D + (size_t)(nt * 32 + r32) * D + 8 * hh, nullptr, D, acc);
                const int row = L + mt * 32 + r32; const int nb = nt * 32;
                const int type = (nb >= 2560 && nb < 3072) ? 2 : (nb >= 3072 && nb < 4096) ? 3 : (nb >= 4096) ? 4 : 0;
                bf16_t* dst;
                if ((nb >= 1024 && nb < 2048) || (nb >= 2560 && nb < 3072)) { const int sel = nb < 1536 ? 1 : nb < 2048 ? 2 : 0; bf16_t* hb = (bf16_t*)(ws + WS_QB + (size_t)sel * QKV_STRIDE); const int cq = nb & 511; dst = hb + (size_t)(cq >> 7) * HB + (size_t)row * 128 + (cq & 127); }
                else { const int zc = nb < 1024 ? nb : nb < 2560 ? ZQA + (nb - 2048) : nb < 4096 ? ZU + (nb - 3072) : ZG + (nb - 4096); dst = Z + (size_t)row * PROJZ + zc; }
#pragma unroll
                for (int g4 = 0; g4 < 4; ++g4) { float v[4];
#pragma unroll
                    for (int i = 0; i < 4; ++i) { float t = acc[0][4 * g4 + i]; t = type == 2 ? t * C2 : type == 3 ? gelu_tanh(t) : type == 4 ? sigmoidf_(t) : t; v[i] = t; }
                    u32x2 w; w.x = pk2(v[0], v[1]); w.y = pk2(v[2], v[3]); *(u32x2*)(dst + 8 * g4 + 4 * hh) = w; } }
        } else if (PH_ON(K_MIX) && kind == K_MIX) {
            { const int nchunk = last ? 128 : 130;
              for (int cu = G - 1 - bid; cu < nchunk; cu += G) gm::unit(lds, Z, IN(15) + l * 512, IN(16) + l * 512, IN(17) + (size_t)l * 4 * 128 * 128, IN(18) + l * 512, cu * 128, Y + 2 * YP, wave, lane); }
            __syncthreads();
            for (int it = gw; it < 2048 + (last ? 0 : 32); it += NGW) { const int h = it & 7;
                const int qrow0 = it < 2048 ? (it >> 3) * 64 : L + ((it - 2048) >> 3) * 64, rr = it < 2048 ? (it >> 3) : -1;
                na::unit(lds, Z, IN(9) + ((size_t)l * 8 + h) * 465, qrow0, rr, h, Y + h * 64, wave, lane); }
            __syncthreads();
            const float lam = LAM[l], oscale = 1.f - (0.8f - 0.6f * expf(-0.3f * (float)l));
            bf16_t* QB = (bf16_t*)(ws + WS_QB); bf16_t* KB = (bf16_t*)(ws + WS_KB); bf16_t* VB = (bf16_t*)(ws + WS_VB);
            const int nlat = (512 - bid + G - 1) / G, nctx = (!last && bid < 8) ? (8 - bid + G - 1) / G : 0;
            for (int ui = 0; ui < nlat + nctx; ++ui) { int h, q0, kbase, NT;
                if (ui < nlat) { const int uu = bid + ui * G, x = uu & 7, b = (uu >> 3) & 31, i = uu >> 8; h = x >> 1; q0 = (((x & 1) * 32 + b) * 2 + i) * 128; kbase = 0; NT = R / 64; }
                else { const int uu = bid + (ui - nlat) * G; h = uu >> 1; q0 = L + (uu & 1) * 128; kbase = L; NT = C / 64; }
                da::unit(lds, QB + (size_t)h * HB, KB + (size_t)h * HB, VB + (size_t)h * HB, q0, kbase, NT, lam, IN(14) + l * 128, oscale, Y + YP + h * 128, wave, lane); }
        } else if (PH_ON(K_M1) && kind == K_M1) {
            if (!last) for (int it = gw; it < 8 * 32; it += NGW) { const int mt = it & 7, nt = it >> 3; const int row = L + mt * 32 + r32; float m4[4][4];
#pragma unroll
                for (int g4 = 0; g4 < 4; ++g4)
#pragma unroll
                    for (int i = 0; i < 4; ++i) m4[g4][i] = 0.f;
                for (int j = 0; j < 3; ++j) { f32x16 acc[1];
                    wgemm_tile<1>(Y + (size_t)j * YP + (size_t)row * 512 + 8 * hh, WBR + ((size_t)l * 3 + j) * D * 512 + (size_t)(nt * 32 + r32) * 512 + 8 * hh, nullptr, 512, acc);
#pragma unroll
                    for (int g4 = 0; g4 < 4; ++g4) { const u32x2 gw2 = *(const u32x2*)(Z + (size_t)row * PROJZ + ZG + j * 1024 + nt * 32 + 8 * g4 + 4 * hh);
                        m4[g4][0] += __uint_as_float(gw2.x << 16) * acc[0][4 * g4]; m4[g4][1] += __uint_as_float(gw2.x & 0xffff0000u) * acc[0][4 * g4 + 1];
                        m4[g4][2] += __uint_as_float(gw2.y << 16) * acc[0][4 * g4 + 2]; m4[g4][3] += __uint_as_float(gw2.y & 0xffff0000u) * acc[0][4 * g4 + 3]; } }
#pragma unroll
                for (int g4 = 0; g4 < 4; ++g4) { u32x2 w; w.x = pk2(m4[g4][0], m4[g4][1]); w.y = pk2(m4[g4][2], m4[g4][3]); *(u32x2*)(MB + (size_t)row * D + nt * 32 + 8 * g4 + 4 * hh) = w; } }
        } else if (PH_ON(K_M2) && kind == K_M2) {
            const float* xl_old = l == 0 ? x_in : out; const float* xc_old = l == 0 ? ctx_in : XC;
            if (!last) for (int it = gw; it < 8 * 32; it += NGW) { const int mt = it & 7, nt = it >> 3; const int rc = mt * 32 + r32; f32x16 acc[1];
                wgemm_tile<1>(MB + (size_t)(L + rc) * D + 8 * hh, WOUT + (size_t)l * D * D + (size_t)(nt * 32 + r32) * D + 8 * hh, nullptr, D, acc);
#pragma unroll
                for (int g4 = 0; g4 < 4; ++g4) { const int n = nt * 32 + 8 * g4 + 4 * hh; const f32x4 xo = *(const f32x4*)(xc_old + (size_t)rc * D + n), gt = *(const f32x4*)(mod + 6144 + 2048 + n);
                    f32x4 a; a[0] = acc[0][4 * g4]; a[1] = acc[0][4 * g4 + 1]; a[2] = acc[0][4 * g4 + 2]; a[3] = acc[0][4 * g4 + 3]; *(f32x4*)(XC + (size_t)rc * D + n) = xo + gt * a; } }
        } else if (PH_ON(K_R) && kind == K_R) {
            const int NR = last ? L : R; const float* g2 = IN(7) + l * D; const float* w_r = IN(21) + (size_t)l * D * 16;
            for (int row = gw; row < NR; row += NGW) {
                const float* x = row < L ? out + (size_t)row * D : XC + (size_t)(row - L) * D; const float* m = mod + (row < L ? 0 : 6144);
                f32x4 v[4]; float s = 0.f;
#pragma unroll
                for (int j = 0; j < 4; ++j) { v[j] = *(const f32x4*)(x + j * 256 + lane * 4); s += (v[j][0] * v[j][0] + v[j][1] * v[j][1]) + (v[j][2] * v[j][2] + v[j][3] * v[j][3]); }
                const float rs = rsqrtf(wave_sum(s) * (1.f / D) + EPS);
                float lg[16];
#pragma unroll
                for (int e = 0; e < 16; ++e) lg[e] = 0.f;
#pragma unroll
                for (int j = 0; j < 4; ++j) { const int d = j * 256 + lane * 4; const f32x4 gg = *(const f32x4*)(g2 + d), a = *(const f32x4*)(m + 4096 + d), b = *(const f32x4*)(m + 3072 + d);
                    const f32x4 h = v[j] * rs * gg * (a + 1.f) + b; u32x2 w; w.x = pk2(h[0], h[1]); w.y = pk2(h[2], h[3]); *(u32x2*)(H2 + (size_t)row * D + d) = w;
#pragma unroll
                    for (int i = 0; i < 4; ++i) { const f32x4* wr = (const f32x4*)(w_r + (size_t)(d + i) * 16);
#pragma unroll
                        for (int e4 = 0; e4 < 4; ++e4) { const f32x4 w4 = wr[e4]; lg[4 * e4] += h[i] * w4[0]; lg[4 * e4 + 1] += h[i] * w4[1]; lg[4 * e4 + 2] += h[i] * w4[2]; lg[4 * e4 + 3] += h[i] * w4[3]; } } }
                float mx = -1e30f;
#pragma unroll
                for (int e = 0; e < 16; ++e) { lg[e] = wave_sum(lg[e]); mx = fmaxf(mx, lg[e]); }
                float den = 0.f;
#pragma unroll
                for (int e = 0; e < 16; ++e) { lg[e] = expf(lg[e] - mx); den += lg[e]; }
                float rv = 0.f;
#pragma unroll
                for (int e = 0; e < 16; ++e) rv = (lane == e) ? lg[e] : rv;
                if (lane < 16) AFF[(size_t)row * 16 + lane] = rv / den;
            }
        } else if (PH_ON(K_S) && kind == K_S) {
            LAS int* red = (LAS int*)lds; LAS int* sc_gt = red + 16; LAS int* sc_eq = sc_gt + NTHREADS;
            for (int it = bid; it < 32; it += G) { const int e = it & 15, set = it >> 4;
                const int n = set == 0 ? L : C, base = set == 0 ? 0 : L, cap = set == 0 ? CAPL : CAPC, sbase = set == 0 ? 0 : CAPL, per = set == 0 ? 32 : 1;
                if (set == 1) { for (int s = CAPL + (last ? 0 : CAPC) + tid; s < SLOTS; s += NTHREADS) { IDX[e * SLOTS + s] = 0; GATE[e * SLOTS + s] = 0.f; } if (last) continue; }
                const bool act = tid * per < n; const float* ap = AFF + (size_t)(base + tid * per) * 16 + e;
                unsigned T = 0u;
                for (int bit = 30; bit >= 0; --bit) { const unsigned cand = T | (1u << bit); int cnt = 0;
                    if (act) for (int i = 0; i < per; ++i) cnt += (__float_as_uint(ap[(size_t)i * 16]) >= cand) ? 1 : 0;
                    cnt = (int)wave_sum((float)cnt);
                    __syncthreads(); if (lane == 0) red[wave] = cnt; __syncthreads();
                    int tot = 0;
#pragma unroll
                    for (int i = 0; i < NWAVES; ++i) tot += red[i];
                    if (tot >= cap) T = cand; }
                int gtc = 0, eqc = 0;
                if (act) for (int i = 0; i < per; ++i) { const unsigned v = __float_as_uint(ap[(size_t)i * 16]); gtc += v > T ? 1 : 0; eqc += v == T ? 1 : 0; }
                __syncthreads(); sc_gt[tid] = gtc; sc_eq[tid] = eqc; __syncthreads();
                for (int o = 1; o < NTHREADS; o <<= 1) { const int a = tid >= o ? sc_gt[tid - o] : 0, b = tid >= o ? sc_eq[tid - o] : 0; __syncthreads(); sc_gt[tid] += a; sc_eq[tid] += b; __syncthreads(); }
                const int need = cap - sc_gt[NTHREADS - 1]; int gt_before = sc_gt[tid] - gtc, eq_before = sc_eq[tid] - eqc;
                if (act) for (int i = 0; i < per; ++i) { const int tok = base + tid * per + i; const unsigned v = __float_as_uint(ap[(size_t)i * 16]); int slot = -1;
                    if (v > T) { slot = gt_before + (eq_before < need ? eq_before : need); ++gt_before; }
                    else if (v == T) { if (eq_before < need) slot = gt_before + eq_before; ++eq_before; }
                    if (slot >= 0) { IDX[e * SLOTS + sbase + slot] = tok; GATE[e * SLOTS + sbase + slot] = __uint_as_float(v); }
                    INV[(size_t)tok * 16 + e] = slot >= 0 ? sbase + slot : -1; }
                __syncthreads(); }
        } else if (PH_ON(K_E1) && kind == K_E1) {
            if (!last) for (int it = gw; it < 16 * 32; it += NGW) { const int e = it >> 5, nt = it & 31, p = nt >> 2, c4 = nt & 3; f32x16 acc[2];
                const int tok = IDX[e * SLOTS + CAPL + r32]; const bf16_t* b0 = W13 + ((size_t)l * 16 + e) * 2048 * D + (size_t)(256 * p + 32 * c4 + r32) * D + 8 * hh;
                wgemm_tile<2>(H2 + (size_t)tok * D + 8 * hh, b0, b0 + (size_t)128 * D, D, acc);
#pragma unroll
                for (int g4 = 0; g4 < 4; ++g4) { float v[4];
#pragma unroll
                    for (int i = 0; i < 4; ++i) v[i] = siluf_(acc[0][4 * g4 + i]) * acc[1][4 * g4 + i];
                    u32x2 w; w.x = pk2(v[0], v[1]); w.y = pk2(v[2], v[3]); *(u32x2*)(HID + ((size_t)e * SLOTS + CAPL + r32) * FF + 128 * p + 32 * c4 + 8 * g4 + 4 * hh) = w; } }
        } else if (PH_ON(K_E2) && kind == K_E2) {
            if (!last) for (int it = gw; it < 16 * 32; it += NGW) { const int e = it >> 5, nt = it & 31; f32x16 acc[1]; const size_t row = (size_t)e * SLOTS + CAPL + r32;
                wgemm_tile<1>(HID + row * FF + 8 * hh, W2 + ((size_t)l * 16 + e) * D * FF + (size_t)(nt * 32 + r32) * FF + 8 * hh, nullptr, FF, acc);
                const float gsc = GATE[row];
#pragma unroll
                for (int g4 = 0; g4 < 4; ++g4) { u32x2 w; w.x = pk2(acc[0][4 * g4] * gsc, acc[0][4 * g4 + 1] * gsc); w.y = pk2(acc[0][4 * g4 + 2] * gsc, acc[0][4 * g4 + 3] * gsc);
                    *(u32x2*)(YE + row * D + nt * 32 + 8 * g4 + 4 * hh) = w; } }
        } else if (PH_ON(K_CB) && kind == K_CB) {
            const int NR = last ? L : R; const float* gn = last ? IN(25) : IN(6) + D; const float* modn = MOD + (size_t)2 * 6144;
            for (int row = gw; row < NR; row += NGW) {
                float* x = row < L ? out + (size_t)row * D : XC + (size_t)(row - L) * D; const float* m = mod + (row < L ? 0 : 6144);
                f32x4 v[4], a[4];
#pragma unroll
                for (int j = 0; j < 4; ++j) { v[j] = *(const f32x4*)(x + j * 256 + lane * 4); a[j] = (f32x4){0.f, 0.f, 0.f, 0.f}; }
                for (int e = 0; e < 16; ++e) { const int s = INV[(size_t)row * 16 + e]; if (s < 0) continue; const bf16_t* y = YE + ((size_t)e * SLOTS + s) * D;
#pragma unroll
                    for (int j = 0; j < 4; ++j) { const u32x2 u = *(const u32x2*)(y + j * 256 + lane * 4); a[j][0] += __uint_as_float(u.x << 16); a[j][1] += __uint_as_float(u.x & 0xffff0000u); a[j][2] += __uint_as_float(u.y << 16); a[j][3] += __uint_as_float(u.y & 0xffff0000u); } }
                float s = 0.f;
#pragma unroll
                for (int j = 0; j < 4; ++j) { const f32x4 gt = *(const f32x4*)(m + 5120 + j * 256 + lane * 4); v[j] = v[j] + gt * a[j]; s += (v[j][0] * v[j][0] + v[j][1] * v[j][1]) + (v[j][2] * v[j][2] + v[j][3] * v[j][3]); }
                const float rs = rsqrtf(wave_sum(s) * (1.f / D) + EPS);
                if (last) {
#pragma unroll
                    for (int j = 0; j < 4; ++j) { const int d = j * 256 + lane * 4; *(f32x4*)(out + (size_t)row * D + d) = v[j] * rs * *(const f32x4*)(gn + d); }
                } else { const float* mn = modn + (row < L ? 0 : 6144);
#pragma unroll
                    for (int j = 0; j < 4; ++j) { const int d = j * 256 + lane * 4; *(f32x4*)(x + d) = v[j];
                        const f32x4 h = v[j] * rs * *(const f32x4*)(gn + d) * (*(const f32x4*)(mn + 1024 + d) + 1.f) + *(const f32x4*)(mn + d); u32x2 w; w.x = pk2(h[0], h[1]); w.y = pk2(h[2], h[3]); *(u32x2*)(H + (size_t)row * D + d) = w; } }
            }
        }
        if (ph + 1 < args.ph_hi) xcd_barrier(bar, tid);
    }
}


#ifndef FAST_TAIL
#define FAST_TAIL 1
#endif
static void launch_mk(const Args& base, int lo, int hi, int li, int grid, hipStream_t stream) {
    Args a = base; a.ph_lo = lo; a.ph_hi = hi; a.li = li;
    hipLaunchKernelGGL(mk_fwd, dim3(grid), dim3(NTHREADS), LDS_BYTES, stream, a);
}
extern "C" void kernel_launch(void* const* d_in, const int* in_sizes, int n_in, void* d_out, int out_size, void* d_ws, size_t ws_size, hipStream_t stream) {
    static int grid = 0;
    if (grid == 0) {
        if (n_in != 26 || ws_size < WS_END) { fprintf(stderr, "kernel_launch: bad arguments (n_in %d, ws %zu < %zu)\n", n_in, ws_size, (size_t)WS_END); grid = -1; return; }
        int dev = 0, cus = 0;
        if (hipGetDevice(&dev) != hipSuccess || hipDeviceGetAttribute(&cus, hipDeviceAttributeMultiprocessorCount, dev) != hipSuccess) { grid = -1; return; }
        if (hipFuncSetAttribute((const void*)mk_fwd, hipFuncAttributeMaxDynamicSharedMemorySize, LDS_BYTES) != hipSuccess) { fprintf(stderr, "kernel_launch: hipFuncSetAttribute failed\n"); grid = -1; return; }
        grid = cus;
    }
    if (grid < 0) return;
    (void)hipMemsetAsync((char*)d_ws + WS_CTL, 0, CTL_ZERO_BYTES, stream);
    Args base{};
    for (int i = 0; i < 26; ++i) base.in[i] = (const float*)d_in[i];
    base.out = (float*)d_out; base.ws = (unsigned char*)d_ws;
    launch_mk(base, 0, N_PHASES, 0, grid, stream);
}
```

```cpp
#include <hip/hip_runtime.h>
#include <cstdint>
#include <cstdio>
#include <type_traits>

typedef unsigned short bf16_t;
#define GAS __attribute__((address_space(1)))
__device__ __forceinline__ float bf2f(bf16_t b) { return __uint_as_float(((unsigned)b) << 16); }
__device__ __forceinline__ bf16_t f2bf(float f) { unsigned u = __float_as_uint(f); return (bf16_t)((u + 0x7fffu + ((u >> 16) & 1u)) >> 16); }
__device__ __forceinline__ unsigned pk2(float lo, float hi) { typedef float f2_ __attribute__((ext_vector_type(2))); typedef __bf16 b2_ __attribute__((ext_vector_type(2))); f2_ v = {lo, hi}; b2_ b = __builtin_convertvector(v, b2_); return __builtin_bit_cast(unsigned, b); }

constexpr int D = 1024, L = 16384, C = 256, R = L + C, PROJ = 7168, NE = 16, FF = 1024;
constexpr int CAPL = 2048, CAPC = 32, SLOTS = 2304;
constexpr float EPS = 1e-6f;
constexpr float C2 = 0.125f * 1.4426950408889634f;
constexpr int PROJZ = 4608;
constexpr int ZQA = 0, ZU = 512, ZV = 1024, ZG = 1536;
constexpr size_t HA = (size_t)(R / 64) * 4096;
constexpr size_t HB = (size_t)R * 128;
constexpr size_t YP = (size_t)R * 512;

constexpr size_t MiB = 1u << 20;
constexpr size_t WS_CTL = 0, CTL_ZERO_BYTES = 1 * MiB;
constexpr size_t OFF_MOD = 1 * MiB;
constexpr size_t OFF_ROPE = 1 * MiB + 256 * 1024;
constexpr size_t OFF_LAM = 1 * MiB + 320 * 1024;
constexpr size_t OFF_GST = 1 * MiB + 384 * 1024;
constexpr size_t OFF_AFF = 2 * MiB;
constexpr size_t OFF_INV = 3 * MiB + 256 * 1024;
constexpr size_t OFF_IDX = 4 * MiB + 512 * 1024;
constexpr size_t OFF_GATE = 4 * MiB + 768 * 1024;
constexpr size_t WS_XC = 5 * MiB;
constexpr size_t WS_WIN = 6 * MiB;
constexpr size_t WS_WBR = 34 * MiB;
constexpr size_t WS_WOUT = 40 * MiB;
constexpr size_t WS_W13 = 44 * MiB;
constexpr size_t WS_W2 = 172 * MiB;
constexpr size_t WS_H = 236 * MiB;
constexpr size_t WS_Y = 269 * MiB;
constexpr size_t WS_Z = 318 * MiB;
constexpr size_t KAV_STRIDE = 65 * MiB / 4;
constexpr size_t WS_KA = WS_Z + 585 * MiB / 4, WS_VA = WS_KA + KAV_STRIDE;
constexpr size_t QKV_STRIDE = 33 * MiB / 2;
constexpr size_t WS_QB = 497 * MiB, WS_KB = WS_QB + QKV_STRIDE, WS_VB = WS_QB + 2 * QKV_STRIDE;
constexpr size_t WS_END = 546 * MiB;
constexpr size_t ZO_HID = 72 * MiB;
constexpr size_t ZO_YE = 0;

__device__ __forceinline__ float sigmoidf_(float x) { return __builtin_amdgcn_rcpf(1.f + __builtin_amdgcn_exp2f(-1.4426950408889634f * x)); }
__device__ __forceinline__ float gelu_tanh(float x) { return x * sigmoidf_(1.5957691216057308f * (x + 0.044715f * x * x * x)); }
__device__ __forceinline__ float siluf_(float x) { return x * sigmoidf_(x); }
template <int K> __device__ __forceinline__ float xorf_(float v) { static_assert(K >= 1 && K < 32, "ds_swizzle bit-mask mode");
    return __int_as_float(__builtin_amdgcn_ds_swizzle(__float_as_int(v), (K << 10) | 0x1f)); }
template <int K> __device__ __forceinline__ int xori_(int v) { static_assert(K >= 1 && K < 32, "ds_swizzle bit-mask mode"); return __builtin_amdgcn_ds_swizzle(v, (K << 10) | 0x1f); }
__device__ __forceinline__ float xor32f_(float v, bool lo32) { const auto rr = __builtin_amdgcn_permlane32_swap(__float_as_uint(v), __float_as_uint(v), false, false); return __uint_as_float(lo32 ? rr[1] : rr[0]); }
__device__ __forceinline__ float sum32f_(float v) { const auto rr = __builtin_amdgcn_permlane32_swap(__float_as_uint(v), __float_as_uint(v), false, false); return __uint_as_float(rr[0]) + __uint_as_float(rr[1]); }
__device__ __forceinline__ float wave_sum(float v) { v += xorf_<1>(v); v += xorf_<2>(v); v += xorf_<4>(v); v += xorf_<8>(v); v += xorf_<16>(v); return sum32f_(v); }

enum { K_P0 = 0, K_H1 = 1, K_G1 = 2, K_MIX = 3, K_M1 = 4, K_M2 = 5, K_R = 6, K_S = 7, K_E1 = 8, K_E2 = 9, K_CB = 10 };
__device__ __forceinline__ size_t kv_tiled_off(int sel, int key, int cw) {
    const size_t t = (size_t)(key >> 6) * 8192; const int kk = key & 63;
    return sel == 1 ? t + (size_t)((((cw >> 6) * 8 + ((cw & 63) >> 3)) * 64 + kk) * 8 + (cw & 7)) : t + (size_t)((((cw >> 5) * 4 + (kk >> 4)) * 16 + (kk & 15)) * 32 + (cw & 31));
}
__device__ __forceinline__ int na_tiled_off(int isv, int kk, int d) { return isv ? ((((d >> 5) * 4 + (kk >> 4)) * 16 + (kk & 15)) * 32 + (d & 31)) : (((d >> 3) * 64 + kk) * 8 + (d & 7)); }
__device__ __forceinline__ int lane_id_() { int l; asm volatile("v_mbcnt_lo_u32_b32 %0, -1, 0\n\tv_mbcnt_hi_u32_b32 %0, -1, %0" : "=v"(l)); return l; }

namespace pg8 {
#define PG8_LAS __attribute__((address_space(3)))
typedef unsigned short bf16_t;
typedef short bf16x8 __attribute__((ext_vector_type(8)));
typedef float f32x4 __attribute__((ext_vector_type(4)));
typedef unsigned u32x4 __attribute__((ext_vector_type(4)));
constexpr int BM = 256, BK = 64, HALF = 128, HTB = HALF * BK * 2  , STAGE_BYTES = 8 * HTB, NXCD = 8, WGM = 8;

__host__ __device__ __forceinline__ int lds_byte(int r, int c) { const int st = (r >> 4) * 2 + (c >> 5), rr = r & 15, cc = c & 31, ob = rr * 64 + cc * 2; return st * 1024 + (ob ^ (((ob >> 9) & 1) << 5)); }
__host__ __device__ __forceinline__ void stage_rc(int b, int& R, int& C) { const int st = b / 1024, sb = b % 1024, swz = sb ^ (((sb >> 9) & 1) << 5); R = (st >> 1) * 16 + swz / 64; C = (st & 1) * 32 + (swz % 64) / 2; }
__host__ __device__ __forceinline__ int perm32(int rho) { const int n = rho >> 4, i = rho & 15; return 8 * (i >> 2) + 4 * n + (i & 3); }

struct Unit { int pm, pn; };
struct Gemm { const bf16_t* A; const bf16_t* Bt; int M, N, K; };

struct StaticOrder {
    int nM, nN, nwg, G, c;
    __host__ __device__ void init(int M, int N, int G_, int c_) { nM = M / BM; nN = N / BM; nwg = nM * nN; G = G_; c = c_; }
    __host__ __device__ bool next(int i, Unit& u) const {
        const long L = (long)i * G + c; if (L >= nwg) return false;
        int wgid = (int)L; { const int q = nwg / NXCD, r = nwg % NXCD, xcd = wgid % NXCD, off = wgid / NXCD; wgid = (xcd < r ? xcd * (q + 1) : r * (q + 1) + (xcd - r) * q) + off; }
        const int nig = WGM * nN, gid = wgid / nig, fm = gid * WGM, gsz = (nM - fm) < WGM ? (nM - fm) : WGM;
        u.pm = fm + ((wgid % nig) % gsz); u.pn = (wgid % nig) / gsz; return true;
    }
    __device__ __forceinline__ void a_ready(const Unit&) const {}
    __device__ __forceinline__ void done(const Unit&) const {}
};

__device__ __forceinline__ unsigned cvt_pk_bf16(float lo, float hi) { unsigned r; asm volatile("v_cvt_pk_bf16_f32 %0, %1, %2" : "=v"(r) : "v"(lo), "v"(hi)); return r; }
typedef float f32x2 __attribute__((ext_vector_type(2)));
template <class Epi, class Sched>
__device__ __forceinline__ void gemm_phase(PG8_LAS unsigned char* lds, const Gemm g, const Sched& S, const Epi& E, const bool PERM, const bool GATHER, const int tid_in) {
    constexpr bool ALIGN_EPI = true, SP2 = true;
    int tid_ = tid_in; asm volatile("" : "+v"(tid_));
    const int tid = tid_, wid = __builtin_amdgcn_readfirstlane(tid >> 6), lane = tid & 63, wr = wid >> 2, wc = wid & 3, fr = lane & 15, fq = lane >> 4;
    const int K = g.K, nt = K / BK;
    unsigned voffA[2], voffB[2];
#pragma unroll
    for (int i = 0; i < 2; ++i) { int R, C; stage_rc(tid * 16 + i * 8192, R, C); const int Rb = PERM ? ((R & ~31) + perm32(R & 31)) : R;
        voffA[i] = (unsigned)(R * K + C) * 2u; voffB[i] = (unsigned)(Rb * K + C) * 2u; }
    unsigned vc0[2], vc1[2], vn0[2], vn1[2];
#pragma unroll
    for (int i = 0; i < 2; ++i) { vc0[i] = vc1[i] = vn0[i] = vn1[i] = voffA[i]; }
#define PG8_GLOAD(dst0, dst1, u) do { if (GATHER) { const int* gi_ = S.rows(u); int t_ = tid; asm volatile("" : "+v"(t_)); int ga_[2], gb_[2], cc_[2];     \
        _Pragma("unroll") for (int i = 0; i < 2; ++i) { int R_, C_; stage_rc(t_ * 16 + i * 8192, R_, C_); ga_[i] = gi_[R_]; gb_[i] = gi_[R_ + HALF]; cc_[i] = C_; } \
        _Pragma("unroll") for (int i = 0; i < 2; ++i) { dst0[i] = (unsigned)ga_[i] * (unsigned)(K * 2) + (unsigned)(cc_[i] * 2); dst1[i] = (unsigned)gb_[i] * (unsigned)(K * 2) + (unsigned)(cc_[i] * 2); } } } while (0)
    const size_t kstep = (size_t)(BK * 2);
    const size_t hstep = (size_t)HALF * K * 2;
    const size_t tstep = 2 * hstep; const size_t hstepA = GATHER ? 0 : hstep, tstepA = GATHER ? 0 : tstep;
    const unsigned ldsw = (unsigned)wid * 1024u;
    const int aoff = lds_byte(wr * 64 + fr, fq * 8), boff = lds_byte(wc * 32 + fr, fq * 8);
#define PG8_SA(b, h) (((b) * 2 + (h)) * HTB)
#define PG8_SB(b, h) ((4 + (b) * 2 + (h)) * HTB)
#define PG8_STAGE(bufoff, gbase, voff) do { _Pragma("unroll") for (int _i = 0; _i < 2; ++_i) \
        __builtin_amdgcn_global_load_lds((const unsigned*)((const char*)(gbase) + (voff)[_i]), (PG8_LAS unsigned*)(lds + (bufoff) + ldsw + _i * 8192), 16, 0, 0); } while (0)
#define PG8_LDA(dst, b, h) do { _Pragma("unroll") for (int m = 0; m < 4; ++m) _Pragma("unroll") for (int k = 0; k < 2; ++k) dst[m][k] = *(const PG8_LAS bf16x8*)(lds + PG8_SA(b, h) + aoff + m * 2048 + k * 1024); } while (0)
#define PG8_LDB(dst, b, h) do { _Pragma("unroll") for (int n = 0; n < 2; ++n) _Pragma("unroll") for (int k = 0; k < 2; ++k) dst[n][k] = *(const PG8_LAS bf16x8*)(lds + PG8_SB(b, h) + boff + n * 2048 + k * 1024); } while (0)
#define PG8_MMA(ai, bj, At, Bt) do { __builtin_amdgcn_s_setprio(1); _Pragma("unroll") for (int m = 0; m < 4; ++m) _Pragma("unroll") for (int n = 0; n < 2; ++n) _Pragma("unroll") for (int k = 0; k < 2; ++k) \
        acc[ai][bj][m][n] = __builtin_amdgcn_mfma_f32_16x16x32_bf16(Bt[n][k], At[m][k], acc[ai][bj][m][n], 0, 0, 0); __builtin_amdgcn_s_setprio(0); } while (0)
#define PG8_WAIT_V(n) asm volatile("s_waitcnt vmcnt(" #n ")" ::: "memory")
#define PG8_WAIT_L(n) asm volatile("s_waitcnt lgkmcnt(" #n ")" ::: "memory")
#define PG8_BAR __builtin_amdgcn_s_barrier()
#define PG8_SCHED __builtin_amdgcn_sched_barrier(0)
    Unit cur, nxt; int ui = 0;
    if (!S.next(0, cur)) return;
    f32x4 acc[2][2][4][2];
#pragma unroll
    for (int a = 0; a < 2; ++a)
#pragma unroll
        for (int b = 0; b < 2; ++b)
#pragma unroll
            for (int m = 0; m < 4; ++m)
#pragma unroll
                for (int n = 0; n < 2; ++n) acc[a][b][m][n] = (f32x4){0.f, 0.f, 0.f, 0.f};
    bf16x8 At[4][2], B0[2][2], B1[2][2];
    const char* cA = (const char*)g.A + (size_t)cur.pm * tstepA; const char* cB = (const char*)g.Bt + (size_t)cur.pn * tstep;
    S.a_ready(cur); PG8_GLOAD(vc0, vc1, cur);
    if constexpr (SP2) {
        PG8_STAGE(PG8_SB(0, 0), cB, voffB); PG8_STAGE(PG8_SB(0, 1), cB + hstep, voffB); PG8_STAGE(PG8_SA(0, 0), cA, vc0); PG8_STAGE(PG8_SA(0, 1), cA + hstepA, vc1);
        if (wr == 1) PG8_BAR;
        PG8_WAIT_V(2); PG8_BAR;
        PG8_STAGE(PG8_SB(1, 0), cB + kstep, voffB); PG8_STAGE(PG8_SA(1, 0), cA + kstep, vc0); PG8_STAGE(PG8_SB(1, 1), cB + hstep + kstep, voffB);
        PG8_WAIT_V(6); PG8_BAR;
    }
    for (;;) {
        const bool has_next = S.next(ui + 1, nxt);
        const char* nA = has_next ? (const char*)g.A + (size_t)nxt.pm * tstepA : cA; const char* nB = has_next ? (const char*)g.Bt + (size_t)nxt.pn * tstep : cB;
        if (GATHER) { if (has_next) PG8_GLOAD(vn0, vn1, nxt); else { _Pragma("unroll") for (int i = 0; i < 2; ++i) { vn0[i] = vc0[i]; vn1[i] = vc1[i]; } } }
        for (int t = 0; t < nt; t += 2) {
            const bool last = (t == nt - 2);
            unsigned m0[2], m1[2];
#pragma unroll
            for (int i = 0; i < 2; ++i) { m0[i] = (GATHER && last) ? vn0[i] : vc0[i]; m1[i] = (GATHER && last) ? vn1[i] : vc1[i]; }
            const char* a1 = cA + (size_t)(t + 1) * kstep;
            const char* a2 = last ? nA : cA + (size_t)(t + 2) * kstep; const char* b2 = last ? nB : cB + (size_t)(t + 2) * kstep;
            const char* a3 = a2 + kstep; const char* b3 = b2 + kstep;
            if (last && has_next) S.a_ready(nxt);
            if constexpr (SP2) {
            PG8_LDB(B0, 0, 0); PG8_LDB(B1, 0, 1); PG8_SCHED; PG8_LDA(At, 0, 0); PG8_STAGE(PG8_SA(1, 1), a1 + hstepA, vc1);
            PG8_WAIT_V(8); PG8_WAIT_L(0); PG8_BAR; PG8_MMA(0, 0, At, B0); PG8_MMA(0, 1, At, B1); PG8_BAR; PG8_SCHED;
            PG8_LDA(At, 0, 1); PG8_STAGE(PG8_SB(0, 0), b2, voffB); PG8_STAGE(PG8_SB(0, 1), b2 + hstep, voffB); PG8_STAGE(PG8_SA(0, 0), a2, m0);
            PG8_WAIT_V(8); PG8_WAIT_L(0); PG8_BAR; PG8_MMA(1, 0, At, B0); PG8_MMA(1, 1, At, B1); PG8_BAR; PG8_SCHED;
            PG8_LDB(B0, 1, 0); PG8_LDB(B1, 1, 1); PG8_SCHED; PG8_LDA(At, 1, 0); PG8_STAGE(PG8_SA(0, 1), a2 + hstepA, m1);
            PG8_WAIT_V(8); PG8_WAIT_L(0); PG8_BAR; PG8_MMA(0, 0, At, B0); PG8_MMA(0, 1, At, B1); PG8_BAR; PG8_SCHED;
            PG8_LDA(At, 1, 1); PG8_STAGE(PG8_SB(1, 0), b3, voffB); PG8_STAGE(PG8_SB(1, 1), b3 + hstep, voffB); PG8_STAGE(PG8_SA(1, 0), a3, m0);
            PG8_WAIT_V(8); PG8_WAIT_L(0); PG8_BAR; PG8_MMA(1, 0, At, B0); PG8_MMA(1, 1, At, B1); PG8_BAR; PG8_SCHED;
            } else { static_assert(SP2, "only the SP2 loop is kept"); }
        }
        if constexpr (ALIGN_EPI) { if (wr == 0) PG8_BAR; }
#ifdef PROBE_EPI2
        if (E.kind == PROBE_EPI2) E(acc, cur, wr, wc, fr, fq);
#endif
        if (E.carries()) { E.carry(acc, cur, wr, wc, fr, fq); S.done(cur); } else
        if constexpr (!Epi::AFTER_DRAIN) { E(acc, cur, wr, wc, fr, fq); S.done(cur); }
        if (!has_next) break;
        if (!E.keeps(cur))
#pragma unroll
        for (int a = 0; a < 2; ++a)
#pragma unroll
            for (int b = 0; b < 2; ++b)
#pragma unroll
                for (int m = 0; m < 4; ++m)
#pragma unroll
                    for (int n = 0; n < 2; ++n) acc[a][b][m][n] = (f32x4){0.f, 0.f, 0.f, 0.f};
        cur = nxt; cA = nA; cB = nB; ++ui;
#pragma unroll
        for (int i = 0; i < 2; ++i) { vc0[i] = vn0[i]; vc1[i] = vn1[i]; }
        if constexpr (ALIGN_EPI) { if (wr == 1) PG8_BAR; }
    }
    PG8_WAIT_V(0);
    if constexpr (!ALIGN_EPI) { if (wr == 0) PG8_BAR; }
    PG8_BAR;
    if constexpr (Epi::AFTER_DRAIN) { E.fused(acc, cur, wr, wc, fr, fq, lds, wid, lane); S.done(cur); }
#undef PG8_GLOAD
#undef PG8_SA
#undef PG8_SB
#undef PG8_STAGE
#undef PG8_LDA
#undef PG8_LDB
#undef PG8_MMA
#undef PG8_WAIT_V
#undef PG8_WAIT_L
#undef PG8_BAR
#undef PG8_SCHED
}
}

typedef pg8::f32x4 f32x4; typedef pg8::u32x4 u32x4; typedef pg8::Unit Unit;
typedef float f32x16 __attribute__((ext_vector_type(16)));
typedef short bf16x8 __attribute__((ext_vector_type(8)));
typedef unsigned u32x2 __attribute__((ext_vector_type(2)));

struct EpiZ { static constexpr bool PERM = true, AFTER_DRAIN = false;
    bf16_t* Z; const float* rope; unsigned char* qkv;
    __device__ __forceinline__ void operator()(const f32x4 (&acc)[2][2][4][2], const Unit& u, int wr, int wc, int fr, int fq) const {
        const int row0 = u.pm * 256 + wr * 64 + fr, col0 = u.pn * 256 + wc * 32 + 8 * fq, pn = u.pn;
        const int type = (pn == 4 || pn == 5) ? 1 : (pn == 10 || pn == 11) ? 2 : (pn >= 12 && pn < 16) ? 3 : (pn >= 16) ? 4 : 0;
        const int colhalf = wc & 1; const float* rc = rope + (colhalf ? 8192 : 0) + 8 * (fq & 1); const float* rs = rc + (colhalf ? 1024 : 4096);
#pragma unroll
        for (int ai = 0; ai < 2; ++ai)
#pragma unroll
            for (int m = 0; m < 4; ++m) { const int row = row0 + ai * 128 + m * 16;
                const int cq = (pn & 1) * 256 + wc * 32 + 8 * fq;
                bf16_t* rowp; size_t bjstep = 128;
                if (type == 1 || type == 2 || pn == 6 || pn == 7) { const int sel = type == 2 ? 0 : type == 1 ? 1 : 2; bf16_t* hb = (bf16_t*)(qkv + (size_t)sel * QKV_STRIDE); rowp = hb + (size_t)(cq >> 7) * HB + (sel == 0 ? (size_t)row * 128 + (cq & 127) : kv_tiled_off(sel, row, cq & 127)); bjstep = HB; }
                else if (pn < 4) { bf16_t* ab = (bf16_t*)(qkv + (WS_KA - WS_QB) + (size_t)(pn >> 1) * KAV_STRIDE); rowp = ab + (size_t)(cq >> 6) * HA + (size_t)(row >> 6) * 4096 + na_tiled_off(pn >> 1, row & 63, cq & 63); bjstep = 2 * HA; }
                else { const int zc = pn < 10 ? ZQA + (pn - 8) * 256 : pn < 16 ? ZU + (pn - 12) * 256 : ZG + (pn - 16) * 256; rowp = Z + (size_t)row * PROJZ + zc + wc * 32 + 8 * fq; }
                float cs[8], sn[8];
                if (type == 1 || type == 2) { const int pos = colhalf ? (row & 63) : (row >> 6);
                    const f32x4 c0 = *(const GAS f32x4*)(rc + pos * 16), c1 = *(const GAS f32x4*)(rc + pos * 16 + 4), s0 = *(const GAS f32x4*)(rs + pos * 16), s1 = *(const GAS f32x4*)(rs + pos * 16 + 4);
#pragma unroll
                    for (int e = 0; e < 4; ++e) { cs[e] = c0[e]; cs[4 + e] = c1[e]; sn[e] = fq < 2 ? -s0[e] : s0[e]; sn[4 + e] = fq < 2 ? -s1[e] : s1[e]; } }
#pragma unroll
                for (int bj = 0; bj < 2; ++bj) { float v[8];
#pragma unroll
                    for (int e = 0; e < 4; ++e) { v[e] = acc[ai][bj][m][0][e]; v[4 + e] = acc[ai][bj][m][1][e]; }
                    if (type == 1 || type == 2) { const float sc = type == 2 ? C2 : 1.f;
#pragma unroll
                        for (int e = 0; e < 8; ++e) { const float p = xor32f_(v[e], fq < 2); v[e] = (v[e] * cs[e] + p * sn[e]) * sc; } }
                    else if (type == 3) {
#pragma unroll
                        for (int e = 0; e < 8; ++e) v[e] = gelu_tanh(v[e]); }
                    else if (type == 4) {
#pragma unroll
                        for (int e = 0; e < 8; ++e) v[e] = sigmoidf_(v[e]); }
                    else if (pn == 8 || pn == 9) {
#pragma unroll
                        for (int e = 0; e < 8; ++e) v[e] *= C2; }
                    u32x4 w; w.x = pk2(v[0], v[1]); w.y = pk2(v[2], v[3]); w.z = pk2(v[4], v[5]); w.w = pk2(v[6], v[7]);
                    *(GAS u32x4*)(rowp + bj * bjstep) = w; } }
    }
};
__device__ __forceinline__ void unpack8(const u32x4 w, float (&f)[8]) {
    f[0] = __uint_as_float(w.x << 16); f[1] = __uint_as_float(w.x & 0xffff0000u); f[2] = __uint_as_float(w.y << 16); f[3] = __uint_as_float(w.y & 0xffff0000u);
    f[4] = __uint_as_float(w.z << 16); f[5] = __uint_as_float(w.z & 0xffff0000u); f[6] = __uint_as_float(w.w << 16); f[7] = __uint_as_float(w.w & 0xffff0000u);
}
struct EpiMerge { static constexpr bool PERM = true, AFTER_DRAIN = false;
    bf16_t* Mb; const bf16_t* Z;
    __device__ __forceinline__ void carry(f32x4 (&acc)[2][2][4][2], const Unit& u, int wr, int wc, int fr, int fq) const {
        const int j = u.pn >> 2, pm = u.pm - 65 * j, pn = u.pn & 3;
        const int row0 = pm * 256 + wr * 64 + fr, col0 = pn * 256 + wc * 32 + 8 * fq;
#pragma unroll
        for (int qa = 0; qa < 4; ++qa) { const int ai = qa >> 1, mh = qa & 1;
            const bf16_t* gp0 = Z + (size_t)(row0 + ai * 128 + mh * 32) * PROJZ + ZG + j * 1024 + col0;
            u32x4 gq[4];
#pragma unroll
            for (int q = 0; q < 4; ++q) gq[q] = *(const GAS u32x4*)(gp0 + (size_t)(q >> 1) * 16 * PROJZ + (q & 1) * 128);
            if (j < 2) { u32x4 gnq[4];
#pragma unroll
                for (int q = 0; q < 4; ++q) gnq[q] = *(const GAS u32x4*)(gp0 + (size_t)(q >> 1) * 16 * PROJZ + (q & 1) * 128 + 1024);
#pragma unroll
                for (int q = 0; q < 4; ++q) { const int m = 2 * mh + (q >> 1), bj = q & 1; float g[8], gn[8]; unpack8(gq[q], g); unpack8(gnq[q], gn);
#pragma unroll
                    for (int e = 0; e < 8; ++e) g[e] = fmaxf(g[e], 1e-30f) * __builtin_amdgcn_rcpf(fmaxf(gn[e], 1e-30f));
#pragma unroll
                    for (int e = 0; e < 4; ++e) { acc[ai][bj][m][0][e] *= g[e]; acc[ai][bj][m][1][e] *= g[4 + e]; } } }
            else {
#pragma unroll
                for (int q = 0; q < 4; ++q) { const int m = 2 * mh + (q >> 1), bj = q & 1; float g[8], v[8]; unpack8(gq[q], g);
#pragma unroll
                    for (int e = 0; e < 4; ++e) { v[e] = fmaxf(g[e], 1e-30f) * acc[ai][bj][m][0][e]; v[4 + e] = fmaxf(g[4 + e], 1e-30f) * acc[ai][bj][m][1][e]; }
                    u32x4 w; w.x = pk2(v[0], v[1]); w.y = pk2(v[2], v[3]); w.z = pk2(v[4], v[5]); w.w = pk2(v[6], v[7]);
                    *(GAS u32x4*)(Mb + (size_t)(row0 + ai * 128 + m * 16) * D + col0 + bj * 128) = w; } } }
    }
};
struct EpiResid { static constexpr bool PERM = false, AFTER_DRAIN = false;
    const float* xold; float* xnew; const float* gt;
    __device__ __forceinline__ void operator()(const f32x4 (&acc)[2][2][4][2], const Unit& u, int wr, int wc, int fr, int fq) const {
        const int row0 = u.pm * 256 + wr * 64 + fr, col0 = u.pn * 256 + wc * 32 + 4 * fq;
        f32x4 gv[2][2];
#pragma unroll
        for (int bj = 0; bj < 2; ++bj)
#pragma unroll
            for (int n = 0; n < 2; ++n) gv[bj][n] = *(const GAS f32x4*)(gt + col0 + bj * 128 + n * 16);
#pragma unroll
        for (int qa = 0; qa < 4; ++qa) { const int ai = qa >> 1, mh = qa & 1; f32x4 xo[2][2][2];
#pragma unroll
            for (int mm = 0; mm < 2; ++mm)
#pragma unroll
                for (int bj = 0; bj < 2; ++bj)
#pragma unroll
                    for (int n = 0; n < 2; ++n) xo[mm][bj][n] = *(const GAS f32x4*)(xold + (size_t)(row0 + ai * 128 + (2 * mh + mm) * 16) * D + col0 + bj * 128 + n * 16);
#pragma unroll
            for (int mm = 0; mm < 2; ++mm)
#pragma unroll
                for (int bj = 0; bj < 2; ++bj)
#pragma unroll
                    for (int n = 0; n < 2; ++n) *(GAS f32x4*)(xnew + (size_t)(row0 + ai * 128 + (2 * mh + mm) * 16) * D + col0 + bj * 128 + n * 16) = xo[mm][bj][n] + gv[bj][n] * acc[ai][bj][2 * mh + mm][n]; }
    }
};
struct EpiHid { static constexpr bool PERM = true, AFTER_DRAIN = false;
    bf16_t* HID;
    __device__ __forceinline__ void operator()(const f32x4 (&acc)[2][2][4][2], const Unit& u, int wr, int wc, int fr, int fq) const {
        const int row0 = u.pm * 256 + wr * 64 + fr, col0 = (u.pn & 7) * 128 + wc * 32 + 8 * fq;
#pragma unroll
        for (int ai = 0; ai < 2; ++ai)
#pragma unroll
            for (int m = 0; m < 4; ++m) { float v[8];
#pragma unroll
                for (int e = 0; e < 4; ++e) { v[e] = siluf_(acc[ai][0][m][0][e]) * acc[ai][1][m][0][e]; v[4 + e] = siluf_(acc[ai][0][m][1][e]) * acc[ai][1][m][1][e]; }
                u32x4 w; w.x = pk2(v[0], v[1]); w.y = pk2(v[2], v[3]); w.z = pk2(v[4], v[5]); w.w = pk2(v[6], v[7]);
                *(GAS u32x4*)(HID + (size_t)(row0 + ai * 128 + m * 16) * FF + col0) = w; }
    }
};
struct EpiYe { static constexpr bool PERM = true, AFTER_DRAIN = false;
    bf16_t* YE; const float* gate;
    __device__ __forceinline__ void operator()(const f32x4 (&acc)[2][2][4][2], const Unit& u, int wr, int wc, int fr, int fq) const {
        const int row0 = u.pm * 256 + wr * 64 + fr, col0 = (u.pn & 3) * 256 + wc * 32 + 8 * fq;
        float gs[2][4];
#pragma unroll
        for (int ai = 0; ai < 2; ++ai)
#pragma unroll
            for (int m = 0; m < 4; ++m) gs[ai][m] = *(const GAS float*)(gate + row0 + ai * 128 + m * 16);
#pragma unroll
        for (int ai = 0; ai < 2; ++ai)
#pragma unroll
            for (int m = 0; m < 4; ++m) { const int row = row0 + ai * 128 + m * 16; const float gsc = gs[ai][m];
#pragma unroll
                for (int bj = 0; bj < 2; ++bj) { const f32x4 a = acc[ai][bj][m][0] * gsc, b = acc[ai][bj][m][1] * gsc;
                    u32x4 w; w.x = pk2(a[0], a[1]); w.y = pk2(a[2], a[3]); w.z = pk2(b[0], b[1]); w.w = pk2(b[2], b[3]);
                    *(GAS u32x4*)(YE + (size_t)row * D + col0 + bj * 128) = w; } }
    }
};
struct UEpi { static constexpr bool AFTER_DRAIN = false; int kind, l; unsigned char* ws; float* out; const float* xold;
    __device__ __forceinline__ bool carries() const { return kind == K_M1; }
    __device__ __forceinline__ bool keeps(const Unit& u) const { return kind == K_M1 && (u.pn >> 2) < 2; }
    __device__ __forceinline__ void carry(f32x4 (&acc)[2][2][4][2], const Unit& u, int wr, int wc, int fr, int fq) const {
        asm volatile("" : "+v"(fr), "+v"(fq));
        unsigned char* ws = this->ws; asm volatile("" : "+s"(ws));
        const EpiMerge e{(bf16_t*)(ws + WS_H), (const bf16_t*)(ws + WS_Z)}; e.carry(acc, u, wr, wc, fr, fq); }
    __device__ __forceinline__ void operator()(const f32x4 (&acc)[2][2][4][2], const Unit& u, int wr, int wc, int fr, int fq) const {
        asm volatile("" : "+v"(fr), "+v"(fq));
        unsigned char* ws = this->ws; float* out = this->out; const float* xold = this->xold; asm volatile("" : "+s"(ws), "+s"(out), "+s"(xold));
        if (kind == K_G1) { const EpiZ e{(bf16_t*)(ws + WS_Z), (const float*)(ws + OFF_ROPE), ws + WS_QB}; e(acc, u, wr, wc, fr, fq); }
        else if (kind == K_M1) { }
        else if (kind == K_M2) { const EpiResid e{xold, out, (const float*)(ws + OFF_MOD) + (size_t)l * 2 * 6144 + 2048}; e(acc, u, wr, wc, fr, fq); }
        else if (kind == K_E1) { const EpiHid e{(bf16_t*)(ws + WS_Z + ZO_HID)}; e(acc, u, wr, wc, fr, fq); }
        else { const EpiYe e{(bf16_t*)(ws + WS_Z + ZO_YE), (const float*)(ws + OFF_GATE)}; e(acc, u, wr, wc, fr, fq); }
    }
};
struct USched { int kind, c, G; const int* idx;
    __device__ __forceinline__ void a_ready(const Unit&) const {} __device__ __forceinline__ void done(const Unit&) const {}
    __device__ __forceinline__ const int* rows(const Unit& u) const { return idx + u.pm * 256; }
    __device__ __forceinline__ bool next(int i, Unit& u) const {
        if (kind == K_G1) {
            constexpr int nM = L / 256, nN = PROJ / 256, nwg = nM * nN; const long Lx = (long)i * G + c; if (Lx >= nwg) return false;
            int wgid = (int)Lx; { const int q = nwg / 8, r = nwg % 8, xcd = wgid % 8, off = wgid / 8; wgid = (xcd < r ? xcd * (q + 1) : r * (q + 1) + (xcd - r) * q) + off; }
            const int nig = 8 * nN, gid = wgid / nig, fm = gid * 8, gsz = (nM - fm) < 8 ? (nM - fm) : 8; u.pm = fm + ((wgid % nig) % gsz); u.pn = (wgid % nig) / gsz; return true; }
        if (kind == K_M1) { const int rnd = i / 3, j = i - 3 * rnd; const int t = rnd * G + c; if (t >= 256) return false;
            const int T = (t & 7) * 32 + (t >> 3); u.pm = 65 * j + (T >> 2); u.pn = 4 * j + (T & 3); return true; }
        if (kind == K_M2) { const int t = i * G + c; if (t >= 256) return false; const int T = (t & 7) * 32 + (t >> 3); u.pm = T >> 2; u.pn = T & 3; return true; }
        if (kind == K_E1) { const int t = i * G + c; if (t >= 1024) return false; const int x = t & 7, q = t >> 3;
            const int e = 2 * x + (q >> 6), ui = q & 63; u.pm = 9 * e + (ui >> 3); u.pn = 8 * e + (ui & 7); return true; }
        { const int t = i * G + c; if (t >= 512) return false; const int x = t & 7, q = t >> 3;
            const int e = 2 * x + (q >> 5), ui = q & 31; u.pm = 9 * e + (ui >> 2); u.pn = 4 * e + (ui & 3); return true; }
    }
};

template <int NB>
__device__ __forceinline__ void wgemm_tile(const bf16_t* arow, const bf16_t* brow0, const bf16_t* brow1, int K, f32x16 (&acc)[NB]) {
#pragma unroll
    for (int b = 0; b < NB; ++b)
#pragma unroll
        for (int i = 0; i < 16; ++i) acc[b][i] = 0.f;
#pragma unroll 4
    for (int k0 = 0; k0 < K; k0 += 16) {
        const bf16x8 a = *(const bf16x8*)(arow + k0); const bf16x8 b0 = *(const bf16x8*)(brow0 + k0);
        acc[0] = __builtin_amdgcn_mfma_f32_32x32x16_bf16(b0, a, acc[0], 0, 0, 0);
        if constexpr (NB == 2) { const bf16x8 b1 = *(const bf16x8*)(brow1 + k0); acc[1] = __builtin_amdgcn_mfma_f32_32x32x16_bf16(b1, a, acc[1], 0, 0, 0); }
    }
}


#define GAS __attribute__((address_space(1)))
#define LAS __attribute__((address_space(3)))
typedef GAS unsigned gu32;
#define RLX_AGENT __ATOMIC_RELAXED, __HIP_MEMORY_SCOPE_AGENT
#define LDS_WAIT() asm volatile("s_waitcnt lgkmcnt(0)" ::: "memory")
#define VM_WAIT() asm volatile("s_waitcnt vmcnt(0)" ::: "memory")
#define XB_TMO      128
#define XB_XCNT(j)  (256  + 64 * (j))
#define XB_XSUB(j)  (1280 + 64 * (j))
#define XB_XGEN(j)  (2304 + 64 * (j))
#define XB_TOP      3328
#define XB_TOPGEN   3392
#define XCD_BAR_WORDS 3456
#define XB_SPIN_CAP (1u << 24)

__device__ __forceinline__ unsigned xb_ld(unsigned* p)              { return __hip_atomic_load(p, __ATOMIC_RELAXED, __HIP_MEMORY_SCOPE_AGENT); }
__device__ __forceinline__ unsigned xb_add(unsigned* p, unsigned v) { return __hip_atomic_fetch_add(p, v, __ATOMIC_RELAXED, __HIP_MEMORY_SCOPE_AGENT); }
__device__ __forceinline__ unsigned xb_xcc_id() { return (unsigned)__builtin_amdgcn_s_getreg((3 << 11) | 20) & 0xFu; }
#define XB_SPIN(cond, bar) do { unsigned _sp = 0; while (cond) { __builtin_amdgcn_s_sleep(1); \
    if ((++_sp & 255u) == 0u) { if (xb_ld(&(bar)[XB_TMO])) break; if (_sp > XB_SPIN_CAP) { atomicAdd(&(bar)[XB_TMO], 1u); break; } } } } while (0)

struct XcdBarrier {
    unsigned* bar; unsigned x;
    volatile LAS unsigned* st;
};

__device__ __forceinline__ XcdBarrier xcd_barrier_post(unsigned* bar, volatile LAS unsigned* st) {
    XcdBarrier b; b.bar = bar; b.x = xb_xcc_id(); b.st = st;
    if (threadIdx.x == 0) (void)xb_add(&bar[XB_XCNT(b.x)], 1u);
    return b;
}
__device__ __forceinline__ void xcd_barrier_complete(unsigned* bar, unsigned x, unsigned& nloc, unsigned& nx) {
    const unsigned G = gridDim.x * gridDim.y * gridDim.z;
    unsigned sum, cnt, mine, sp = 0u;
    for (;;) {
        sum = 0u; cnt = 0u; mine = 0u;
#pragma unroll
        for (unsigned j = 0; j < 16; ++j) { const unsigned c = xb_ld(&bar[XB_XCNT(j)]); sum += c; cnt += (c > 0u) ? 1u : 0u; mine = (j == x) ? c : mine; }
        if (sum == G) break;
        __builtin_amdgcn_s_sleep(1);
        if ((++sp & 255u) == 0u) { if (xb_ld(&bar[XB_TMO])) break; if (sp > XB_SPIN_CAP) { atomicAdd(&bar[XB_TMO], 1u); break; } }
    }
    nloc = mine > 0u ? mine : 1u; nx = cnt > 0u ? cnt : 1u;
}

__device__ __forceinline__ void xcd_barrier(const XcdBarrier& b, const int tid) {
    asm volatile("s_waitcnt vmcnt(0)" ::: "memory");
    __syncthreads();
    if (tid == 0) {
        unsigned* bar = b.bar;
        __builtin_amdgcn_s_waitcnt(0);
        unsigned nloc = b.st[0], nx = b.st[1];
        if (nloc == 0u) { xcd_barrier_complete(bar, b.x, nloc, nx); b.st[0] = nloc; b.st[1] = nx; }
        const unsigned old = xb_add(&bar[XB_XSUB(b.x)], 1u);
        const unsigned gen = old / nloc;
        if (old + 1u == (gen + 1u) * nloc) {
            __builtin_amdgcn_fence(__ATOMIC_RELEASE, "agent");
            asm volatile("s_waitcnt vmcnt(0)" ::: "memory");
            const unsigned og = xb_add(&bar[XB_TOP], 1u);
            const unsigned tg = og / nx;
            if (og + 1u == (tg + 1u) * nx) xb_add(&bar[XB_TOPGEN], 1u);
            else XB_SPIN(xb_ld(&bar[XB_TOPGEN]) == tg, bar);
            __builtin_amdgcn_fence(__ATOMIC_ACQUIRE, "agent");
            xb_add(&bar[XB_XGEN(b.x)], 1u);
            asm volatile("s_waitcnt vmcnt(0)" ::: "memory");
        } else {
            XB_SPIN(xb_ld(&bar[XB_XGEN(b.x)]) == gen, bar);
            __builtin_amdgcn_fence(__ATOMIC_ACQUIRE, "agent");
            asm volatile("s_waitcnt vmcnt(0)" ::: "memory");
        }
    }
    __syncthreads();
}


namespace da {
typedef short s16x4 __attribute__((ext_vector_type(4)));
constexpr int KSLOT = 16384, VOFF = 4 * KSLOT, WSF_OFF = 132096;
constexpr float THR = 8.f;
__device__ __forceinline__ int crow(int r, int hi) { return (r & 3) + 8 * (r >> 2) + 4 * hi; }
__device__ __forceinline__ s16x4 vtr(const LAS unsigned char* p) { return __builtin_bit_cast(s16x4, __builtin_amdgcn_ds_read_tr16_b64_v4i16((LAS s16x4*)p)); }
__device__ __forceinline__ float max3f(float a, float b, float c) { return fmaxf(fmaxf(a, b), c); }
__device__ __forceinline__ unsigned cvtpk(float lo, float hi) { typedef float f2 __attribute__((ext_vector_type(2))); typedef __bf16 b2 __attribute__((ext_vector_type(2))); f2 v = {lo, hi}; b2 b = __builtin_convertvector(v, b2); return __builtin_bit_cast(unsigned, b); }

__device__ __forceinline__ void issue_piece(LAS unsigned char* lds_dst, const bf16_t* tile, int p, unsigned lane16) {
    __builtin_amdgcn_global_load_lds((const unsigned*)((const char*)(tile + p * 512) + lane16), (LAS unsigned*)(lds_dst + p * 1024), 16, 0, 0);
}
#define DA_ISSUE_K(tl, slot, i) issue_piece(lds + (slot) * KSLOT, KBh + (size_t)(tl) * 8192, 2 * wave + (i), lane16)
#define DA_ISSUE_V(tl, slot, i) issue_piece(lds + VOFF + (slot) * KSLOT, VBh + (size_t)(tl) * 8192, 2 * wave + (i), lane16)
#define DA_SYNC() do { asm volatile("s_waitcnt vmcnt(0) lgkmcnt(0)" ::: "memory"); __builtin_amdgcn_s_barrier(); asm volatile("" ::: "memory"); } while (0)
#define DA_SYNC4() do { asm volatile("s_waitcnt vmcnt(8) lgkmcnt(0)" ::: "memory"); __builtin_amdgcn_s_barrier(); asm volatile("" ::: "memory"); } while (0)
#define DA_SBAR() __builtin_amdgcn_sched_barrier(0)
#ifndef DA_ISSUE_AT
#define DA_ISSUE_AT 3
#endif
#if DA_ISSUE_AT == 1
#define DA_IA(x) x
#define DA_IE(x) do {} while (0)
#elif DA_ISSUE_AT == 3
#define DA_IA(x) do {} while (0)
#define DA_IE(x) x
#else
#define DA_IA(x) do {} while (0)
#define DA_IE(x) do {} while (0)
#endif
#ifndef DA_STAT
#define DA_STAT 0
#endif
#if DA_STAT
#define DA_T(k) do { DA_SBAR(); unsigned long long t_; asm volatile("s_memtime %0\n\ts_waitcnt lgkmcnt(0)" : "=s"(t_) :: "memory"); DA_SBAR(); if ((k) == DA_STAT) stat_acc -= t_; if ((k) == DA_STAT + 1) stat_acc += t_; } while (0)
#else
#define DA_T(k) do {} while (0)
#endif
#define DA_PIN(x) asm volatile("" : "+v"(x))
#define DA_EX(v) __builtin_amdgcn_exp2f(v)
#define DA_MF(a, b, c) __builtin_amdgcn_mfma_f32_32x32x16_bf16(a, b, c, 0, 0, 0)
#define DA_PKW(P, B) cvtpk(P[B], P[B + 1])
#define DA_VF(s) (bf16x8){vl##s[0], vl##s[1], vl##s[2], vl##s[3], vh##s[0], vh##s[1], vh##s[2], vh##s[3]}
#define DA_VRD(s, i) do { vl##s = vtr(vp_ + ((i) & 3) * 4096 + ((i) >> 2) * 1024); vh##s = vtr(vp_ + ((i) & 3) * 4096 + ((i) >> 2) * 1024 + 512); } while (0)
#define DA_KRD(j) do { kf[j] = *(const LAS bf16x8*)(kp_ + ((j) >> 1) * 2048 + ((j) & 1) * 512); } while (0)
#define DA_GAPA(MF) do { MF; DA_SBAR(); } while (0)
#define DA_PVG(j, s, PPk) do { o[(j) & 3] = DA_MF(__builtin_bit_cast(bf16x8, PPk), DA_VF(s), o[(j) & 3]); if ((j) + 4 < 16) DA_VRD(s, (j) + 4); } while (0)
#define DA_GAPM(j, s, PPk, X, B) do { DA_PVG(j, s, PPk); ma_ = max3f(ma_, X[B], X[B + 1]); mb_ = max3f(mb_, X[B + 2], X[B + 3]); ma_ = max3f(ma_, X[B + 4], X[B + 5]); mb_ = max3f(mb_, X[B + 6], X[B + 7]); DA_SBAR(); } while (0)
#define DA_PAIR(X, B, PCk, w) do { X[B] = DA_EX(X[B]); X[B + 1] = DA_EX(X[B + 1]); sacc += X[B]; sacc += X[B + 1]; PCk[w] = cvtpk(X[B], X[B + 1]); } while (0)
#define DA_EXS(X, B) do { X[B] = DA_EX(X[B]); X[B + 1] = DA_EX(X[B + 1]); sacc += X[B]; sacc += X[B + 1]; } while (0)
#define DA_GAPB2(j, s, PPk, X, B, PCk, w, Y, B2) do { DA_PVG(j, s, PPk); DA_PAIR(X, B, PCk, w); DA_EXS(Y, B2); DA_SBAR(); } while (0)
#define DA_GAPB1(j, s, PPk, X, B, PCk, w) do { DA_PVG(j, s, PPk); DA_PAIR(X, B, PCk, w); DA_SBAR(); } while (0)
#define DA_DECIDE(FIRST, C0, C1, PP1, PP2, PP3) do { \
    float rm_ = fmaxf(ma_, mb_); { const auto rr_ = __builtin_amdgcn_permlane32_swap(__float_as_uint(rm_), __float_as_uint(rm_), false, false); rm_ = fmaxf(__uint_as_float(rr_[0]), __uint_as_float(rr_[1])); } \
    if (FIRST || __any(rm_ > THR)) {              \
        const float dl_ = FIRST ? rm_ : fmaxf(rm_, 0.f), f_ = FIRST ? 0.f : DA_EX(-dl_); lsum *= f_; \
        if (hi == 0) wsf[r32] = f_; \
        _Pragma("unroll") for (int g = 0; g < 4; ++g) { const f32x4 fr_ = *(const LAS f32x4*)(wsf + 8 * g + 4 * hi); \
            _Pragma("unroll") for (int i = 0; i < 4; ++i) _Pragma("unroll") for (int d0 = 0; d0 < 4; ++d0) o[d0][4 * g + i] *= fr_[i]; } \
        _Pragma("unroll") for (int i = 0; i < 4; ++i) { PP1[i] = cvtpk(__uint_as_float(PP1[i] << 16) * f_, __uint_as_float(PP1[i] & 0xffff0000u) * f_); \
            PP2[i] = cvtpk(__uint_as_float(PP2[i] << 16) * f_, __uint_as_float(PP2[i] & 0xffff0000u) * f_); PP3[i] = cvtpk(__uint_as_float(PP3[i] << 16) * f_, __uint_as_float(PP3[i] & 0xffff0000u) * f_); } \
        _Pragma("unroll") for (int i = 0; i < 16; ++i) { C0[i] -= dl_; C1[i] -= dl_; negm[i] -= dl_; } } \
    DA_SBAR(); } while (0)
#define DA_STEP(tt, FIRST) do { \
    DA_T(1); DA_SYNC4(); DA_T(2); \
    const int m3_ = (tt) & 3, tk_ = (tt) + 4 < NT ? (tt) + 4 : NT - 1, tv_ = (tt) + 2 < NT ? (tt) + 2 : NT - 1;     \
    const int vs_ = ((tt) + 2) & 3, vr_ = ((tt) + 3) & 3, kn_ = ((tt) + 1) & 3; \
    const LAS unsigned char* vp_ = lds + VOFF + vr_ * KSLOT + voff; const LAS unsigned char* kp_ = lds + kn_ * KSLOT + koff; \
    DA_IA(DA_ISSUE_K(kbt + tk_, m3_, 0)); DA_IA(DA_ISSUE_K(kbt + tk_, m3_, 1)); DA_IA(DA_ISSUE_V(kbt + tv_, vs_, 0)); DA_IA(DA_ISSUE_V(kbt + tv_, vs_, 1)); DA_T(3); \
    DA_GAPA(C0 = DA_MF(kf[0], qf[0], negm)); DA_GAPA(C1 = DA_MF(kf[1], qf[0], negm)); \
    DA_GAPA(C0 = DA_MF(kf[2], qf[1], C0)); DA_GAPA(C1 = DA_MF(kf[3], qf[1], C1)); \
    DA_VRD(0, 0); DA_GAPA(C0 = DA_MF(kf[4], qf[2], C0)); DA_VRD(1, 1); DA_GAPA(C1 = DA_MF(kf[5], qf[2], C1)); \
    DA_VRD(2, 2); DA_GAPA(C0 = DA_MF(kf[6], qf[3], C0)); DA_VRD(3, 3); DA_GAPA(C1 = DA_MF(kf[7], qf[3], C1)); \
    DA_T(4); float sacc = 0.f, ma_ = -3.0e38f, mb_ = -3.0e38f; \
    DA_GAPM(0, 0, pw0, C0, 0); DA_GAPM(1, 1, pw0, C0, 8); DA_KRD(0); DA_GAPM(2, 2, pw0, C1, 0); DA_KRD(1); DA_GAPM(3, 3, pw0, C1, 8); \
    DA_DECIDE(FIRST, C0, C1, pw1, pw2, pw3); DA_T(5); \
      \
    DA_KRD(2); DA_GAPB1(4, 0, pw1, C0, 0, pw0, 0); DA_KRD(3); DA_GAPB1(5, 1, pw1, C0, 2, pw0, 1); DA_KRD(4); DA_GAPB1(6, 2, pw1, C0, 4, pw0, 2); DA_KRD(5); DA_GAPB1(7, 3, pw1, C0, 6, pw0, 3); \
    DA_KRD(6); DA_GAPB1(8, 0, pw2, C0, 8, pw1, 0); DA_KRD(7); DA_GAPB1(9, 1, pw2, C0, 10, pw1, 1); DA_GAPB1(10, 2, pw2, C0, 12, pw1, 2); DA_GAPB1(11, 3, pw2, C0, 14, pw1, 3); \
    DA_GAPB2(12, 0, pw3, C1, 0, pw2, 0, C1, 8); DA_GAPB2(13, 1, pw3, C1, 2, pw2, 1, C1, 10); DA_GAPB2(14, 2, pw3, C1, 4, pw2, 2, C1, 12); DA_GAPB2(15, 3, pw3, C1, 6, pw2, 3, C1, 14); \
    pw3[0] = cvtpk(C1[8], C1[9]); pw3[1] = cvtpk(C1[10], C1[11]); pw3[2] = cvtpk(C1[12], C1[13]); pw3[3] = cvtpk(C1[14], C1[15]); \
    DA_IE(DA_ISSUE_K(kbt + tk_, m3_, 0)); DA_IE(DA_ISSUE_K(kbt + tk_, m3_, 1)); DA_IE(DA_ISSUE_V(kbt + tv_, vs_, 0)); DA_IE(DA_ISSUE_V(kbt + tv_, vs_, 1)); \
    lsum += sacc; DA_T(6); \
    } while (0)

__device__ __forceinline__ void unit(LAS unsigned char* lds, const bf16_t* QBh, const bf16_t* KBh, const bf16_t* VBh, int q0, int kbase, int NT, float lam, const float* subg, float oscale, bf16_t* Yh, int wave, int lane, float* statp) {
    asm volatile("" : "+v"(lane));
    const int c = wave >> 2, s = wave & 3, r32 = lane & 31, hi = lane >> 5;
    LAS float* wsf = (LAS float*)(lds + WSF_OFF) + wave * 64;
    const int kbt = kbase >> 6;
    const unsigned lane16 = (unsigned)lane * 16u;
    DA_ISSUE_K(kbt, 0, 0); DA_ISSUE_K(kbt, 0, 1);
    DA_ISSUE_K(kbt + 1, 1, 0); DA_ISSUE_K(kbt + 1, 1, 1); DA_ISSUE_V(kbt, 3, 0); DA_ISSUE_V(kbt, 3, 1);
    DA_ISSUE_K(kbt + 2, 2, 0); DA_ISSUE_K(kbt + 2, 2, 1); DA_ISSUE_V(kbt, 0, 0); DA_ISSUE_V(kbt, 0, 1);
    DA_ISSUE_K(kbt + 3, 3, 0); DA_ISSUE_K(kbt + 3, 3, 1); DA_ISSUE_V(kbt + 1, 1, 0); DA_ISSUE_V(kbt + 1, 1, 1);
    bf16x8 qf[4];
#pragma unroll
    for (int d0 = 0; d0 < 4; ++d0) qf[d0] = *(const bf16x8*)(QBh + (size_t)(q0 + s * 32 + r32) * 128 + c * 64 + d0 * 16 + hi * 8);
    f32x16 o[4]; f32x16 C0, C1;
#pragma unroll
    for (int i = 0; i < 16; ++i) {
#pragma unroll
        for (int d0 = 0; d0 < 4; ++d0) o[d0][i] = 0.f; }
    float lsum = 0.f; f32x16 negm;
    { float z_ = 0.f; asm volatile("" : "+v"(z_));
#pragma unroll
    for (int i = 0; i < 16; ++i) negm[i] = z_; }
    asm volatile("" : "+v"(negm));
    unsigned long long stat_acc = 0ull; (void)stat_acc;
    const int koff = c * 8192 + hi * 1024 + r32 * 16, voff = ((lane >> 4) & 1) * 32 + (lane & 3) * 8 + (4 * hi + ((lane & 15) >> 2)) * 64;
    bf16x8 kf[8]; u32x4 pw0, pw1, pw2, pw3; pw0 = pw1 = pw2 = pw3 = (u32x4){0u, 0u, 0u, 0u}; s16x4 vl0, vh0, vl1, vh1, vl2, vh2, vl3, vh3;
    asm volatile("s_waitcnt vmcnt(12)" ::: "memory"); __builtin_amdgcn_s_barrier(); asm volatile("" ::: "memory");
    { const LAS unsigned char* kp_ = lds + koff;
#pragma unroll
      for (int j = 0; j < 8; ++j) DA_KRD(j); }
    DA_STEP(0, true);
#pragma unroll 1
    for (int t = 1; t < NT; ++t) DA_STEP(t, false);
#if DA_STAT
    if (statp && lane == 0) *statp = 400.f * floorf((float)((double)(long long)stat_acc / (double)NT) * (1.f / 400.f) + 0.5f);
#endif
    { DA_SYNC();
      const LAS unsigned char* vp_ = lds + VOFF + ((NT - 1) & 3) * KSLOT + voff;
#pragma unroll
      for (int jj = 0; jj < 16; ++jj) { DA_VRD(0, jj); const u32x4 pk = (jj >> 2) == 0 ? pw0 : (jj >> 2) == 1 ? pw1 : (jj >> 2) == 2 ? pw2 : pw3; o[jj & 3] = DA_MF(__builtin_bit_cast(bf16x8, pk), DA_VF(0), o[jj & 3]); } }
    { const auto rr = __builtin_amdgcn_permlane32_swap(__float_as_uint(lsum), __float_as_uint(lsum), false, false); lsum = __uint_as_float(rr[0]) + __uint_as_float(rr[1]); }
    if (hi == 0) wsf[r32] = 1.f / lsum;
#pragma unroll
    for (int g = 0; g < 4; ++g) { const f32x4 fr = *(const LAS f32x4*)(wsf + 8 * g + 4 * hi);
#pragma unroll
        for (int i = 0; i < 4; ++i)
#pragma unroll
            for (int d0 = 0; d0 < 4; ++d0) o[d0][4 * g + i] *= fr[i]; }
    DA_SYNC();
    LAS float* X = (LAS float*)lds + s * 4096;
    if (c == 1) {
#pragma unroll
        for (int d0 = 0; d0 < 4; ++d0)
#pragma unroll
            for (int i = 0; i < 16; ++i) X[(d0 * 16 + i) * 64 + lane] = o[d0][i]; }
    DA_SYNC();
    if (c == 0) {
        float ss[16];
#pragma unroll
        for (int i = 0; i < 16; ++i) ss[i] = 0.f;
#pragma unroll
        for (int d0 = 0; d0 < 4; ++d0)
#pragma unroll
            for (int i = 0; i < 16; ++i) { const float d = o[d0][i] - lam * X[(d0 * 16 + i) * 64 + lane]; o[d0][i] = d; ss[i] += d * d; }
#pragma unroll
        for (int i = 0; i < 16; ++i) { float v = ss[i]; v += xorf_<1>(v); v += xorf_<2>(v); v += xorf_<4>(v); v += xorf_<8>(v); v += xorf_<16>(v); ss[i] = rsqrtf(v * (1.f / 128.f) + EPS) * oscale; }
        float gsub[4];
#pragma unroll
        for (int d0 = 0; d0 < 4; ++d0) gsub[d0] = subg[d0 * 32 + r32];
#pragma unroll
        for (int i = 0; i < 16; ++i) { bf16_t* yr = Yh + (size_t)(q0 + s * 32 + crow(i, hi)) * 512 + r32;
#pragma unroll
            for (int d0 = 0; d0 < 4; ++d0) yr[d0 * 32] = f2bf(o[d0][i] * ss[i] * gsub[d0]); }
    }
    DA_SYNC();
}
}


namespace na {
using da::crow; using da::vtr; using da::cvtpk; using da::s16x4;
constexpr int NA_OFF = 132096, NA_WS = 2304;
constexpr float LOG2E = 1.4426950408889634f;
__device__ __forceinline__ void dma8(LAS unsigned char* dst, const bf16_t* src, unsigned lane16) {
    const unsigned d0 = (unsigned)__builtin_amdgcn_readfirstlane((int)(unsigned)(uintptr_t)dst);
    const unsigned long long s0 = (unsigned long long)(uintptr_t)src;
    const unsigned slo = (unsigned)__builtin_amdgcn_readfirstlane((int)(unsigned)s0), shi = (unsigned)__builtin_amdgcn_readfirstlane((int)(unsigned)(s0 >> 32));
#pragma unroll
    for (int j = 0; j < 8; ++j) { const unsigned long long g = (((unsigned long long)shi << 32) | slo) + (unsigned long long)(j * 1024); const unsigned d = d0 + j * 1024; unsigned keep;
        asm volatile("s_mov_b32 %0, m0\n\ts_mov_b32 m0, %2\n\ts_nop 2\n\tglobal_load_lds_dwordx4 %1, %3\n\ts_mov_b32 m0, %0" : "=&s"(keep) : "v"(lane16), "s"(d), "s"(g) : "memory"); }
}
__device__ __forceinline__ void qk_softmax(const LAS unsigned char* kb, const bf16x8 (&qf)[4], bool win, int qc, unsigned vm0, unsigned vm1, const LAS float* bias2, int drow, LAS float* wsf, int r32, int hi,
                                           f32x16 (&o)[2], float& m, float& l, bf16x8 (&pa)[4]) {
    asm volatile("" : "+v"(qc), "+v"(vm0), "+v"(vm1));
    f32x16 p0, p1;
    if (!win) {
#pragma unroll
        for (int i = 0; i < 16; ++i) { p0[i] = 0.f; p1[i] = 0.f; }
    } else {
        const LAS float* bl = bias2 + (drow + 15 + 4 * hi - qc);
#pragma unroll
        for (int i = 0; i < 16; ++i) { const int kc = 8 * (i >> 2) + (i & 3);
            const unsigned t0 = (unsigned)__builtin_amdgcn_sbfe((int)vm0, i, 1), t1 = (unsigned)__builtin_amdgcn_sbfe((int)vm1, i, 1);
            p0[i] = __uint_as_float((t0 & __float_as_uint(bl[kc])) | (~t0 & 0xf149f2cau)); p1[i] = __uint_as_float((t1 & __float_as_uint(bl[kc + 32])) | (~t1 & 0xf149f2cau)); } }
#pragma unroll
    for (int d0 = 0; d0 < 4; ++d0) { const bf16x8 b0 = *(const LAS bf16x8*)(kb + d0 * 2048), b1 = *(const LAS bf16x8*)(kb + d0 * 2048 + 512);
        p0 = __builtin_amdgcn_mfma_f32_32x32x16_bf16(b0, qf[d0], p0, 0, 0, 0); p1 = __builtin_amdgcn_mfma_f32_32x32x16_bf16(b1, qf[d0], p1, 0, 0, 0); }
    float rm = -1e30f;
#pragma unroll
    for (int i = 0; i < 16; ++i) rm = fmaxf(rm, fmaxf(p0[i], p1[i]));
    { const auto rr = __builtin_amdgcn_permlane32_swap(__float_as_uint(rm), __float_as_uint(rm), false, false); rm = fmaxf(__uint_as_float(rr[0]), __uint_as_float(rr[1])); }
    const float nm = fmaxf(m, rm), f = __builtin_amdgcn_exp2f(m - nm); m = nm; l *= f;
    if (hi == 0) wsf[r32] = f;
    float sum = 0.f;
#pragma unroll
    for (int i = 0; i < 16; ++i) { p0[i] = __builtin_amdgcn_exp2f(p0[i] - nm); p1[i] = __builtin_amdgcn_exp2f(p1[i] - nm); sum += p0[i] + p1[i]; }
    l += sum;
#pragma unroll
    for (int g = 0; g < 4; ++g) { const f32x4 fr = *(const LAS f32x4*)(wsf + 8 * g + 4 * hi);
#pragma unroll
        for (int i = 0; i < 4; ++i) { o[0][4 * g + i] *= fr[i]; o[1][4 * g + i] *= fr[i]; } }
    u32x4 w;
    w.x = cvtpk(p0[0], p0[1]); w.y = cvtpk(p0[2], p0[3]); w.z = cvtpk(p0[4], p0[5]); w.w = cvtpk(p0[6], p0[7]); pa[0] = __builtin_bit_cast(bf16x8, w);
    w.x = cvtpk(p0[8], p0[9]); w.y = cvtpk(p0[10], p0[11]); w.z = cvtpk(p0[12], p0[13]); w.w = cvtpk(p0[14], p0[15]); pa[1] = __builtin_bit_cast(bf16x8, w);
    w.x = cvtpk(p1[0], p1[1]); w.y = cvtpk(p1[2], p1[3]); w.z = cvtpk(p1[4], p1[5]); w.w = cvtpk(p1[6], p1[7]); pa[2] = __builtin_bit_cast(bf16x8, w);
    w.x = cvtpk(p1[8], p1[9]); w.y = cvtpk(p1[10], p1[11]); w.z = cvtpk(p1[12], p1[13]); w.w = cvtpk(p1[14], p1[15]); pa[3] = __builtin_bit_cast(bf16x8, w);
}
__device__ __forceinline__ void pv2(f32x16 (&o)[2], const LAS unsigned char* vp, const bf16x8 (&pa)[4]) {
#pragma unroll
    for (int d0 = 0; d0 < 2; ++d0)
#pragma unroll
        for (int ks = 0; ks < 4; ++ks) { const s16x4 lo = vtr(vp + d0 * 4096 + ks * 1024), h8 = vtr(vp + d0 * 4096 + ks * 1024 + 512);
            const bf16x8 vf = {lo[0], lo[1], lo[2], lo[3], h8[0], h8[1], h8[2], h8[3]};
            o[d0] = __builtin_amdgcn_mfma_f32_32x32x16_bf16(pa[ks], vf, o[d0], 0, 0, 0); }
}
__device__ __forceinline__ void unit(LAS unsigned char* lds, const bf16_t* Z, const bf16_t* KAh, const bf16_t* VAh, const float* rpb_h, int qrow0, int r, int h, bf16_t* Yh, int wave, int lane) {
    asm volatile("" : "+v"(lane));
    const int r32 = lane & 31, hi = lane >> 5; const unsigned lane16 = (unsigned)lane * 16u;
    LAS unsigned char* wl = lds + wave * 16384;
    LAS float* bias2 = (LAS float*)(lds + NA_OFF + wave * NA_WS); LAS float* wsf = bias2 + 480;
    int r0 = 0;
    if (r >= 0) { r0 = r - 4; r0 = r0 < 0 ? 0 : (r0 > 248 ? 248 : r0);
        for (int i = lane; i < 480; i += 64) { const int dr = i >> 5, dc = i & 31; bias2[i] = dc < 31 ? rpb_h[dr * 31 + dc] * LOG2E : 0.f; } }
    const LAS unsigned char* kb = wl + hi * 1024 + r32 * 16; const LAS unsigned char* vp = wl + 8192 + ((lane >> 4) & 1) * 32 + (lane & 3) * 8 + (4 * hi + ((lane & 15) >> 2)) * 64;
    const int nt = r >= 0 ? 12 : 4;
    bf16x8 qf0[4], qf1[4];
#pragma unroll
    for (int d0 = 0; d0 < 4; ++d0) { qf0[d0] = *(const bf16x8*)(Z + (size_t)(qrow0 + r32) * PROJZ + ZQA + h * 64 + d0 * 16 + hi * 8); qf1[d0] = *(const bf16x8*)(Z + (size_t)(qrow0 + 32 + r32) * PROJZ + ZQA + h * 64 + d0 * 16 + hi * 8); }
    asm volatile("" :: "v"(qf0[0]), "v"(qf0[1]), "v"(qf0[2]), "v"(qf0[3]), "v"(qf1[0]), "v"(qf1[1]), "v"(qf1[2]), "v"(qf1[3]));
    asm volatile("s_waitcnt vmcnt(0) lgkmcnt(0)" ::: "memory");
    f32x16 o0[2], o1[2]; float m0 = -1e30f, l0 = 0.f, m1 = -1e30f, l1 = 0.f;
#pragma unroll
    for (int d0 = 0; d0 < 2; ++d0)
#pragma unroll
        for (int i = 0; i < 16; ++i) { o0[d0][i] = 0.f; o1[d0][i] = 0.f; }
    int c00 = r32 - 8; c00 = c00 < 0 ? 0 : c00; const int c01 = (32 + r32 - 8) > 48 ? 48 : (32 + r32 - 8);
    unsigned vma0 = 0, vma1 = 0, vmb0 = 0, vmb1 = 0;
#pragma unroll
    for (int i = 0; i < 16; ++i) { const int k = crow(i, hi);
        vma0 |= ((unsigned)(k - c00) < 16u ? 1u : 0u) << i; vma1 |= ((unsigned)(k + 32 - c00) < 16u ? 1u : 0u) << i; vmb0 |= ((unsigned)(k - c01) < 16u ? 1u : 0u) << i; vmb1 |= ((unsigned)(k + 32 - c01) < 16u ? 1u : 0u) << i; }
    { const int kt0 = r >= 0 || true ? L / 64 : 0; dma8(wl, KAh + (size_t)kt0 * 4096, lane16); dma8(wl + 8192, VAh + (size_t)kt0 * 4096, lane16); }
#pragma unroll 1
    for (int t = 0; t < nt; ++t) {
        const int tn = t + 1 < nt ? t + 1 : nt - 1; const int ktn = tn < 4 ? L / 64 + tn : r0 + tn - 4;
        const bool win = t >= 4; const int drow = win ? (r0 + t - 4 - r + 7) * 32 : 0;
        bf16x8 pa[4];
        asm volatile("s_waitcnt vmcnt(8)" ::: "memory");
        qk_softmax(kb, qf0, win, r32, vma0, vma1, bias2, drow, wsf, r32, hi, o0, m0, l0, pa);
        asm volatile("s_waitcnt vmcnt(0)" ::: "memory");
        pv2(o0, vp, pa);
        __builtin_amdgcn_sched_barrier(0);
        qk_softmax(kb, qf1, win, 32 + r32, vmb0, vmb1, bias2, drow, wsf, r32, hi, o1, m1, l1, pa);
        asm volatile("s_waitcnt lgkmcnt(0)" ::: "memory");
        dma8(wl, KAh + (size_t)ktn * 4096, lane16);
        pv2(o1, vp, pa);
        asm volatile("s_waitcnt lgkmcnt(0)" ::: "memory");
        dma8(wl + 8192, VAh + (size_t)ktn * 4096, lane16);
    }
    asm volatile("s_waitcnt vmcnt(0)" ::: "memory");
    { const auto rr = __builtin_amdgcn_permlane32_swap(__float_as_uint(l0), __float_as_uint(l0), false, false); l0 = __uint_as_float(rr[0]) + __uint_as_float(rr[1]); }
    { const auto rr = __builtin_amdgcn_permlane32_swap(__float_as_uint(l1), __float_as_uint(l1), false, false); l1 = __uint_as_float(rr[0]) + __uint_as_float(rr[1]); }
    if (hi == 0) { wsf[r32] = 1.f / l0; wsf[32 + r32] = 1.f / l1; }
#pragma unroll
    for (int g = 0; g < 4; ++g) { const f32x4 fa = *(const LAS f32x4*)(wsf + 8 * g + 4 * hi), fb = *(const LAS f32x4*)(wsf + 32 + 8 * g + 4 * hi);
#pragma unroll
        for (int i = 0; i < 4; ++i) { bf16_t* ya = Yh + (size_t)(qrow0 + crow(4 * g + i, hi)) * 512 + r32; bf16_t* yb = ya + (size_t)32 * 512;
            ya[0] = f2bf(o0[0][4 * g + i] * fa[i]); ya[32] = f2bf(o0[1][4 * g + i] * fa[i]); yb[0] = f2bf(o1[0][4 * g + i] * fb[i]); yb[32] = f2bf(o1[1][4 * g + i] * fb[i]); } }
    asm volatile("s_waitcnt lgkmcnt(0)" ::: "memory");
}
}

namespace gm {
using da::crow; using da::vtr; using da::cvtpk; using da::s16x4;
__device__ __forceinline__ void unit(LAS unsigned char* lds, const bf16_t* Z, const float* ln_g, const float* ln_b, const float* w_s, const float* b_s, int row0, bf16_t* Yc, int wave, int lane) {
    asm volatile("" : "+v"(lane));
    const int r32 = lane & 31, hi = lane >> 5;
    { u32x4 rw[16];
#pragma unroll
      for (int tk = 0; tk < 16; ++tk) rw[tk] = *(const u32x4*)(Z + (size_t)(row0 + wave * 16 + tk) * PROJZ + ZV + lane * 8);
      float sm[16];
#pragma unroll
      for (int tk = 0; tk < 16; ++tk) { float v[8]; unpack8(rw[tk], v); sm[tk] = ((v[0] + v[1]) + (v[2] + v[3])) + ((v[4] + v[5]) + (v[6] + v[7])); }
#define GM_RED16(X, OUT) do { float a8_[8], a4_[4], a2_[2]; \
        _Pragma("unroll") for (int i = 0; i < 8; ++i) { const bool h_ = (lane & 32) != 0; a8_[i] = (h_ ? X[8 + i] : X[i]) + xor32f_(h_ ? X[i] : X[8 + i], !h_); } \
        _Pragma("unroll") for (int i = 0; i < 4; ++i) { const bool h_ = (lane & 16) != 0; a4_[i] = (h_ ? a8_[4 + i] : a8_[i]) + xorf_<16>(h_ ? a8_[i] : a8_[4 + i]); } \
        _Pragma("unroll") for (int i = 0; i < 2; ++i) { const bool h_ = (lane & 8) != 0; a2_[i] = (h_ ? a4_[2 + i] : a4_[i]) + xorf_<8>(h_ ? a4_[i] : a4_[2 + i]); } \
        { const bool h_ = (lane & 4) != 0; OUT = (h_ ? a2_[1] : a2_[0]) + xorf_<4>(h_ ? a2_[0] : a2_[1]); } OUT += xorf_<2>(OUT); OUT += xorf_<1>(OUT); } while (0)
      float tot; GM_RED16(sm, tot); const float mean_l = tot * (1.f / 512.f);
      float mean[16];
#pragma unroll
      for (int tk = 0; tk < 16; ++tk) mean[tk] = __int_as_float(__builtin_amdgcn_readlane(__float_as_int(mean_l), 4 * tk));
#pragma unroll
      for (int tk = 0; tk < 16; ++tk) { float v[8]; unpack8(rw[tk], v); float q = 0.f;
#pragma unroll
          for (int i = 0; i < 8; ++i) { const float d = v[i] - mean[tk]; q += d * d; }
          sm[tk] = q; }
      float qt; GM_RED16(sm, qt); const float rstd_l = rsqrtf(qt * (1.f / 512.f) + EPS);
#undef GM_RED16
      float lg[8], lb[8];
#pragma unroll
      for (int i = 0; i < 8; ++i) { lg[i] = ln_g[lane * 8 + i]; lb[i] = ln_b[lane * 8 + i]; }
#pragma unroll
      for (int tk = 0; tk < 16; ++tk) { float v[8]; unpack8(rw[tk], v); const float rstd = __int_as_float(__builtin_amdgcn_readlane(__float_as_int(rstd_l), 4 * tk)), mu = mean[tk];
          u32x4 w; w.x = pk2((v[0] - mu) * rstd * lg[0] + lb[0], (v[1] - mu) * rstd * lg[1] + lb[1]); w.y = pk2((v[2] - mu) * rstd * lg[2] + lb[2], (v[3] - mu) * rstd * lg[3] + lb[3]);
          w.z = pk2((v[4] - mu) * rstd * lg[4] + lb[4], (v[5] - mu) * rstd * lg[5] + lb[5]); w.w = pk2((v[6] - mu) * rstd * lg[6] + lb[6], (v[7] - mu) * rstd * lg[7] + lb[7]);
          *(LAS u32x4*)(lds + ((lane >> 2) * 8 + wave) * 1024 + tk * 64 + (lane & 3) * 16) = w; } }
    __syncthreads();
    const int pb = wave & 3, chh = wave >> 2;
    const LAS unsigned char* vp = lds + ((lane >> 4) & 1) * 32 + (lane & 3) * 8 + (4 * hi + ((lane & 15) >> 2)) * 64;
#pragma unroll 1
    for (int gg = 0; gg < 2; ++gg) { const int g = 2 * chh + gg; const float* wrow = w_s + ((size_t)g * 128 + 32 * pb + r32) * 128;
        bf16x8 a[8];
        { f32x4 xw[16];
#pragma unroll
          for (int ks = 0; ks < 8; ++ks) { xw[2 * ks] = *(const GAS f32x4*)(wrow + 16 * ks + 4 * hi); xw[2 * ks + 1] = *(const GAS f32x4*)(wrow + 16 * ks + 8 + 4 * hi); }
#pragma unroll
          for (int ks = 0; ks < 8; ++ks) { const f32x4 x0 = xw[2 * ks], x1 = xw[2 * ks + 1];
            u32x4 w; w.x = cvtpk(x0[0], x0[1]); w.y = cvtpk(x0[2], x0[3]); w.z = cvtpk(x1[0], x1[1]); w.w = cvtpk(x1[2], x1[3]); a[ks] = __builtin_bit_cast(bf16x8, w); } }
        float bsv[16];
#pragma unroll
        for (int i = 0; i < 16; ++i) bsv[i] = b_s[g * 128 + 32 * pb + crow(i, hi)];
#pragma unroll 1
        for (int c4 = 0; c4 < 4; ++c4) { const int cb = g * 4 + c4; f32x16 acc;
            unsigned short uv[16];
#pragma unroll
            for (int i = 0; i < 16; ++i) uv[i] = *(const GAS unsigned short*)(Z + (size_t)(row0 + 32 * pb + crow(i, hi)) * PROJZ + ZU + cb * 32 + r32);
#pragma unroll
            for (int i = 0; i < 16; ++i) acc[i] = 0.f;
#pragma unroll
            for (int ks = 0; ks < 8; ++ks) { const s16x4 lo = vtr(vp + (cb * 8 + ks) * 1024), h8 = vtr(vp + (cb * 8 + ks) * 1024 + 512);
                const bf16x8 vf = {lo[0], lo[1], lo[2], lo[3], h8[0], h8[1], h8[2], h8[3]};
                acc = __builtin_amdgcn_mfma_f32_32x32x16_bf16(a[ks], vf, acc, 0, 0, 0); }
#pragma unroll
            for (int i = 0; i < 16; ++i) { const int row = row0 + 32 * pb + crow(i, hi), ch = cb * 32 + r32;
                *(GAS bf16_t*)(Yc + (size_t)row * 512 + ch) = f2bf(bf2f(uv[i]) * (acc[i] + bsv[i])); } } }
    __syncthreads();
}
}


constexpr int NWAVES = 8, NTHREADS = 512;
constexpr int RING_BYTES = 131072, LDSCTL_OFF = RING_BYTES, MISC_OFF = LDSCTL_OFF + 320, LDS_BYTES = 163840;
constexpr int CW_BAR = 4096;
constexpr int N_PHASES = 20;
#ifndef PROBE_KIND
#define PROBE_KIND (-1)
#define PROBE_N 1
#endif
#ifndef STAT_BID
#define STAT_BID 0
#define STAT_WAVE 0
#endif
#ifndef PROBE_NA
#define PROBE_NA 0
#endif
#ifndef PROBE_CTX
#define PROBE_CTX 0
#endif
#ifndef PROBE_GM
#define PROBE_GM 0
#endif
#ifndef PH_MASK
#define PH_MASK 0xFFFF
#endif
#define PH_ON(k) ((PH_MASK >> (k)) & 1)

__device__ __forceinline__ void p0_transpose_item(const float* W, int K, int N, bf16_t* WT, int mode, LAS unsigned short* scr, int item, int lane) {
    const int nblk = N / 64, kb = item / nblk, nb = item % nblk, k0 = 64 * kb, n0 = 64 * nb;
    const int lk = lane >> 4, ln = (lane & 15) * 4;
    f32x4 v[16];
#pragma unroll
    for (int i = 0; i < 16; ++i) v[i] = *(const f32x4*)(W + (size_t)(k0 + 4 * i + lk) * N + n0 + ln);
#pragma unroll
    for (int i = 0; i < 16; ++i) { const int kk = 4 * i + lk; const unsigned p01 = pk2(v[i][0], v[i][1]), p23 = pk2(v[i][2], v[i][3]);
        scr[(ln + 0) * 66 + kk] = (unsigned short)p01; scr[(ln + 1) * 66 + kk] = (unsigned short)(p01 >> 16); scr[(ln + 2) * 66 + kk] = (unsigned short)p23; scr[(ln + 3) * 66 + kk] = (unsigned short)(p23 >> 16); }
    LDS_WAIT(); asm volatile("" ::: "memory");
    const int c = lane & 7;
#pragma unroll
    for (int j = 0; j < 8; ++j) { const int n = (lane >> 3) + 8 * j; const LAS unsigned* s = (const LAS unsigned*)(scr + n * 66 + 8 * c); const int nn = n0 + n;
        const int row = mode == 0 ? nn : (256 * (nn >> 7) + (nn & 127) + (mode == 2 ? 128 : 0));
        u32x4 o; o.x = s[0]; o.y = s[1]; o.z = s[2]; o.w = s[3];
        *(GAS u32x4*)(WT + (size_t)row * K + k0 + 8 * c) = o; }
    LDS_WAIT(); asm volatile("" ::: "memory");
}
__device__ __forceinline__ void wg_dma4(LAS unsigned char* dst, const char* src, const unsigned (&off)[4]) {
    const unsigned d0 = (unsigned)__builtin_amdgcn_readfirstlane((int)(unsigned)(uintptr_t)dst);
    const unsigned long long s0 = (unsigned long long)(uintptr_t)src;
    const unsigned slo = (unsigned)__builtin_amdgcn_readfirstlane((int)(unsigned)s0), shi = (unsigned)__builtin_amdgcn_readfirstlane((int)(unsigned)(s0 >> 32));
    const unsigned long long g = ((unsigned long long)shi << 32) | slo;
#pragma unroll
    for (int q = 0; q < 4; ++q) { const unsigned d = d0 + q * 1024; unsigned keep;
        asm volatile("s_mov_b32 %0, m0\n\ts_mov_b32 m0, %2\n\ts_nop 2\n\tglobal_load_lds_dwordx4 %1, %3\n\ts_mov_b32 m0, %0" : "=&s"(keep) : "v"(off[q]), "s"(d), "s"(g) : "memory"); }
}
__device__ __forceinline__ void wgemm_lds(LAS unsigned char* wl, int S, const bf16_t* Abase, const unsigned (&aoff)[4], const bf16_t* Bbase, const unsigned (&boff)[4], int K, f32x16& acc, int lane) {
    const int nch = K >> 6;
#pragma unroll
    for (int i = 0; i < 16; ++i) acc[i] = 0.f;
    asm volatile("s_waitcnt vmcnt(0)" ::: "memory");
#define WG_ISSUE(c_, st_) do { const int cc_ = (c_) < nch ? (c_) : nch - 1; LAS unsigned char* d_ = wl + (st_) * 8192; \
        wg_dma4(d_, (const char*)Abase + cc_ * 128, aoff); wg_dma4(d_ + 4096, (const char*)Bbase + cc_ * 128, boff); } while (0)
    for (int c = 0; c < S - 1; ++c) WG_ISSUE(c, c);
    const int rdo = (lane & 31) * 128, xr = lane & 7, h_ = lane >> 5;
    for (int c = 0; c < nch; ++c) {
        asm volatile("s_waitcnt lgkmcnt(0)" ::: "memory");
        WG_ISSUE(c + S - 1, (c + S - 1) & (S - 1));
        if (S == 8) asm volatile("s_waitcnt vmcnt(56)" ::: "memory"); else if (S == 4) asm volatile("s_waitcnt vmcnt(24)" ::: "memory"); else asm volatile("s_waitcnt vmcnt(8)" ::: "memory");
        const LAS unsigned char* sp = wl + (c & (S - 1)) * 8192 + rdo;
#pragma unroll
        for (int s = 0; s < 4; ++s) { const int o = ((2 * s + h_) ^ xr) << 4; const bf16x8 a = *(const LAS bf16x8*)(sp + o), b = *(const LAS bf16x8*)(sp + 4096 + o);
            acc = __builtin_amdgcn_mfma_f32_32x32x16_bf16(b, a, acc, 0, 0, 0); } }
#undef WG_ISSUE
    asm volatile("s_waitcnt vmcnt(0) lgkmcnt(0)" ::: "memory");
}
#define CTX_BEGIN(n_) for (int rp_ = 0; rp_ < 1 + PROBE_CTX; ++rp_) for (int base_ = 0; base_ < (n_); base_ += G * NWAVES) { const int rem_ = (n_) - base_; int na_ = (rem_ + G - 1) / G; na_ = na_ > NWAVES ? NWAVES : na_; \
        const int S_ = na_ <= 2 ? 8 : na_ <= 4 ? 4 : 2; const int it = base_ + bid * na_ + wave; LAS unsigned char* wl_ = lds + wave * (S_ * 8192); \
        if (wave < na_ && it < (n_))
#define CTX_END }
constexpr int XCONV_R = 6144;
#define EXPERT_CONV_ITEM(it_, scr_) do { const int w_ = (it_) >> 12, r_ = (it_) & 4095, z_ = l * 16 + (r_ >> 8); \
        if (w_ < 2) p0_transpose_item((w_ == 0 ? IN(22) : IN(23)) + (size_t)z_ * D * FF, D, FF, W13 + (size_t)z_ * 2048 * D, 1 + w_, scr_, r_ & 255, lane); \
        else p0_transpose_item(IN(24) + (size_t)z_ * FF * D, FF, D, W2 + (size_t)z_ * D * FF, 0, scr_, r_ & 255, lane); } while (0)
#define CTX_SWZ (((lane & 7) ^ (lane >> 3)) * 16)
#define CTX_ROW(q) (8 * (q) + (lane >> 3))
__device__ __forceinline__ void norm_mod_row(const float* x, const float* g, const float* sh, const float* sc, bf16_t* o, int lane) {
    f32x4 v[4]; float s = 0.f;
#pragma unroll
    for (int j = 0; j < 4; ++j) { v[j] = *(const f32x4*)(x + j * 256 + lane * 4); s += (v[j][0] * v[j][0] + v[j][1] * v[j][1]) + (v[j][2] * v[j][2] + v[j][3] * v[j][3]); }
    const float rs = rsqrtf(wave_sum(s) * (1.f / D) + EPS);
#pragma unroll
    for (int j = 0; j < 4; ++j) { const int d = j * 256 + lane * 4; const f32x4 gg = *(const f32x4*)(g + d), a = *(const f32x4*)(sc + d), b = *(const f32x4*)(sh + d);
        const f32x4 h = v[j] * rs * gg * (a + 1.f) + b; u32x2 w; w.x = pk2(h[0], h[1]); w.y = pk2(h[2], h[3]); *(u32x2*)(o + d) = w; }
}

#define IN(i) (args.in[(i) + zero])
struct Args { const float* in[26]; float* out; unsigned char* ws; int ph_lo, ph_hi, li, pad; };

__global__ void __launch_bounds__(NTHREADS, 2) mk_fwd(Args args) {
    extern __shared__ __attribute__((aligned(16))) unsigned char lds_raw[];
    LAS unsigned char* lds = (LAS unsigned char*)lds_raw;
    volatile LAS unsigned* MISC = (volatile LAS unsigned*)(lds + MISC_OFF);
    const int tid0 = threadIdx.x, wave = __builtin_amdgcn_readfirstlane(tid0 >> 6);
    const int G = gridDim.x, bid = blockIdx.x, gw = bid * NWAVES + wave, NGW = G * NWAVES;
    for (int u = tid0; u < (LDS_BYTES - LDSCTL_OFF) / 4; u += NTHREADS) ((LAS unsigned*)(lds + LDSCTL_OFF))[u] = 0u;
    __syncthreads();
    XcdBarrier bar = xcd_barrier_post((unsigned*)(args.ws + WS_CTL) + CW_BAR + args.li * XCD_BAR_WORDS, MISC + 8);

    int nrep_ = 0; (void)nrep_;
    for (int ph = args.ph_lo; ph < args.ph_hi; ++ph) {
        int zero = 0; asm volatile("" : "+s"(zero));
        unsigned char* ws = args.ws + zero;
        const float* x_in = IN(0); const float* ctx_in = IN(2); float* out = args.out + zero;
        float* MOD = (float*)(ws + OFF_MOD); float* ROPE = (float*)(ws + OFF_ROPE); float* LAM = (float*)(ws + OFF_LAM);
        float* AFF = (float*)(ws + OFF_AFF); int* INV = (int*)(ws + OFF_INV); int* IDX = (int*)(ws + OFF_IDX); float* GATE = (float*)(ws + OFF_GATE); float* XC = (float*)(ws + WS_XC);
        bf16_t* WIN = (bf16_t*)(ws + WS_WIN); bf16_t* WBR = (bf16_t*)(ws + WS_WBR); bf16_t* WOUT = (bf16_t*)(ws + WS_WOUT); bf16_t* W13 = (bf16_t*)(ws + WS_W13); bf16_t* W2 = (bf16_t*)(ws + WS_W2);
        bf16_t* H = (bf16_t*)(ws + WS_H); bf16_t* Y = (bf16_t*)(ws + WS_Y); bf16_t* Z = (bf16_t*)(ws + WS_Z);
        bf16_t* MB = H; bf16_t* H2 = Y; bf16_t* HID = (bf16_t*)(ws + WS_Z + ZO_HID); bf16_t* YE = (bf16_t*)(ws + WS_Z + ZO_YE);

        const int l = ph < 2 ? 0 : (ph - 2) / 9, kind = ph < 2 ? ph : 2 + (ph - 2) % 9; const bool last = (l == 1);
        const float* mod = MOD + (size_t)l * 2 * 6144;
        if (kind == K_G1 || kind == K_M1 || kind == K_M2 || kind == K_E1 || kind == K_E2) {
            pg8::Gemm g; g.M = 0; g.N = 0;
            if (kind == K_G1) { g.A = H; g.Bt = WIN + (size_t)l * PROJ * D; g.K = D; }
            else if (kind == K_M1) { g.A = Y; g.Bt = WBR + (size_t)l * 3 * D * 512; g.K = 512; }
            else if (kind == K_M2) { g.A = MB; g.Bt = WOUT + (size_t)l * D * D; g.K = D; }
            else if (kind == K_E1) { g.A = H2; g.Bt = W13 + (size_t)l * 16 * 2048 * D; g.K = D; }
            else { g.A = HID; g.Bt = W2 + (size_t)l * 16 * D * FF; g.K = FF; }
            const USched S{kind, bid, G, IDX}; const UEpi E{kind, l, ws, out, l == 0 ? x_in : out};
            int wv_ = wave; asm volatile("" : "+s"(wv_)); const int tidg = wv_ * 64 + lane_id_();
            if ((PH_MASK >> kind) & 1) pg8::gemm_phase<UEpi, USched>(lds, g, S, E, kind != K_M2, kind == K_E1, tidg);
        }
#define tid (wave * 64 + lane)
#define r32 (lane & 31)
#define hh (lane >> 5)
        if (PH_ON(K_P0) && kind == K_P0) { const int lane = lane_id_(); (void)lane;

            if (bid < 192) {
                LAS float* sv = (LAS float*)(lds + 8192);
                { float c_[2], d_[2];
#pragma unroll
                  for (int q = 0; q < 2; ++q) { c_[q] = IN(1)[tid + q * NTHREADS]; d_[q] = IN(3)[tid + q * NTHREADS]; }
#pragma unroll
                  for (int q = 0; q < 2; ++q) { sv[tid + q * NTHREADS] = siluf_(c_[q]); sv[1024 + tid + q * NTHREADS] = siluf_(d_[q]); } }
                __syncthreads();
            for (int it = bid; it < 192; it += G) { const int ll = it / 96, n0 = (it % 96) * 64; const float* w = IN(4) + (size_t)ll * D * 6144 + n0 + lane;
                float a0 = 0.f, a1 = 0.f;
#pragma unroll 16
                for (int k = wave * 128; k < wave * 128 + 128; ++k) { const float wv = w[(size_t)k * 6144]; a0 += sv[k] * wv; a1 += sv[1024 + k] * wv; }
                LAS float* red = (LAS float*)lds; red[(wave * 2 + 0) * 64 + lane] = a0; red[(wave * 2 + 1) * 64 + lane] = a1; __syncthreads();
                if (wave < 2) { float s = 0.f;
#pragma unroll
                    for (int q = 0; q < 8; ++q) s += red[(q * 2 + wave) * 64 + lane];
                    MOD[(size_t)(ll * 2 + wave) * 6144 + n0 + lane] = s + IN(5)[ll * 6144 + n0 + lane]; }
                __syncthreads(); } }
            if (bid == G - 1) {
                for (int t = tid; t < 320 * 16; t += NTHREADS) { const int pos = t / 16, j = t % 16; const float inv = powf(10000.f, -(float)(2 * j) / 32.f);
                    if (pos < 256) { const float a = (float)pos * inv; ROPE[pos * 16 + j] = cosf(a); ROPE[4096 + pos * 16 + j] = sinf(a); }
                    else { const int p = pos - 256; const float a = (float)p * inv; ROPE[8192 + p * 16 + j] = cosf(a); ROPE[8192 + 1024 + p * 16 + j] = sinf(a); } }
                if (tid < 2) { float s1 = 0.f, s2 = 0.f; for (int i = 0; i < 64; ++i) { s1 += IN(10)[tid * 64 + i] * IN(11)[tid * 64 + i]; s2 += IN(12)[tid * 64 + i] * IN(13)[tid * 64 + i]; }
                    LAM[tid] = expf(s1) - expf(s2) + (0.8f - 0.6f * expf(-0.3f * (float)tid)); }
            }
            LAS unsigned short* scr = (LAS unsigned short*)(lds + wave * 16384);
            for (int it = gw; it < 4864; it += NGW) { int r = it;
                if (r < 3584) { const int z = r / 1792; p0_transpose_item(IN(8) + (size_t)z * D * PROJ, D, PROJ, WIN + (size_t)z * PROJ * D, 0, scr, r % 1792, lane); continue; } r -= 3584;
                if (r < 768) { const int z = r / 128; p0_transpose_item(IN(19) + (size_t)z * 512 * D, 512, D, WBR + (size_t)z * D * 512, 0, scr, r % 128, lane); continue; } r -= 768;
                { const int z = r / 256; p0_transpose_item(IN(20) + (size_t)z * D * D, D, D, WOUT + (size_t)z * D * D, 0, scr, r % 256, lane); }
            }
        } else if (PH_ON(K_H1) && kind == K_H1) { const int lane = lane_id_(); (void)lane;

            for (int row = gw; row < R; row += NGW) { const float* xr = row < L ? x_in + (size_t)row * D : ctx_in + (size_t)(row - L) * D; const float* m = MOD + (row < L ? 0 : 6144);
                norm_mod_row(xr, IN(6), m, m + 1024, H + (size_t)row * D, lane); }
        } else if (PH_ON(K_G1) && kind == K_G1) { const int lane = lane_id_(); (void)lane;

            const int ntn = (last ? 2048 : PROJ) / 32;
            CTX_BEGIN(8 * ntn) { const int mt = it & 7, nt = it >> 3; f32x16 acc[1]; unsigned ao[4], bo[4];
#pragma unroll
                for (int q = 0; q < 4; ++q) { ao[q] = (unsigned)((L + mt * 32 + CTX_ROW(q)) * D * 2 + CTX_SWZ); bo[q] = (unsigned)((nt * 32 + CTX_ROW(q)) * D * 2 + CTX_SWZ); }
                wgemm_lds(wl_, S_, H, ao, WIN + (size_t)l * PROJ * D, bo, D, acc[0], lane);
                const int row = L + mt * 32 + r32; const int nb = nt * 32;
                const int type = (nb >= 2048 && nb < 3072) ? 2 : (nb >= 3072 && nb < 4096) ? 3 : (nb >= 4096) ? 4 : 0;
                bf16_t* dst;
                if ((nb >= 1024 && nb < 2048) || (nb >= 2560 && nb < 3072)) { const int sel = nb < 1536 ? 1 : nb < 2048 ? 2 : 0; bf16_t* hb = (bf16_t*)(ws + WS_QB + (size_t)sel * QKV_STRIDE); const int cq = nb & 511; dst = hb + (size_t)(cq >> 7) * HB; if (sel == 0) dst += (size_t)row * 128 + (cq & 127); }
                else if (nb < 1024) { dst = (bf16_t*)(ws + WS_KA + (size_t)(nb >> 9) * KAV_STRIDE) + (size_t)((nb & 511) >> 6) * HA + (size_t)(row >> 6) * 4096; }
                else { const int zc = nb < 2560 ? ZQA + (nb - 2048) : nb < 4096 ? ZU + (nb - 3072) : ZG + (nb - 4096); dst = Z + (size_t)row * PROJZ + zc; }
#pragma unroll
                for (int g4 = 0; g4 < 4; ++g4) { float v[4];
#pragma unroll
                    for (int i = 0; i < 4; ++i) { float t = acc[0][4 * g4 + i]; t = type == 2 ? t * C2 : type == 3 ? gelu_tanh(t) : type == 4 ? sigmoidf_(t) : t; v[i] = t; }
                    u32x2 w; w.x = pk2(v[0], v[1]); w.y = pk2(v[2], v[3]);
                    const bool tiled = (nb >= 1024 && nb < 2048); const int sel2 = nb < 1536 ? 1 : 2;
                    bf16_t* dp = tiled ? dst + kv_tiled_off(sel2, row, (nb & 127) + 8 * g4 + 4 * hh) : nb < 1024 ? dst + na_tiled_off(nb >> 9, row & 63, (nb & 63) + 8 * g4 + 4 * hh) : dst + 8 * g4 + 4 * hh; *(u32x2*)dp = w; } } CTX_END
        } else if (PH_ON(K_MIX) && kind == K_MIX) { const int lane = lane_id_(); (void)lane;

            { const int nchunk = last ? 128 : 130;
              for (int rp_ = 0; rp_ < 1 + PROBE_GM; ++rp_) for (int cu = G - 1 - bid; cu < nchunk; cu += G) gm::unit(lds, Z, IN(15) + l * 512, IN(16) + l * 512, IN(17) + (size_t)l * 4 * 128 * 128, IN(18) + l * 512, cu * 128, Y + 2 * YP, wave, lane_id_()); }
            __syncthreads();
            for (int rp_ = 0; rp_ < 1 + PROBE_NA; ++rp_) for (int it = gw; it < 2048 + (last ? 0 : 32); it += NGW) { const int h = it & 7;
                const int gr = (((it >> 3) & 7) << 5) | (it >> 6);
                const int qrow0 = it < 2048 ? gr * 64 : L + ((it - 2048) >> 3) * 64, rr = it < 2048 ? gr : -1;
                na::unit(lds, Z, (const bf16_t*)(ws + WS_KA) + (size_t)h * HA, (const bf16_t*)(ws + WS_VA) + (size_t)h * HA, IN(9) + ((size_t)l * 8 + h) * 465, qrow0, rr, h, Y + h * 64, wave, lane_id_()); }
            __syncthreads();
            const float lam = LAM[l], oscale = 1.f - (0.8f - 0.6f * expf(-0.3f * (float)l));
            bf16_t* QB = (bf16_t*)(ws + WS_QB); bf16_t* KB = (bf16_t*)(ws + WS_KB); bf16_t* VB = (bf16_t*)(ws + WS_VB);
            const int nlat = (512 - bid + G - 1) / G, nctx = (!last && bid < 8) ? (8 - bid + G - 1) / G : 0;
            for (int ui = 0; ui < nlat + nctx; ++ui) { int h, q0, kbase, NT;
                if (ui < nlat) { const int uu = bid + ui * G, x = uu & 7, b = (uu >> 3) & 31, i = uu >> 8; h = x >> 1; q0 = (((x & 1) * 32 + b) * 2 + i) * 128; kbase = 0; NT = R / 64; }
                else { const int uu = bid + (ui - nlat) * G; h = uu >> 1; q0 = L + (uu & 1) * 128; kbase = L; NT = C / 64; }
                da::unit(lds, QB + (size_t)h * HB, KB + (size_t)h * HB, VB + (size_t)h * HB, q0, kbase, NT, lam, IN(14) + l * 128, oscale, Y + YP + h * 128, wave, lane_id_(), (bid == STAT_BID && wave == STAT_WAVE && ui == 0 && l == 0) ? (float*)(ws + OFF_LAM + 64) : nullptr); }
        } else if (PH_ON(K_M1) && kind == K_M1) { const int lane = lane_id_(); (void)lane;

            if (!last) CTX_BEGIN(8 * 32) { const int mt = it & 7, nt = it >> 3; const int row = L + mt * 32 + r32; float m4[4][4];
#pragma unroll
                for (int g4 = 0; g4 < 4; ++g4)
#pragma unroll
                    for (int i = 0; i < 4; ++i) m4[g4][i] = 0.f;
                unsigned ao[4], bo[4];
#pragma unroll
                for (int q = 0; q < 4; ++q) { ao[q] = (unsigned)((L + mt * 32 + CTX_ROW(q)) * 512 * 2 + CTX_SWZ); bo[q] = (unsigned)((nt * 32 + CTX_ROW(q)) * 512 * 2 + CTX_SWZ); }
                for (int j = 0; j < 3; ++j) { f32x16 acc[1];
                    wgemm_lds(wl_, S_, Y + (size_t)j * YP, ao, WBR + ((size_t)l * 3 + j) * D * 512, bo, 512, acc[0], lane);
                    u32x2 gq[4];
#pragma unroll
                    for (int g4 = 0; g4 < 4; ++g4) gq[g4] = *(const u32x2*)(Z + (size_t)row * PROJZ + ZG + j * 1024 + nt * 32 + 8 * g4 + 4 * hh);
#pragma unroll
                    for (int g4 = 0; g4 < 4; ++g4) { const u32x2 gw2 = gq[g4];
                        m4[g4][0] += __uint_as_float(gw2.x << 16) * acc[0][4 * g4]; m4[g4][1] += __uint_as_float(gw2.x & 0xffff0000u) * acc[0][4 * g4 + 1];
                        m4[g4][2] += __uint_as_float(gw2.y << 16) * acc[0][4 * g4 + 2]; m4[g4][3] += __uint_as_float(gw2.y & 0xffff0000u) * acc[0][4 * g4 + 3]; } }
#pragma unroll
                for (int g4 = 0; g4 < 4; ++g4) { u32x2 w; w.x = pk2(m4[g4][0], m4[g4][1]); w.y = pk2(m4[g4][2], m4[g4][3]); *(u32x2*)(MB + (size_t)row * D + nt * 32 + 8 * g4 + 4 * hh) = w; } } CTX_END
        } else if (PH_ON(K_M2) && kind == K_M2) { const int lane = lane_id_(); (void)lane;

            const float* xl_old = l == 0 ? x_in : out; const float* xc_old = l == 0 ? ctx_in : XC;
            if (!last) CTX_BEGIN(8 * 32) { const int mt = it & 7, nt = it >> 3; const int rc = mt * 32 + r32; f32x16 acc[1]; unsigned ao[4], bo[4];
#pragma unroll
                for (int q = 0; q < 4; ++q) { ao[q] = (unsigned)((L + mt * 32 + CTX_ROW(q)) * D * 2 + CTX_SWZ); bo[q] = (unsigned)((nt * 32 + CTX_ROW(q)) * D * 2 + CTX_SWZ); }
                wgemm_lds(wl_, S_, MB, ao, WOUT + (size_t)l * D * D, bo, D, acc[0], lane);
                f32x4 xo4[4], gt4[4];
#pragma unroll
                for (int g4 = 0; g4 < 4; ++g4) { const int n = nt * 32 + 8 * g4 + 4 * hh; xo4[g4] = *(const f32x4*)(xc_old + (size_t)rc * D + n); gt4[g4] = *(const f32x4*)(mod + 6144 + 2048 + n); }
#pragma unroll
                for (int g4 = 0; g4 < 4; ++g4) { const int n = nt * 32 + 8 * g4 + 4 * hh;
                    f32x4 a; a[0] = acc[0][4 * g4]; a[1] = acc[0][4 * g4 + 1]; a[2] = acc[0][4 * g4 + 2]; a[3] = acc[0][4 * g4 + 3]; *(f32x4*)(XC + (size_t)rc * D + n) = xo4[g4] + gt4[g4] * a; } } CTX_END
        } else if (PH_ON(K_R) && kind == K_R) { const int lane = lane_id_(); (void)lane;

            const int NR = last ? L : R; const float* g2 = IN(7) + l * D; const float* w_r = IN(21) + (size_t)l * D * 16;
            LAS float* wrT = (LAS float*)lds;
            { f32x4 wq[8];
#pragma unroll
              for (int q = 0; q < 8; ++q) wq[q] = *(const f32x4*)(w_r + 4 * (tid + q * NTHREADS));
#pragma unroll
              for (int q = 0; q < 8; ++q) { const int f = tid + q * NTHREADS, k = f >> 2, e0 = 4 * (f & 3);
#pragma unroll
                  for (int j = 0; j < 4; ++j) wrT[(e0 + j) * 1024 + k] = wq[q][j]; } }
            LAS float* mA = (LAS float*)(lds + 141312); LAS float* mB = mA + 1024;
            { float ga[2], sa[2], sb[2];
#pragma unroll
              for (int q = 0; q < 2; ++q) { const int idx = tid + q * NTHREADS; ga[q] = g2[idx]; sa[q] = mod[4096 + idx]; sb[q] = mod[3072 + idx]; }
#pragma unroll
              for (int q = 0; q < 2; ++q) { const int idx = tid + q * NTHREADS; mA[idx] = ga[q] * (sa[q] + 1.f); mB[idx] = sb[q]; } }
            __syncthreads();
            f32x4 vn[4]; { float z_ = 0.f; asm volatile("" : "+v"(z_));
#pragma unroll
                for (int j = 0; j < 4; ++j) vn[j] = (f32x4){z_, z_, z_, z_}; }
            if (wave & 1) { LAS unsigned short* scr = (LAS unsigned short*)(lds + (wave < 7 ? 65536 + wave * 8448 : 132096));
              for (int it = gw; it < XCONV_R; it += NGW) EXPERT_CONV_ITEM(it, scr); }
            if (gw < NR) { const float* xp = gw < L ? out + (size_t)gw * D : XC + (size_t)(gw - L) * D;
#pragma unroll
                for (int j = 0; j < 4; ++j) vn[j] = *(const f32x4*)(xp + j * 256 + lane * 4); }
            auto r_row = [&](const int row, auto lat_tag) { constexpr bool LAT = decltype(lat_tag)::value;
                f32x4 v[4]; float s = 0.f;
#pragma unroll
                for (int j = 0; j < 4; ++j) { v[j] = vn[j]; s += (v[j][0] * v[j][0] + v[j][1] * v[j][1]) + (v[j][2] * v[j][2] + v[j][3] * v[j][3]); }
                { const int nrow = row + NGW; if (nrow < NR) { const float* xp = nrow < L ? out + (size_t)nrow * D : XC + (size_t)(nrow - L) * D;
#pragma unroll
                    for (int j = 0; j < 4; ++j) vn[j] = *(const f32x4*)(xp + j * 256 + lane * 4); } }
                const float rs = rsqrtf(wave_sum(s) * (1.f / D) + EPS);
#pragma unroll
                for (int j = 0; j < 4; ++j) { const int d = j * 256 + lane * 4; f32x4 ma, mb;
                    if constexpr (LAT) { ma = *(const LAS f32x4*)(mA + d); mb = *(const LAS f32x4*)(mB + d); }
                    else { const float* m = mod + 6144; ma = *(const f32x4*)(g2 + d) * (*(const f32x4*)(m + 4096 + d) + 1.f); mb = *(const f32x4*)(m + 3072 + d); }
                    v[j] = v[j] * rs * ma + mb; u32x2 w; w.x = pk2(v[j][0], v[j][1]); w.y = pk2(v[j][2], v[j][3]); *(u32x2*)(H2 + (size_t)row * D + d) = w; }
                float lg[16];
#pragma unroll
                for (int e = 0; e < 16; ++e) { float a = 0.f;
#pragma unroll
                    for (int j = 0; j < 4; ++j) { const f32x4 w4 = *(const LAS f32x4*)(wrT + e * 1024 + j * 256 + lane * 4); a += (v[j][0] * w4[0] + v[j][1] * w4[1]) + (v[j][2] * w4[2] + v[j][3] * w4[3]); }
                    lg[e] = a; if ((e & 3) == 3) __builtin_amdgcn_sched_barrier(0); }
                float a8[8], a4[4], a2[2];
#pragma unroll
                for (int i = 0; i < 8; ++i) { const bool hi_ = (lane & 32) != 0; a8[i] = (hi_ ? lg[8 + i] : lg[i]) + xor32f_(hi_ ? lg[i] : lg[8 + i], !hi_); }
#pragma unroll
                for (int i = 0; i < 4; ++i) { const bool hi_ = (lane & 16) != 0; a4[i] = (hi_ ? a8[4 + i] : a8[i]) + xorf_<16>(hi_ ? a8[i] : a8[4 + i]); }
#pragma unroll
                for (int i = 0; i < 2; ++i) { const bool hi_ = (lane & 8) != 0; a2[i] = (hi_ ? a4[2 + i] : a4[i]) + xorf_<8>(hi_ ? a4[i] : a4[2 + i]); }
                float lgt; { const bool hi_ = (lane & 4) != 0; lgt = (hi_ ? a2[1] : a2[0]) + xorf_<4>(hi_ ? a2[0] : a2[1]); }
                lgt += xorf_<2>(lgt); lgt += xorf_<1>(lgt);
                float mx = lgt;
                mx = fmaxf(mx, xorf_<4>(mx)); mx = fmaxf(mx, xorf_<8>(mx)); mx = fmaxf(mx, xorf_<16>(mx)); mx = fmaxf(mx, xor32f_(mx, lane < 32));
                const float ex = expf(lgt - mx); float den = ex;
                den += xorf_<4>(den); den += xorf_<8>(den); den += xorf_<16>(den); den = sum32f_(den);
                if ((lane & 3) == 0) AFF[(size_t)(lane >> 2) * R + row] = ex / den;
            };
            { int row = gw;
              for (; row < NR && row < L; row += NGW) r_row(row, std::true_type{});
              for (; row < NR; row += NGW) r_row(row, std::false_type{}); }
            if (!(wave & 1)) { LAS unsigned short* scr = (LAS unsigned short*)(lds + (wave < 7 ? 65536 + wave * 8448 : 132096));
              for (int it = gw; it < XCONV_R; it += NGW) EXPERT_CONV_ITEM(it, scr); }
        } else if (PH_ON(K_S) && kind == K_S) { const int lane = lane_id_(); (void)lane;

            LAS int* red = (LAS int*)lds; LAS int* sc_gt = red + 32; LAS int* sc_eq = sc_gt + NTHREADS;
            for (int it = bid; it < 32; it += G) { const int e = it & 15, set = it >> 4;
                const int base = set == 0 ? 0 : L, cap = set == 0 ? CAPL : CAPC, sbase = set == 0 ? 0 : CAPL;
                if (set == 1) { for (int s = CAPL + (last ? 0 : CAPC) + tid; s < SLOTS; s += NTHREADS) { IDX[e * SLOTS + s] = 0; GATE[e * SLOTS + s] = 0.f; } if (last) continue; }
                unsigned v[32];
                if (set == 0) {
#pragma unroll
                    for (int q = 0; q < 8; ++q) { const u32x4 w = *(const u32x4*)(AFF + (size_t)e * R + tid * 32 + q * 4); v[4 * q] = w.x; v[4 * q + 1] = w.y; v[4 * q + 2] = w.z; v[4 * q + 3] = w.w; }
                } else {
#pragma unroll
                    for (int i = 0; i < 32; ++i) v[i] = 0u;
                    if (tid < C) v[0] = __float_as_uint(AFF[(size_t)e * R + L + tid]);
                }
                const int per = set == 0 ? 32 : 1; const bool act = set == 0 || tid < C;
                unsigned T = 0u;
                for (int rnd = 0; rnd < 15; ++rnd) { const int b1 = 29 - 2 * rnd, b0 = b1 - 1; const unsigned c1 = T | (1u << b1), c2 = T | (1u << b0), c3 = c1 | (1u << b0);
                    int n12 = 0, n3 = 0;
#pragma unroll
                    for (int i = 0; i < 32; ++i) { n12 += (v[i] >= c1 ? 1 : 0) + (v[i] >= c2 ? 65536 : 0); n3 += v[i] >= c3 ? 1 : 0; }
                    n12 += xori_<1>(n12); n3 += xori_<1>(n3); n12 += xori_<2>(n12); n3 += xori_<2>(n3); n12 += xori_<4>(n12); n3 += xori_<4>(n3); n12 += xori_<8>(n12); n3 += xori_<8>(n3); n12 += xori_<16>(n12); n3 += xori_<16>(n3);
                    { const auto r12 = __builtin_amdgcn_permlane32_swap((unsigned)n12, (unsigned)n12, false, false), r3 = __builtin_amdgcn_permlane32_swap((unsigned)n3, (unsigned)n3, false, false); n12 = (int)(r12[0] + r12[1]); n3 = (int)(r3[0] + r3[1]); }
                    LAS int* rb = red + (rnd & 1) * 16; if (lane == 0) { rb[wave] = n12; rb[8 + wave] = n3; } __syncthreads();
                    int t12 = 0, t3 = 0;
#pragma unroll
                    for (int i = 0; i < NWAVES; ++i) { t12 += rb[i]; t3 += rb[8 + i]; }
                    const int t1 = t12 & 0xffff, t2 = t12 >> 16;
                    T = t3 >= cap ? c3 : t1 >= cap ? c1 : t2 >= cap ? c2 : T; }
                int gtc = 0, eqc = 0;
#pragma unroll
                for (int i = 0; i < 32; ++i) { const bool a = act && i < per; gtc += (a && v[i] > T) ? 1 : 0; eqc += (a && v[i] == T) ? 1 : 0; }
                __syncthreads(); sc_gt[tid] = gtc; sc_eq[tid] = eqc; __syncthreads();
                for (int o = 1; o < NTHREADS; o <<= 1) { const int a = tid >= o ? sc_gt[tid - o] : 0, b = tid >= o ? sc_eq[tid - o] : 0; __syncthreads(); sc_gt[tid] += a; sc_eq[tid] += b; __syncthreads(); }
                const int need = cap - sc_gt[NTHREADS - 1]; int gt_before = sc_gt[tid] - gtc, eq_before = sc_eq[tid] - eqc;
#pragma unroll
                for (int i = 0; i < 32; ++i) if (act && i < per) { const int tok = base + tid * per + i; int slot = -1;
                    if (v[i] > T) { slot = gt_before + (eq_before < need ? eq_before : need); ++gt_before; }
                    else if (v[i] == T) { if (eq_before < need) slot = gt_before + eq_before; ++eq_before; }
                    if (slot >= 0) { IDX[e * SLOTS + sbase + slot] = tok; GATE[e * SLOTS + sbase + slot] = __uint_as_float(v[i]); }
                    INV[(size_t)e * R + tok] = slot >= 0 ? sbase + slot : -1; }
                __syncthreads(); }
            { const int nconv = G > 32 ? G - 32 : G, cb = G > 32 ? bid - 32 : bid;
              if (cb >= 0) { LAS unsigned short* scr = (LAS unsigned short*)(lds + wave * 16384);
                  if (G <= 32) __syncthreads();
                  for (int it = XCONV_R + cb * NWAVES + wave; it < 12288; it += nconv * NWAVES) EXPERT_CONV_ITEM(it, scr); } }
        } else if (PH_ON(K_E1) && kind == K_E1) { const int lane = lane_id_(); (void)lane;

            if (!last) CTX_BEGIN(16 * 64) { const int e = it >> 6, t = it & 63, j0 = 16 * t; f32x16 acc[1]; unsigned ao[4], bo[4];
#pragma unroll
                for (int q = 0; q < 4; ++q) { const int tok = IDX[e * SLOTS + CAPL + CTX_ROW(q)]; ao[q] = (unsigned)(tok * D * 2 + CTX_SWZ);
                    bo[q] = (unsigned)((256 * (j0 >> 7) + (j0 & 127) + (q & 1) * 8 + (lane >> 3) + (q >> 1) * 128) * D * 2 + CTX_SWZ); }
                wgemm_lds(wl_, S_, H2, ao, W13 + ((size_t)l * 16 + e) * 2048 * D, bo, D, acc[0], lane);
#pragma unroll
                for (int g4 = 0; g4 < 2; ++g4) { float v[4];
#pragma unroll
                    for (int i = 0; i < 4; ++i) v[i] = siluf_(acc[0][4 * g4 + i]) * acc[0][4 * (g4 + 2) + i];
                    u32x2 w; w.x = pk2(v[0], v[1]); w.y = pk2(v[2], v[3]); *(u32x2*)(HID + ((size_t)e * SLOTS + CAPL + r32) * FF + j0 + 8 * g4 + 4 * hh) = w; } } CTX_END
        } else if (PH_ON(K_E2) && kind == K_E2) { const int lane = lane_id_(); (void)lane;

            if (!last) CTX_BEGIN(16 * 32) { const int e = it >> 5, nt = it & 31; f32x16 acc[1]; const size_t row = (size_t)e * SLOTS + CAPL + r32; unsigned ao[4], bo[4];
#pragma unroll
                for (int q = 0; q < 4; ++q) { ao[q] = (unsigned)((e * SLOTS + CAPL + CTX_ROW(q)) * FF * 2 + CTX_SWZ); bo[q] = (unsigned)((nt * 32 + CTX_ROW(q)) * FF * 2 + CTX_SWZ); }
                wgemm_lds(wl_, S_, HID, ao, W2 + ((size_t)l * 16 + e) * D * FF, bo, FF, acc[0], lane);
                const float gsc = GATE[row];
#pragma unroll
                for (int g4 = 0; g4 < 4; ++g4) { u32x2 w; w.x = pk2(acc[0][4 * g4] * gsc, acc[0][4 * g4 + 1] * gsc); w.y = pk2(acc[0][4 * g4 + 2] * gsc, acc[0][4 * g4 + 3] * gsc);
                    *(u32x2*)(YE + row * D + nt * 32 + 8 * g4 + 4 * hh) = w; } } CTX_END
        } else if (PH_ON(K_CB) && kind == K_CB) { const int lane = lane_id_(); (void)lane;

            const int NR = last ? L : R; const float* gn = last ? IN(25) : IN(6) + D; const float* modn = MOD + (size_t)2 * 6144;
            f32x4 vn[4]; int invn = -1; { float z_ = 0.f; asm volatile("" : "+v"(z_));
#pragma unroll
                for (int j = 0; j < 4; ++j) vn[j] = (f32x4){z_, z_, z_, z_}; }
            if (gw < NR) { const float* xp = gw < L ? out + (size_t)gw * D : XC + (size_t)(gw - L) * D;
#pragma unroll
                for (int j = 0; j < 4; ++j) vn[j] = *(const f32x4*)(xp + j * 256 + lane * 4);
                invn = lane < 16 ? INV[(size_t)lane * R + gw] : -1; }
            LAS float* vG = (LAS float*)lds; LAS float* vA = vG + 1024; LAS float* vB = vA + 1024;
            { float g_[2], a_[2], b_[2], c_[2];
#pragma unroll
              for (int q = 0; q < 2; ++q) { const int idx = tid + q * NTHREADS; g_[q] = mod[5120 + idx]; a_[q] = gn[idx]; b_[q] = last ? 0.f : modn[1024 + idx]; c_[q] = last ? 0.f : modn[idx]; }
#pragma unroll
              for (int q = 0; q < 2; ++q) { const int idx = tid + q * NTHREADS; vG[idx] = g_[q]; vA[idx] = a_[q] * (b_[q] + 1.f); vB[idx] = c_[q]; } }
            __syncthreads();
            auto cb_row = [&](const int row, auto lat_tag) { constexpr bool LAT = decltype(lat_tag)::value;
                float* x = row < L ? out + (size_t)row * D : XC + (size_t)(row - L) * D; const float* m = mod + (row < L ? 0 : 6144);
                f32x4 v[4], a[4];
#pragma unroll
                for (int j = 0; j < 4; ++j) { v[j] = vn[j]; a[j] = (f32x4){0.f, 0.f, 0.f, 0.f}; }
                const int myinv = invn;
                { const int nrow = row + NGW; if (nrow < NR) { const float* xp = nrow < L ? out + (size_t)nrow * D : XC + (size_t)(nrow - L) * D;
#pragma unroll
                    for (int j = 0; j < 4; ++j) vn[j] = *(const f32x4*)(xp + j * 256 + lane * 4);
                    invn = lane < 16 ? INV[(size_t)lane * R + nrow] : -1; } }
                unsigned long long msk = __ballot(myinv >= 0);
                while (msk) { const int e0 = __builtin_ctzll(msk); msk &= msk - 1; const bool has1 = msk != 0ull; const int e1 = has1 ? __builtin_ctzll(msk) : e0; if (has1) msk &= msk - 1;
                    const int s0 = __builtin_amdgcn_readlane(myinv, e0), s1 = __builtin_amdgcn_readlane(myinv, e1); const float w1 = has1 ? 1.f : 0.f;
                    const bf16_t* y0 = YE + ((size_t)e0 * SLOTS + s0) * D; const bf16_t* y1 = YE + ((size_t)e1 * SLOTS + s1) * D;
                    u32x2 u0[4], u1[4];
#pragma unroll
                    for (int j = 0; j < 4; ++j) { u0[j] = *(const u32x2*)(y0 + j * 256 + lane * 4); u1[j] = *(const u32x2*)(y1 + j * 256 + lane * 4); }
#pragma unroll
                    for (int j = 0; j < 4; ++j) { a[j][0] += __uint_as_float(u0[j].x << 16) + w1 * __uint_as_float(u1[j].x << 16); a[j][1] += __uint_as_float(u0[j].x & 0xffff0000u) + w1 * __uint_as_float(u1[j].x & 0xffff0000u);
                        a[j][2] += __uint_as_float(u0[j].y << 16) + w1 * __uint_as_float(u1[j].y << 16); a[j][3] += __uint_as_float(u0[j].y & 0xffff0000u) + w1 * __uint_as_float(u1[j].y & 0xffff0000u); } }
                float s = 0.f;
#pragma unroll
                for (int j = 0; j < 4; ++j) { f32x4 gt; if constexpr (LAT) gt = *(const LAS f32x4*)(vG + j * 256 + lane * 4); else gt = *(const f32x4*)(m + 5120 + j * 256 + lane * 4); v[j] = v[j] + gt * a[j]; s += (v[j][0] * v[j][0] + v[j][1] * v[j][1]) + (v[j][2] * v[j][2] + v[j][3] * v[j][3]); }
                const float rs = rsqrtf(wave_sum(s) * (1.f / D) + EPS);
                if (last) {
#pragma unroll
                    for (int j = 0; j < 4; ++j) { const int d = j * 256 + lane * 4; *(f32x4*)(out + (size_t)row * D + d) = v[j] * rs * *(const LAS f32x4*)(vA + d); }
#if DA_STAT
                    if (row == 0 && lane == 0) out[0] += *(const float*)(ws + OFF_LAM + 64);
#endif
                } else { const float* mn = modn + (row < L ? 0 : 6144);
#pragma unroll
                    for (int j = 0; j < 4; ++j) { const int d = j * 256 + lane * 4; *(f32x4*)(x + d) = v[j];
                        f32x4 h; if constexpr (LAT) h = v[j] * rs * *(const LAS f32x4*)(vA + d) + *(const LAS f32x4*)(vB + d); else h = v[j] * rs * *(const f32x4*)(gn + d) * (*(const f32x4*)(mn + 1024 + d) + 1.f) + *(const f32x4*)(mn + d);
                        u32x2 w; w.x = pk2(h[0], h[1]); w.y = pk2(h[2], h[3]); *(u32x2*)(H + (size_t)row * D + d) = w; } }
            };
            { int row = gw;
              for (; row < NR && row < L; row += NGW) cb_row(row, std::true_type{});
              for (; row < NR; row += NGW) cb_row(row, std::false_type{}); }
        }
        if (ph + 1 < args.ph_hi) xcd_barrier(bar, wave * 64 + lane_id_());
#if PROBE_KIND >= 0
        if (kind == PROBE_KIND && !(kind == K_M2 && l == 1) && nrep_ < PROBE_N && ph + 1 < args.ph_hi) { ++nrep_; --ph; } else nrep_ = 0;
#endif
    }
}
#undef tid
#undef r32
#undef hh


#ifndef FAST_TAIL
#define FAST_TAIL 1
#endif
static void launch_mk(const Args& base, int lo, int hi, int li, int grid, hipStream_t stream) {
    Args a = base; a.ph_lo = lo; a.ph_hi = hi; a.li = li;
    hipLaunchKernelGGL(mk_fwd, dim3(grid), dim3(NTHREADS), LDS_BYTES, stream, a);
}
extern "C" void kernel_launch(void* const* d_in, const int* in_sizes, int n_in, void* d_out, int out_size, void* d_ws, size_t ws_size, hipStream_t stream) {
    static int grid = 0;
    if (grid == 0) {
        if (n_in != 26 || ws_size < WS_END) { fprintf(stderr, "kernel_launch: bad arguments (n_in %d, ws %zu < %zu)\n", n_in, ws_size, (size_t)WS_END); grid = -1; return; }
        int dev = 0, cus = 0;
        if (hipGetDevice(&dev) != hipSuccess || hipDeviceGetAttribute(&cus, hipDeviceAttributeMultiprocessorCount, dev) != hipSuccess) { grid = -1; return; }
        if (hipFuncSetAttribute((const void*)mk_fwd, hipFuncAttributeMaxDynamicSharedMemorySize, LDS_BYTES) != hipSuccess) { fprintf(stderr, "kernel_launch: hipFuncSetAttribute failed\n"); grid = -1; return; }
        int nb = 0;
        if (hipOccupancyMaxActiveBlocksPerMultiprocessor(&nb, (const void*)mk_fwd, NTHREADS, LDS_BYTES) != hipSuccess || nb < 1) { fprintf(stderr, "kernel_launch: the occupancy query grants no resident workgroup per CU\n"); grid = -1; return; }
        grid = cus;
    }
    if (grid < 0) return;
    (void)hipMemsetAsync((char*)d_ws + WS_CTL, 0, CTL_ZERO_BYTES, stream);
    Args base{};
    for (int i = 0; i < 26; ++i) base.in[i] = (const float*)d_in[i];
    base.out = (float*)d_out; base.ws = (unsigned char*)d_ws;
    launch_mk(base, 0, N_PHASES, 0, grid, stream);
}
```

```cpp
#include <hip/hip_runtime.h>
#include <cstdint>
#include <cstdio>
#include <type_traits>

typedef unsigned short bf16_t;
#define GAS __attribute__((address_space(1)))
__device__ __forceinline__ float bf2f(bf16_t b) { return __uint_as_float(((unsigned)b) << 16); }
__device__ __forceinline__ bf16_t f2bf(float f) { unsigned u = __float_as_uint(f); return (bf16_t)((u + 0x7fffu + ((u >> 16) & 1u)) >> 16); }
__device__ __forceinline__ unsigned pk2(float lo, float hi) { typedef float f2_ __attribute__((ext_vector_type(2))); typedef __bf16 b2_ __attribute__((ext_vector_type(2))); f2_ v = {lo, hi}; b2_ b = __builtin_convertvector(v, b2_); return __builtin_bit_cast(unsigned, b); }

constexpr int D = 1024, L = 16384, C = 256, R = L + C, PROJ = 7168, NE = 16, FF = 1024;
constexpr int CAPL = 2048, CAPC = 32, SLOTS = 2304;
constexpr float EPS = 1e-6f;
constexpr float C2 = 0.125f * 1.4426950408889634f;
constexpr int PROJZ = 4608;
constexpr int ZQA = 0, ZU = 512, ZV = 1024, ZG = 1536;
constexpr size_t HA = (size_t)(R / 64) * 4096;
constexpr size_t HB = (size_t)R * 128;
constexpr size_t YP = (size_t)R * 512;

constexpr size_t MiB = 1u << 20;
constexpr size_t WS_CTL = 0, CTL_ZERO_BYTES = 1 * MiB;
constexpr size_t OFF_MOD = 1 * MiB;
constexpr size_t OFF_ROPE = 1 * MiB + 256 * 1024;
constexpr size_t OFF_LAM = 1 * MiB + 320 * 1024;
constexpr size_t OFF_GST = 1 * MiB + 384 * 1024;
constexpr size_t OFF_AFF = 2 * MiB;
constexpr size_t OFF_INV = 3 * MiB + 256 * 1024;
constexpr size_t OFF_IDX = 4 * MiB + 512 * 1024;
constexpr size_t OFF_GATE = 4 * MiB + 768 * 1024;
constexpr size_t WS_XC = 5 * MiB;
constexpr size_t WS_WIN = 6 * MiB;
constexpr size_t WS_WBR = 34 * MiB;
constexpr size_t WS_WOUT = 40 * MiB;
constexpr size_t WS_W13 = 44 * MiB;
constexpr size_t WS_W2 = 172 * MiB;
constexpr size_t WS_H = 236 * MiB;
constexpr size_t WS_Y = 269 * MiB;
constexpr size_t WS_Z = 318 * MiB;
constexpr size_t KAV_STRIDE = 65 * MiB / 4;
constexpr size_t WS_KA = WS_Z + 585 * MiB / 4, WS_VA = WS_KA + KAV_STRIDE;
constexpr size_t QKV_STRIDE = 33 * MiB / 2;
constexpr size_t WS_QB = 497 * MiB, WS_KB = WS_QB + QKV_STRIDE, WS_VB = WS_QB + 2 * QKV_STRIDE;
constexpr size_t WS_END = 546 * MiB;
constexpr size_t ZO_HID = 72 * MiB;
constexpr size_t ZO_YE = 0;

__device__ __forceinline__ float sigmoidf_(float x) { return __builtin_amdgcn_rcpf(1.f + __builtin_amdgcn_exp2f(-1.4426950408889634f * x)); }
__device__ __forceinline__ float gelu_tanh(float x) { return x * sigmoidf_(1.5957691216057308f * (x + 0.044715f * x * x * x)); }
__device__ __forceinline__ float siluf_(float x) { return x * sigmoidf_(x); }
template <int K> __device__ __forceinline__ int xori_(int v) { static_assert(K >= 1 && K < 32, "lane exchange inside a half-wave");
    if constexpr (K == 1) return __builtin_amdgcn_update_dpp(v, v, 0xB1, 0xF, 0xF, false);
    else if constexpr (K == 2) return __builtin_amdgcn_update_dpp(v, v, 0x4E, 0xF, 0xF, false);
    else if constexpr (K == 8) return __builtin_amdgcn_update_dpp(v, v, 0x128, 0xF, 0xF, false);
    else return __builtin_amdgcn_ds_swizzle(v, (K << 10) | 0x1f); }
template <int K> __device__ __forceinline__ float xorf_(float v) { return __int_as_float(xori_<K>(__float_as_int(v))); }
__device__ __forceinline__ float xor32f_(float v, bool lo32) { const auto rr = __builtin_amdgcn_permlane32_swap(__float_as_uint(v), __float_as_uint(v), false, false); return __uint_as_float(lo32 ? rr[1] : rr[0]); }
__device__ __forceinline__ float sum32f_(float v) { const auto rr = __builtin_amdgcn_permlane32_swap(__float_as_uint(v), __float_as_uint(v), false, false); return __uint_as_float(rr[0]) + __uint_as_float(rr[1]); }
__device__ __forceinline__ float wave_sum(float v) { v += xorf_<1>(v); v += xorf_<2>(v); v += xorf_<4>(v); v += xorf_<8>(v); v += xorf_<16>(v); return sum32f_(v); }

enum { K_P0 = 0, K_H1 = 1, K_G1 = 2, K_MIX = 3, K_M1 = 4, K_M2 = 5, K_R = 6, K_S = 7, K_E1 = 8, K_E2 = 9, K_CB = 10 };
__device__ __forceinline__ size_t kv_tiled_off(int sel, int key, int cw) {
    const size_t t = (size_t)(key >> 6) * 8192; const int kk = key & 63;
    return sel == 1 ? t + (size_t)((((cw >> 6) * 8 + ((cw & 63) >> 3)) * 64 + kk) * 8 + (cw & 7)) : t + (size_t)((((cw >> 5) * 4 + (kk >> 4)) * 16 + (kk & 15)) * 32 + (cw & 31));
}
constexpr size_t HB8 = (size_t)R * 128;
__device__ __forceinline__ size_t k8_tiled_off(int key, int cw) { return (size_t)(key >> 6) * 8192 + (size_t)((((cw >> 6) * 4 + ((cw & 63) >> 4)) * 64 + (key & 63)) * 16 + (cw & 15)); }
__device__ __forceinline__ unsigned pk4_fp8u(float a, float b, float c, float d) { int r; asm volatile("" : "=v"(r)); r = __builtin_amdgcn_cvt_pk_fp8_f32(a, b, r, false); r = __builtin_amdgcn_cvt_pk_fp8_f32(c, d, r, true); return (unsigned)r; }
__device__ __forceinline__ unsigned pk4_fp8(float a, float b, float c, float d) { int r = __builtin_amdgcn_cvt_pk_fp8_f32(a, b, 0, false); r = __builtin_amdgcn_cvt_pk_fp8_f32(c, d, r, true); return (unsigned)r; }
__device__ __forceinline__ size_t v8_tiled_off(int key, int cw) { const int kk = key & 31, i = (kk & 3) + 4 * (kk >> 3), hk = (kk >> 2) & 1, jj = (key >> 5) & 1;
    return (size_t)(key >> 6) * 8192 + (size_t)(((((cw >> 5) * 4 + 2 * hk + jj) * 32 + (cw & 31)) * 16) + i); }
__device__ __forceinline__ unsigned char f2fp8(float a) { return (unsigned char)(__builtin_amdgcn_cvt_pk_fp8_f32(a, a, 0, false) & 0xff); }
constexpr size_t HA8 = (size_t)(R / 64) * 4096;
__device__ __forceinline__ int na8k_off(int kk, int d) { return (((d >> 4) * 64 + kk) * 16) + (d & 15); }
__device__ __forceinline__ int na8v_off(int kk, int d) { const int k5 = kk & 31, i = (k5 & 3) + 4 * (k5 >> 3), hk = (k5 >> 2) & 1, jj = kk >> 5; return ((((d >> 5) * 4 + 2 * hk + jj) * 32 + (d & 31)) * 16) + i; }
__device__ __forceinline__ int na_tiled_off(int isv, int kk, int d) { return isv ? ((((d >> 5) * 4 + (kk >> 4)) * 16 + (kk & 15)) * 32 + (d & 31)) : (((d >> 3) * 64 + kk) * 8 + (d & 7)); }
__device__ __forceinline__ int lane_id_() { int l; asm volatile("v_mbcnt_lo_u32_b32 %0, -1, 0\n\tv_mbcnt_hi_u32_b32 %0, -1, %0" : "=v"(l)); return l; }

namespace pg8 {
#define PG8_LAS __attribute__((address_space(3)))
typedef unsigned short bf16_t;
typedef short bf16x8 __attribute__((ext_vector_type(8)));
typedef float f32x4 __attribute__((ext_vector_type(4)));
typedef unsigned u32x4 __attribute__((ext_vector_type(4)));
constexpr int BM = 256, BK = 64, HALF = 128, HTB = HALF * BK * 2  , STAGE_BYTES = 8 * HTB, NXCD = 8, WGM = 8;

__host__ __device__ __forceinline__ int lds_byte(int r, int c) { const int st = (r >> 4) * 2 + (c >> 5), rr = r & 15, cc = c & 31, ob = rr * 64 + cc * 2; return st * 1024 + (ob ^ (((ob >> 9) & 1) << 5)); }
__host__ __device__ __forceinline__ void stage_rc(int b, int& R, int& C) { const int st = b / 1024, sb = b % 1024, swz = sb ^ (((sb >> 9) & 1) << 5); R = (st >> 1) * 16 + swz / 64; C = (st & 1) * 32 + (swz % 64) / 2; }
__host__ __device__ __forceinline__ int perm32(int rho) { const int n = rho >> 4, i = rho & 15; return 8 * (i >> 2) + 4 * n + (i & 3); }

struct Unit { int pm, pn; };
struct Gemm { const bf16_t* A; const bf16_t* Bt; int M, N, K; };

struct StaticOrder {
    int nM, nN, nwg, G, c;
    __host__ __device__ void init(int M, int N, int G_, int c_) { nM = M / BM; nN = N / BM; nwg = nM * nN; G = G_; c = c_; }
    __host__ __device__ bool next(int i, Unit& u) const {
        const long L = (long)i * G + c; if (L >= nwg) return false;
        int wgid = (int)L; { const int q = nwg / NXCD, r = nwg % NXCD, xcd = wgid % NXCD, off = wgid / NXCD; wgid = (xcd < r ? xcd * (q + 1) : r * (q + 1) + (xcd - r) * q) + off; }
        const int nig = WGM * nN, gid = wgid / nig, fm = gid * WGM, gsz = (nM - fm) < WGM ? (nM - fm) : WGM;
        u.pm = fm + ((wgid % nig) % gsz); u.pn = (wgid % nig) / gsz; return true;
    }
    __device__ __forceinline__ void a_ready(const Unit&) const {}
    __device__ __forceinline__ void done(const Unit&) const {}
};

__device__ __forceinline__ unsigned cvt_pk_bf16(float lo, float hi) { unsigned r; asm volatile("v_cvt_pk_bf16_f32 %0, %1, %2" : "=v"(r) : "v"(lo), "v"(hi)); return r; }
typedef float f32x2 __attribute__((ext_vector_type(2)));
template <class Epi, class Sched>
__device__ __forceinline__ void gemm_phase(PG8_LAS unsigned char* lds, const Gemm g, const Sched& S, const Epi& E, const bool PERM, const bool GATHER, const int tid_in) {
    constexpr bool ALIGN_EPI = true, SP2 = true;
    int tid_ = tid_in; asm volatile("" : "+v"(tid_));
    const int tid = tid_, wid = __builtin_amdgcn_readfirstlane(tid >> 6), lane = tid & 63, wr = wid >> 2, wc = wid & 3, fr = lane & 15, fq = lane >> 4;
    const int K = g.K, nt = K / BK;
    unsigned voffA[2], voffB[2];
#pragma unroll
    for (int i = 0; i < 2; ++i) { int R, C; stage_rc(tid * 16 + i * 8192, R, C); const int Rb = PERM ? ((R & ~31) + perm32(R & 31)) : R;
        voffA[i] = (unsigned)(R * K + C) * 2u; voffB[i] = (unsigned)(Rb * K + C) * 2u; }
    unsigned vc0[2], vc1[2], vn0[2], vn1[2];
#pragma unroll
    for (int i = 0; i < 2; ++i) { vc0[i] = vc1[i] = vn0[i] = vn1[i] = voffA[i]; }
#define PG8_GLOAD(dst0, dst1, u) do { if (GATHER) { const int* gi_ = S.rows(u); int t_ = tid; asm volatile("" : "+v"(t_)); int ga_[2], gb_[2], cc_[2];     \
        _Pragma("unroll") for (int i = 0; i < 2; ++i) { int R_, C_; stage_rc(t_ * 16 + i * 8192, R_, C_); ga_[i] = gi_[R_]; gb_[i] = gi_[R_ + HALF]; cc_[i] = C_; } \
        _Pragma("unroll") for (int i = 0; i < 2; ++i) { dst0[i] = (unsigned)ga_[i] * (unsigned)(K * 2) + (unsigned)(cc_[i] * 2); dst1[i] = (unsigned)gb_[i] * (unsigned)(K * 2) + (unsigned)(cc_[i] * 2); } } } while (0)
    const size_t kstep = (size_t)(BK * 2);
    const size_t hstep = (size_t)HALF * K * 2;
    const size_t tstep = 2 * hstep; const size_t hstepA = GATHER ? 0 : hstep, tstepA = GATHER ? 0 : tstep;
    const unsigned ldsw = (unsigned)wid * 1024u;
    const int aoff = lds_byte(wr * 64 + fr, fq * 8), boff = lds_byte(wc * 32 + fr, fq * 8);
#define PG8_SA(b, h) (((b) * 2 + (h)) * HTB)
#define PG8_SB(b, h) ((4 + (b) * 2 + (h)) * HTB)
#define PG8_STAGE(bufoff, gbase, voff) do { _Pragma("unroll") for (int _i = 0; _i < 2; ++_i) \
        __builtin_amdgcn_global_load_lds((const unsigned*)((const char*)(gbase) + (voff)[_i]), (PG8_LAS unsigned*)(lds + (bufoff) + ldsw + _i * 8192), 16, 0, 0); } while (0)
#define PG8_LDA(dst, b, h) do { _Pragma("unroll") for (int m = 0; m < 4; ++m) _Pragma("unroll") for (int k = 0; k < 2; ++k) dst[m][k] = *(const PG8_LAS bf16x8*)(lds + PG8_SA(b, h) + aoff + m * 2048 + k * 1024); } while (0)
#define PG8_LDB(dst, b, h) do { _Pragma("unroll") for (int n = 0; n < 2; ++n) _Pragma("unroll") for (int k = 0; k < 2; ++k) dst[n][k] = *(const PG8_LAS bf16x8*)(lds + PG8_SB(b, h) + boff + n * 2048 + k * 1024); } while (0)
#define PG8_MMA(ai, bj, At, Bt) do { __builtin_amdgcn_s_setprio(1); _Pragma("unroll") for (int m = 0; m < 4; ++m) _Pragma("unroll") for (int n = 0; n < 2; ++n) _Pragma("unroll") for (int k = 0; k < 2; ++k) \
        acc[ai][bj][m][n] = __builtin_amdgcn_mfma_f32_16x16x32_bf16(Bt[n][k], At[m][k], acc[ai][bj][m][n], 0, 0, 0); __builtin_amdgcn_s_setprio(0); } while (0)
#define PG8_WAIT_V(n) asm volatile("s_waitcnt vmcnt(" #n ")" ::: "memory")
#define PG8_WAIT_L(n) asm volatile("s_waitcnt lgkmcnt(" #n ")" ::: "memory")
#define PG8_BAR __builtin_amdgcn_s_barrier()
#define PG8_SCHED __builtin_amdgcn_sched_barrier(0)
    Unit cur, nxt; int ui = 0;
    if (!S.next(0, cur)) return;
    f32x4 acc[2][2][4][2];
#pragma unroll
    for (int a = 0; a < 2; ++a)
#pragma unroll
        for (int b = 0; b < 2; ++b)
#pragma unroll
            for (int m = 0; m < 4; ++m)
#pragma unroll
                for (int n = 0; n < 2; ++n) acc[a][b][m][n] = (f32x4){0.f, 0.f, 0.f, 0.f};
    bf16x8 At[4][2], B0[2][2], B1[2][2];
    const char* cA = (const char*)g.A + (size_t)cur.pm * tstepA; const char* cB = (const char*)g.Bt + (size_t)cur.pn * tstep;
    S.a_ready(cur); PG8_GLOAD(vc0, vc1, cur);
    if constexpr (SP2) {
        PG8_STAGE(PG8_SB(0, 0), cB, voffB); PG8_STAGE(PG8_SB(0, 1), cB + hstep, voffB); PG8_STAGE(PG8_SA(0, 0), cA, vc0); PG8_STAGE(PG8_SA(0, 1), cA + hstepA, vc1);
        if (wr == 1) PG8_BAR;
        PG8_WAIT_V(2); PG8_BAR;
        PG8_STAGE(PG8_SB(1, 0), cB + kstep, voffB); PG8_STAGE(PG8_SA(1, 0), cA + kstep, vc0); PG8_STAGE(PG8_SB(1, 1), cB + hstep + kstep, voffB);
        PG8_WAIT_V(6); PG8_BAR;
    }
    for (;;) {
        const bool has_next = S.next(ui + 1, nxt);
        const char* nA = has_next ? (const char*)g.A + (size_t)nxt.pm * tstepA : cA; const char* nB = has_next ? (const char*)g.Bt + (size_t)nxt.pn * tstep : cB;
        if (GATHER) { if (has_next) PG8_GLOAD(vn0, vn1, nxt); else { _Pragma("unroll") for (int i = 0; i < 2; ++i) { vn0[i] = vc0[i]; vn1[i] = vc1[i]; } } }
        for (int t = 0; t < nt; t += 2) {
            const bool last = (t == nt - 2);
            unsigned m0[2], m1[2];
#pragma unroll
            for (int i = 0; i < 2; ++i) { m0[i] = (GATHER && last) ? vn0[i] : vc0[i]; m1[i] = (GATHER && last) ? vn1[i] : vc1[i]; }
            const char* a1 = cA + (size_t)(t + 1) * kstep;
            const char* a2 = last ? nA : cA + (size_t)(t + 2) * kstep; const char* b2 = last ? nB : cB + (size_t)(t + 2) * kstep;
            const char* a3 = a2 + kstep; const char* b3 = b2 + kstep;
            if (last && has_next) S.a_ready(nxt);
            if constexpr (SP2) {
            PG8_LDB(B0, 0, 0); PG8_LDB(B1, 0, 1); PG8_SCHED; PG8_LDA(At, 0, 0); PG8_STAGE(PG8_SA(1, 1), a1 + hstepA, vc1);
            PG8_WAIT_V(8); PG8_WAIT_L(0); PG8_BAR; PG8_MMA(0, 0, At, B0); PG8_MMA(0, 1, At, B1); PG8_BAR; PG8_SCHED;
            PG8_LDA(At, 0, 1); PG8_STAGE(PG8_SB(0, 0), b2, voffB); PG8_STAGE(PG8_SB(0, 1), b2 + hstep, voffB); PG8_STAGE(PG8_SA(0, 0), a2, m0);
            PG8_WAIT_V(8); PG8_WAIT_L(0); PG8_BAR; PG8_MMA(1, 0, At, B0); PG8_MMA(1, 1, At, B1); PG8_BAR; PG8_SCHED;
            PG8_LDB(B0, 1, 0); PG8_LDB(B1, 1, 1); PG8_SCHED; PG8_LDA(At, 1, 0); PG8_STAGE(PG8_SA(0, 1), a2 + hstepA, m1);
            PG8_WAIT_V(8); PG8_WAIT_L(0); PG8_BAR; PG8_MMA(0, 0, At, B0); PG8_MMA(0, 1, At, B1); PG8_BAR; PG8_SCHED;
            PG8_LDA(At, 1, 1); PG8_STAGE(PG8_SB(1, 0), b3, voffB); PG8_STAGE(PG8_SB(1, 1), b3 + hstep, voffB); PG8_STAGE(PG8_SA(1, 0), a3, m0);
            PG8_WAIT_V(8); PG8_WAIT_L(0); PG8_BAR; PG8_MMA(1, 0, At, B0); PG8_MMA(1, 1, At, B1); PG8_BAR; PG8_SCHED;
            } else { static_assert(SP2, "only the SP2 loop is kept"); }
        }
        if constexpr (ALIGN_EPI) { if (wr == 0) PG8_BAR; }
#ifdef PROBE_EPI2
        if (E.kind == PROBE_EPI2) E(acc, cur, wr, wc, fr, fq);
#endif
        if (E.carries()) { E.carry(acc, cur, wr, wc, fr, fq); S.done(cur); } else
        if constexpr (!Epi::AFTER_DRAIN) { E(acc, cur, wr, wc, fr, fq); S.done(cur); }
        if (!has_next) break;
        if (!E.keeps(cur))
#pragma unroll
        for (int a = 0; a < 2; ++a)
#pragma unroll
            for (int b = 0; b < 2; ++b)
#pragma unroll
                for (int m = 0; m < 4; ++m)
#pragma unroll
                    for (int n = 0; n < 2; ++n) acc[a][b][m][n] = (f32x4){0.f, 0.f, 0.f, 0.f};
        cur = nxt; cA = nA; cB = nB; ++ui;
#pragma unroll
        for (int i = 0; i < 2; ++i) { vc0[i] = vn0[i]; vc1[i] = vn1[i]; }
        if constexpr (ALIGN_EPI) { if (wr == 1) PG8_BAR; }
    }
    PG8_WAIT_V(0);
    if constexpr (!ALIGN_EPI) { if (wr == 0) PG8_BAR; }
    PG8_BAR;
    if constexpr (Epi::AFTER_DRAIN) { E.fused(acc, cur, wr, wc, fr, fq, lds, wid, lane); S.done(cur); }
#undef PG8_GLOAD
#undef PG8_SA
#undef PG8_SB
#undef PG8_STAGE
#undef PG8_LDA
#undef PG8_LDB
#undef PG8_MMA
#undef PG8_WAIT_V
#undef PG8_WAIT_L
#undef PG8_BAR
#undef PG8_SCHED
}
}

typedef pg8::f32x4 f32x4; typedef pg8::u32x4 u32x4; typedef pg8::Unit Unit;
typedef float f32x16 __attribute__((ext_vector_type(16)));
typedef short bf16x8 __attribute__((ext_vector_type(8)));
typedef unsigned u32x2 __attribute__((ext_vector_type(2)));

struct EpiZ { static constexpr bool PERM = true, AFTER_DRAIN = false;
    bf16_t* Z; const float* rope; unsigned char* qkv;
    __device__ __forceinline__ void operator()(const f32x4 (&acc)[2][2][4][2], const Unit& u, int wr, int wc, int fr, int fq) const {
        const int row0 = u.pm * 256 + wr * 64 + fr, col0 = u.pn * 256 + wc * 32 + 8 * fq, pn = u.pn;
        const int type = (pn == 4 || pn == 5) ? 1 : (pn == 10 || pn == 11) ? 2 : (pn >= 12 && pn < 16) ? 3 : (pn >= 16) ? 4 : 0;
        if (pn == 2 || pn == 3 || pn == 6 || pn == 7) {
            typedef __attribute__((address_space(3))) unsigned char lds_u8; typedef __attribute__((address_space(3))) u32x4 lds_u32x4;
            lds_u8* scr = (lds_u8*)(unsigned)(132096u + (unsigned)(wr * 4 + wc) * 2048u);
            const bool isna = pn < 4; const int lane_ = fr + 16 * fq;
#pragma unroll
            for (int ai = 0; ai < 2; ++ai)
#pragma unroll
                for (int bj = 0; bj < 2; ++bj) { const int tile = (u.pm * 256 + wr * 64 + ai * 128) >> 6;
                    unsigned char* gb = isna ? qkv + (WS_KA - WS_QB) + KAV_STRIDE + (size_t)((pn & 1) * 4 + (wc >> 1) + 2 * bj) * HA8 + (size_t)tile * 4096 + (wc & 1) * 2048
                                             : qkv + (size_t)2 * QKV_STRIDE + (size_t)((pn & 1) * 2 + bj) * HB8 + (size_t)tile * 8192 + wc * 2048;
#pragma unroll
                    for (int m = 0; m < 4; ++m) { const int k5 = 16 * (m & 1) + fr, i_ = (k5 & 3) + 4 * (k5 >> 3), hk = (k5 >> 2) & 1, jj = m >> 1;
#pragma unroll
                        for (int e = 0; e < 4; ++e) { scr[((2 * hk + jj) * 32 + 8 * fq + e) * 16 + i_] = f2fp8(acc[ai][bj][m][0][e]); scr[((2 * hk + jj) * 32 + 8 * fq + 4 + e) * 16 + i_] = f2fp8(acc[ai][bj][m][1][e]); } }
                    asm volatile("s_waitcnt lgkmcnt(0)" ::: "memory");
                    const u32x4 w0 = *(const lds_u32x4*)(scr + lane_ * 16), w1 = *(const lds_u32x4*)(scr + 1024 + lane_ * 16);
                    *(GAS u32x4*)(gb + lane_ * 16) = w0; *(GAS u32x4*)(gb + 1024 + lane_ * 16) = w1;
                    asm volatile("s_waitcnt lgkmcnt(0)" ::: "memory"); }
            return; }
        const int colhalf = wc & 1; const float* rc = rope + (colhalf ? 8192 : 0) + 8 * (fq & 1); const float* rs = rc + (colhalf ? 1024 : 4096);
#pragma unroll
        for (int ai = 0; ai < 2; ++ai)
#pragma unroll
            for (int m = 0; m < 4; ++m) { const int row = row0 + ai * 128 + m * 16;
                const int cq = (pn & 1) * 256 + wc * 32 + 8 * fq;
                bf16_t* rowp; size_t bjstep = 128;
                if (type == 1 || type == 2 || pn == 6 || pn == 7) { const int sel = type == 2 ? 0 : type == 1 ? 1 : 2; bf16_t* hb = (bf16_t*)(qkv + (size_t)sel * QKV_STRIDE); rowp = hb + (size_t)(cq >> 7) * HB + (sel == 0 ? (size_t)row * 128 + (cq & 127) : kv_tiled_off(sel, row, cq & 127)); bjstep = HB; }
                else if (pn < 4) { bf16_t* ab = (bf16_t*)(qkv + (WS_KA - WS_QB) + (size_t)(pn >> 1) * KAV_STRIDE); rowp = ab + (size_t)(cq >> 6) * HA + (size_t)(row >> 6) * 4096 + na_tiled_off(pn >> 1, row & 63, cq & 63); bjstep = 2 * HA; }
                else { const int zc = pn < 10 ? ZQA + (pn - 8) * 256 : pn < 16 ? ZU + (pn - 12) * 256 : ZG + (pn - 16) * 256; rowp = Z + (size_t)row * PROJZ + zc + wc * 32 + 8 * fq; }
                float cs[8], sn[8];
                if (type == 1 || type == 2) { const int pos = colhalf ? (row & 63) : (row >> 6);
                    const f32x4 c0 = *(const GAS f32x4*)(rc + pos * 16), c1 = *(const GAS f32x4*)(rc + pos * 16 + 4), s0 = *(const GAS f32x4*)(rs + pos * 16), s1 = *(const GAS f32x4*)(rs + pos * 16 + 4);
#pragma unroll
                    for (int e = 0; e < 4; ++e) { cs[e] = c0[e]; cs[4 + e] = c1[e]; sn[e] = fq < 2 ? -s0[e] : s0[e]; sn[4 + e] = fq < 2 ? -s1[e] : s1[e]; } }
#pragma unroll
                for (int bj = 0; bj < 2; ++bj) { float v[8];
#pragma unroll
                    for (int e = 0; e < 4; ++e) { v[e] = acc[ai][bj][m][0][e]; v[4 + e] = acc[ai][bj][m][1][e]; }
                    if (type == 1 || type == 2) { const float sc = type == 2 ? C2 : 1.f;
#pragma unroll
                        for (int e = 0; e < 8; ++e) { const float p = xor32f_(v[e], fq < 2); v[e] = (v[e] * cs[e] + p * sn[e]) * sc; } }
                    else if (type == 3) {
#pragma unroll
                        for (int e = 0; e < 8; ++e) v[e] = gelu_tanh(v[e]); }
                    else if (type == 4) {
#pragma unroll
                        for (int e = 0; e < 8; ++e) v[e] = sigmoidf_(v[e]); }
                    else if (pn == 8 || pn == 9) {
#pragma unroll
                        for (int e = 0; e < 8; ++e) v[e] *= C2; }
                    if (type == 1 || type == 2) {
                        const int cq8 = (pn & 1) * 256 + wc * 32 + 8 * fq; unsigned char* p8 = qkv + (size_t)(type == 2 ? 0 : 1) * QKV_STRIDE + (size_t)((cq8 >> 7) + bj) * HB8 + (type == 2 ? (size_t)row * 128 + (cq8 & 127) : k8_tiled_off(row, cq8 & 127));
                        u32x2 w8; w8.x = pk4_fp8u(v[0], v[1], v[2], v[3]); w8.y = pk4_fp8u(v[4], v[5], v[6], v[7]); *(GAS u32x2*)p8 = w8; }
                    else if (pn < 4) {
                        const int cq8 = (pn & 1) * 256 + wc * 32 + 8 * fq; unsigned char* b8 = qkv + (WS_KA - WS_QB) + (size_t)(pn >> 1) * KAV_STRIDE + (size_t)((cq8 >> 6) + 2 * bj) * HA8 + (size_t)(row >> 6) * 4096;
                        if (pn < 2) { u32x2 w8; w8.x = pk4_fp8u(v[0], v[1], v[2], v[3]); w8.y = pk4_fp8u(v[4], v[5], v[6], v[7]); *(GAS u32x2*)(b8 + na8k_off(row & 63, cq8 & 63)) = w8; }
                        else {
#pragma unroll
                            for (int e = 0; e < 8; ++e) *(GAS unsigned char*)(b8 + na8v_off(row & 63, (cq8 & 63) + e)) = f2fp8(v[e]); } }
                    else if (pn == 6 || pn == 7) {
                        const int cq8 = (pn & 1) * 256 + wc * 32 + 8 * fq; unsigned char* b8 = qkv + (size_t)2 * QKV_STRIDE + (size_t)((cq8 >> 7) + bj) * HB8;
#pragma unroll
                        for (int e = 0; e < 8; ++e) *(GAS unsigned char*)(b8 + v8_tiled_off(row, (cq8 & 127) + e)) = f2fp8(v[e]); }
                    else {
                    u32x4 w; w.x = pk2(v[0], v[1]); w.y = pk2(v[2], v[3]); w.z = pk2(v[4], v[5]); w.w = pk2(v[6], v[7]);
                    *(GAS u32x4*)(rowp + bj * bjstep) = w; } } }
    }
};
__device__ __forceinline__ void unpack8(const u32x4 w, float (&f)[8]) {
    f[0] = __uint_as_float(w.x << 16); f[1] = __uint_as_float(w.x & 0xffff0000u); f[2] = __uint_as_float(w.y << 16); f[3] = __uint_as_float(w.y & 0xffff0000u);
    f[4] = __uint_as_float(w.z << 16); f[5] = __uint_as_float(w.z & 0xffff0000u); f[6] = __uint_as_float(w.w << 16); f[7] = __uint_as_float(w.w & 0xffff0000u);
}
struct EpiMerge { static constexpr bool PERM = true, AFTER_DRAIN = false;
    bf16_t* Mb; const bf16_t* Z;
    __device__ __forceinline__ void carry(f32x4 (&acc)[2][2][4][2], const Unit& u, int wr, int wc, int fr, int fq) const {
        const int j = u.pn >> 2, pm = u.pm - 65 * j, pn = u.pn & 3;
        const int row0 = pm * 256 + wr * 64 + fr, col0 = pn * 256 + wc * 32 + 8 * fq;
#pragma unroll
        for (int qa = 0; qa < 4; ++qa) { const int ai = qa >> 1, mh = qa & 1;
            const bf16_t* gp0 = Z + (size_t)(row0 + ai * 128 + mh * 32) * PROJZ + ZG + j * 1024 + col0;
            u32x4 gq[4];
#pragma unroll
            for (int q = 0; q < 4; ++q) gq[q] = *(const GAS u32x4*)(gp0 + (size_t)(q >> 1) * 16 * PROJZ + (q & 1) * 128);
            if (j < 2) { u32x4 gnq[4];
#pragma unroll
                for (int q = 0; q < 4; ++q) gnq[q] = *(const GAS u32x4*)(gp0 + (size_t)(q >> 1) * 16 * PROJZ + (q & 1) * 128 + 1024);
#pragma unroll
                for (int q = 0; q < 4; ++q) { const int m = 2 * mh + (q >> 1), bj = q & 1; float g[8], gn[8]; unpack8(gq[q], g); unpack8(gnq[q], gn);
#pragma unroll
                    for (int e = 0; e < 8; ++e) g[e] = fmaxf(g[e], 1e-30f) * __builtin_amdgcn_rcpf(fmaxf(gn[e], 1e-30f));
#pragma unroll
                    for (int e = 0; e < 4; ++e) { acc[ai][bj][m][0][e] *= g[e]; acc[ai][bj][m][1][e] *= g[4 + e]; } } }
            else {
#pragma unroll
                for (int q = 0; q < 4; ++q) { const int m = 2 * mh + (q >> 1), bj = q & 1; float g[8], v[8]; unpack8(gq[q], g);
#pragma unroll
                    for (int e = 0; e < 4; ++e) { v[e] = fmaxf(g[e], 1e-30f) * acc[ai][bj][m][0][e]; v[4 + e] = fmaxf(g[4 + e], 1e-30f) * acc[ai][bj][m][1][e]; }
                    u32x4 w; w.x = pk2(v[0], v[1]); w.y = pk2(v[2], v[3]); w.z = pk2(v[4], v[5]); w.w = pk2(v[6], v[7]);
                    *(GAS u32x4*)(Mb + (size_t)(row0 + ai * 128 + m * 16) * D + col0 + bj * 128) = w; } } }
    }
};
struct EpiResid { static constexpr bool PERM = false, AFTER_DRAIN = false;
    const float* xold; float* xnew; const float* gt;
    __device__ __forceinline__ void operator()(const f32x4 (&acc)[2][2][4][2], const Unit& u, int wr, int wc, int fr, int fq) const {
        const int row0 = u.pm * 256 + wr * 64 + fr, col0 = u.pn * 256 + wc * 32 + 4 * fq;
        f32x4 gv[2][2];
#pragma unroll
        for (int bj = 0; bj < 2; ++bj)
#pragma unroll
            for (int n = 0; n < 2; ++n) gv[bj][n] = *(const GAS f32x4*)(gt + col0 + bj * 128 + n * 16);
#pragma unroll
        for (int qa = 0; qa < 4; ++qa) { const int ai = qa >> 1, mh = qa & 1; f32x4 xo[2][2][2];
#pragma unroll
            for (int mm = 0; mm < 2; ++mm)
#pragma unroll
                for (int bj = 0; bj < 2; ++bj)
#pragma unroll
                    for (int n = 0; n < 2; ++n) xo[mm][bj][n] = *(const GAS f32x4*)(xold + (size_t)(row0 + ai * 128 + (2 * mh + mm) * 16) * D + col0 + bj * 128 + n * 16);
#pragma unroll
            for (int mm = 0; mm < 2; ++mm)
#pragma unroll
                for (int bj = 0; bj < 2; ++bj)
#pragma unroll
                    for (int n = 0; n < 2; ++n) *(GAS f32x4*)(xnew + (size_t)(row0 + ai * 128 + (2 * mh + mm) * 16) * D + col0 + bj * 128 + n * 16) = xo[mm][bj][n] + gv[bj][n] * acc[ai][bj][2 * mh + mm][n]; }
    }
};
struct EpiHid { static constexpr bool PERM = true, AFTER_DRAIN = false;
    bf16_t* HID;
    __device__ __forceinline__ void operator()(const f32x4 (&acc)[2][2][4][2], const Unit& u, int wr, int wc, int fr, int fq) const {
        const int row0 = u.pm * 256 + wr * 64 + fr, col0 = (u.pn & 7) * 128 + wc * 32 + 8 * fq;
#pragma unroll
        for (int ai = 0; ai < 2; ++ai)
#pragma unroll
            for (int m = 0; m < 4; ++m) { float v[8];
#pragma unroll
                for (int e = 0; e < 4; ++e) { v[e] = siluf_(acc[ai][0][m][0][e]) * acc[ai][1][m][0][e]; v[4 + e] = siluf_(acc[ai][0][m][1][e]) * acc[ai][1][m][1][e]; }
                u32x4 w; w.x = pk2(v[0], v[1]); w.y = pk2(v[2], v[3]); w.z = pk2(v[4], v[5]); w.w = pk2(v[6], v[7]);
                *(GAS u32x4*)(HID + (size_t)(row0 + ai * 128 + m * 16) * FF + col0) = w; }
    }
};
struct EpiYe { static constexpr bool PERM = true, AFTER_DRAIN = false;
    bf16_t* YE; const float* gate;
    __device__ __forceinline__ void operator()(const f32x4 (&acc)[2][2][4][2], const Unit& u, int wr, int wc, int fr, int fq) const {
        const int row0 = u.pm * 256 + wr * 64 + fr, col0 = (u.pn & 3) * 256 + wc * 32 + 8 * fq;
        float gs[2][4];
#pragma unroll
        for (int ai = 0; ai < 2; ++ai)
#pragma unroll
            for (int m = 0; m < 4; ++m) gs[ai][m] = *(const GAS float*)(gate + row0 + ai * 128 + m * 16);
#pragma unroll
        for (int ai = 0; ai < 2; ++ai)
#pragma unroll
            for (int m = 0; m < 4; ++m) { const int row = row0 + ai * 128 + m * 16; const float gsc = gs[ai][m];
#pragma unroll
                for (int bj = 0; bj < 2; ++bj) { const f32x4 a = acc[ai][bj][m][0] * gsc, b = acc[ai][bj][m][1] * gsc;
                    u32x4 w; w.x = pk2(a[0], a[1]); w.y = pk2(a[2], a[3]); w.z = pk2(b[0], b[1]); w.w = pk2(b[2], b[3]);
                    *(GAS u32x4*)(YE + (size_t)row * D + col0 + bj * 128) = w; } }
    }
};
struct UEpi { static constexpr bool AFTER_DRAIN = false; int kind, l; unsigned char* ws; float* out; const float* xold;
    __device__ __forceinline__ bool carries() const { return kind == K_M1; }
    __device__ __forceinline__ bool keeps(const Unit& u) const { return kind == K_M1 && (u.pn >> 2) < 2; }
    __device__ __forceinline__ void carry(f32x4 (&acc)[2][2][4][2], const Unit& u, int wr, int wc, int fr, int fq) const {
        asm volatile("" : "+v"(fr), "+v"(fq));
        unsigned char* ws = this->ws; asm volatile("" : "+s"(ws));
        const EpiMerge e{(bf16_t*)(ws + WS_H), (const bf16_t*)(ws + WS_Z)}; e.carry(acc, u, wr, wc, fr, fq); }
    __device__ __forceinline__ void operator()(const f32x4 (&acc)[2][2][4][2], const Unit& u, int wr, int wc, int fr, int fq) const {
        asm volatile("" : "+v"(fr), "+v"(fq));
        unsigned char* ws = this->ws; float* out = this->out; const float* xold = this->xold; asm volatile("" : "+s"(ws), "+s"(out), "+s"(xold));
        if (kind == K_G1) { const EpiZ e{(bf16_t*)(ws + WS_Z), (const float*)(ws + OFF_ROPE), ws + WS_QB}; e(acc, u, wr, wc, fr, fq); }
        else if (kind == K_M1) { }
        else if (kind == K_M2) { const EpiResid e{xold, out, (const float*)(ws + OFF_MOD) + (size_t)l * 2 * 6144 + 2048}; e(acc, u, wr, wc, fr, fq); }
        else if (kind == K_E1) { const EpiHid e{(bf16_t*)(ws + WS_Z + ZO_HID)}; e(acc, u, wr, wc, fr, fq); }
        else { const EpiYe e{(bf16_t*)(ws + WS_Z + ZO_YE), (const float*)(ws + OFF_GATE)}; e(acc, u, wr, wc, fr, fq); }
    }
};
struct USched { int kind, c, G; const int* idx;
    __device__ __forceinline__ void a_ready(const Unit&) const {} __device__ __forceinline__ void done(const Unit&) const {}
    __device__ __forceinline__ const int* rows(const Unit& u) const { return idx + u.pm * 256; }
    __device__ __forceinline__ bool next(int i, Unit& u) const {
        if (kind == K_G1) {
            constexpr int nM = L / 256, nN = PROJ / 256, nwg = nM * nN; const long Lx = (long)i * G + c; if (Lx >= nwg) return false;
            int wgid = (int)Lx; { const int q = nwg / 8, r = nwg % 8, xcd = wgid % 8, off = wgid / 8; wgid = (xcd < r ? xcd * (q + 1) : r * (q + 1) + (xcd - r) * q) + off; }
            const int nig = 8 * nN, gid = wgid / nig, fm = gid * 8, gsz = (nM - fm) < 8 ? (nM - fm) : 8; u.pm = fm + ((wgid % nig) % gsz); u.pn = (wgid % nig) / gsz; return true; }
        if (kind == K_M1) { const int rnd = i / 3, j = i - 3 * rnd; const int t = rnd * G + c; if (t >= 256) return false;
            const int T = (t & 7) * 32 + (t >> 3); u.pm = 65 * j + (T >> 2); u.pn = 4 * j + (T & 3); return true; }
        if (kind == K_M2) { const int t = i * G + c; if (t >= 256) return false; const int T = (t & 7) * 32 + (t >> 3); u.pm = T >> 2; u.pn = T & 3; return true; }
        if (kind == K_E1) { const int t = i * G + c; if (t >= 1024) return false; const int x = t & 7, q = t >> 3;
            const int e = 2 * x + (q >> 6), ui = q & 63; u.pm = 9 * e + (ui >> 3); u.pn = 8 * e + (ui & 7); return true; }
        { const int t = i * G + c; if (t >= 512) return false; const int x = t & 7, q = t >> 3;
            const int e = 2 * x + (q >> 5), ui = q & 31; u.pm = 9 * e + (ui >> 2); u.pn = 4 * e + (ui & 3); return true; }
    }
};

template <int NB>
__device__ __forceinline__ void wgemm_tile(const bf16_t* arow, const bf16_t* brow0, const bf16_t* brow1, int K, f32x16 (&acc)[NB]) {
#pragma unroll
    for (int b = 0; b < NB; ++b)
#pragma unroll
        for (int i = 0; i < 16; ++i) acc[b][i] = 0.f;
#pragma unroll 4
    for (int k0 = 0; k0 < K; k0 += 16) {
        const bf16x8 a = *(const bf16x8*)(arow + k0); const bf16x8 b0 = *(const bf16x8*)(brow0 + k0);
        acc[0] = __builtin_amdgcn_mfma_f32_32x32x16_bf16(b0, a, acc[0], 0, 0, 0);
        if constexpr (NB == 2) { const bf16x8 b1 = *(const bf16x8*)(brow1 + k0); acc[1] = __builtin_amdgcn_mfma_f32_32x32x16_bf16(b1, a, acc[1], 0, 0, 0); }
    }
}


#define GAS __attribute__((address_space(1)))
#define LAS __attribute__((address_space(3)))
typedef GAS unsigned gu32;
#define RLX_AGENT __ATOMIC_RELAXED, __HIP_MEMORY_SCOPE_AGENT
#define LDS_WAIT() asm volatile("s_waitcnt lgkmcnt(0)" ::: "memory")
#define VM_WAIT() asm volatile("s_waitcnt vmcnt(0)" ::: "memory")
#define XB_TMO      128
#define XB_XCNT(j)  (256  + 64 * (j))
#define XB_XSUB(j)  (1280 + 64 * (j))
#define XB_XGEN(j)  (2304 + 64 * (j))
#define XB_TOP      3328
#define XB_TOPGEN   3392
#define XCD_BAR_WORDS 3456
#define XB_SPIN_CAP (1u << 24)

__device__ __forceinline__ unsigned xb_ld(unsigned* p)              { return __hip_atomic_load(p, __ATOMIC_RELAXED, __HIP_MEMORY_SCOPE_AGENT); }
__device__ __forceinline__ unsigned xb_add(unsigned* p, unsigned v) { return __hip_atomic_fetch_add(p, v, __ATOMIC_RELAXED, __HIP_MEMORY_SCOPE_AGENT); }
__device__ __forceinline__ unsigned xb_xcc_id() { return (unsigned)__builtin_amdgcn_s_getreg((3 << 11) | 20) & 0xFu; }
#define XB_SPIN(cond, bar) do { unsigned _sp = 0; while (cond) { __builtin_amdgcn_s_sleep(1); \
    if ((++_sp & 255u) == 0u) { if (xb_ld(&(bar)[XB_TMO])) break; if (_sp > XB_SPIN_CAP) { atomicAdd(&(bar)[XB_TMO], 1u); break; } } } } while (0)

struct XcdBarrier {
    unsigned* bar; unsigned x;
    volatile LAS unsigned* st;
};

__device__ __forceinline__ XcdBarrier xcd_barrier_post(unsigned* bar, volatile LAS unsigned* st) {
    XcdBarrier b; b.bar = bar; b.x = xb_xcc_id(); b.st = st;
    if (threadIdx.x == 0) (void)xb_add(&bar[XB_XCNT(b.x)], 1u);
    return b;
}
__device__ __forceinline__ void xcd_barrier_complete(unsigned* bar, unsigned x, unsigned& nloc, unsigned& nx) {
    const unsigned G = gridDim.x * gridDim.y * gridDim.z;
    unsigned sum, cnt, mine, sp = 0u;
    for (;;) {
        sum = 0u; cnt = 0u; mine = 0u;
#pragma unroll
        for (unsigned j = 0; j < 16; ++j) { const unsigned c = xb_ld(&bar[XB_XCNT(j)]); sum += c; cnt += (c > 0u) ? 1u : 0u; mine = (j == x) ? c : mine; }
        if (sum == G) break;
        __builtin_amdgcn_s_sleep(1);
        if ((++sp & 255u) == 0u) { if (xb_ld(&bar[XB_TMO])) break; if (sp > XB_SPIN_CAP) { atomicAdd(&bar[XB_TMO], 1u); break; } }
    }
    nloc = mine > 0u ? mine : 1u; nx = cnt > 0u ? cnt : 1u;
}

__device__ __forceinline__ void xcd_barrier(const XcdBarrier& b, const int tid) {
    asm volatile("s_waitcnt vmcnt(0)" ::: "memory");
    __syncthreads();
    if (tid == 0) {
        unsigned* bar = b.bar;
        __builtin_amdgcn_s_waitcnt(0);
        unsigned nloc = b.st[0], nx = b.st[1];
        if (nloc == 0u) { xcd_barrier_complete(bar, b.x, nloc, nx); b.st[0] = nloc; b.st[1] = nx; }
        const unsigned old = xb_add(&bar[XB_XSUB(b.x)], 1u);
        const unsigned gen = old / nloc;
        if (old + 1u == (gen + 1u) * nloc) {
            __builtin_amdgcn_fence(__ATOMIC_RELEASE, "agent");
            asm volatile("s_waitcnt vmcnt(0)" ::: "memory");
            const unsigned og = xb_add(&bar[XB_TOP], 1u);
            const unsigned tg = og / nx;
            if (og + 1u == (tg + 1u) * nx) xb_add(&bar[XB_TOPGEN], 1u);
            else XB_SPIN(xb_ld(&bar[XB_TOPGEN]) == tg, bar);
            __builtin_amdgcn_fence(__ATOMIC_ACQUIRE, "agent");
            xb_add(&bar[XB_XGEN(b.x)], 1u);
            asm volatile("s_waitcnt vmcnt(0)" ::: "memory");
        } else {
            XB_SPIN(xb_ld(&bar[XB_XGEN(b.x)]) == gen, bar);
            __builtin_amdgcn_fence(__ATOMIC_ACQUIRE, "agent");
            asm volatile("s_waitcnt vmcnt(0)" ::: "memory");
        }
    }
    __syncthreads();
}


namespace da {
typedef short s16x4 __attribute__((ext_vector_type(4)));
typedef int i32x8 __attribute__((ext_vector_type(8)));
constexpr int KSLOT = 16384, VOFF = 4 * KSLOT, WSF_OFF = 132096;
constexpr float THR = 8.f;
__device__ __forceinline__ int crow(int r, int hi) { return (r & 3) + 8 * (r >> 2) + 4 * hi; }
__device__ __forceinline__ s16x4 vtr(const LAS unsigned char* p) { return __builtin_bit_cast(s16x4, __builtin_amdgcn_ds_read_tr16_b64_v4i16((LAS s16x4*)p)); }
__device__ __forceinline__ float max3f(float a, float b, float c) { return fmaxf(fmaxf(a, b), c); }
__device__ __forceinline__ float max3a(float a, float b, float c) { float r; asm("v_max3_f32 %0, %1, %2, %3" : "=v"(r) : "v"(a), "v"(b), "v"(c)); return r; }
__device__ __forceinline__ float max2a(float a, float b) { float r; asm("v_max_f32 %0, %1, %2" : "=v"(r) : "v"(a), "v"(b)); return r; }
__device__ __forceinline__ unsigned cvtpk(float lo, float hi) { typedef float f2 __attribute__((ext_vector_type(2))); typedef __bf16 b2 __attribute__((ext_vector_type(2))); f2 v = {lo, hi}; b2 b = __builtin_convertvector(v, b2); return __builtin_bit_cast(unsigned, b); }

__device__ __forceinline__ void issue_piece(LAS unsigned char* lds_dst, const bf16_t* tile, int p, unsigned lane16) {
    __builtin_amdgcn_global_load_lds((const unsigned*)((const char*)(tile + p * 512) + lane16), (LAS unsigned*)(lds_dst + p * 1024), 16, 0, 0);
}
#define DA_ISSUE_K(tl, slot, i) do { if ((i) == 0) __builtin_amdgcn_global_load_lds((const unsigned*)(KBh + (size_t)(tl) * 8192 + wave * 1024 + lane16), (LAS unsigned*)(lds + (slot) * KSLOT + wave * 1024), 16, 0, 0); } while (0)
#define DA_ISSUE_V(tl, slot, i) do { if ((i) == 0) __builtin_amdgcn_global_load_lds((const unsigned*)(VBh + (size_t)(tl) * 8192 + wave * 1024 + lane16), (LAS unsigned*)(lds + VOFF + (slot) * KSLOT + wave * 1024), 16, 0, 0); } while (0)
#define DA_SYNC() do { asm volatile("s_waitcnt vmcnt(0) lgkmcnt(0)" ::: "memory"); __builtin_amdgcn_s_barrier(); asm volatile("" ::: "memory"); } while (0)
#define DA_SYNC4() do { asm volatile("" ::: "memory"); __builtin_amdgcn_s_waitcnt(0x0074)  ; __builtin_amdgcn_s_barrier(); asm volatile("" ::: "memory"); } while (0)
#define DA_SBAR() __builtin_amdgcn_sched_barrier(0)
#ifndef DA_ISSUE_AT
#define DA_ISSUE_AT 3
#endif
#if DA_ISSUE_AT == 1
#define DA_IA(x) x
#define DA_IE(x) do {} while (0)
#elif DA_ISSUE_AT == 3
#define DA_IA(x) do {} while (0)
#define DA_IE(x) x
#else
#define DA_IA(x) do {} while (0)
#define DA_IE(x) do {} while (0)
#endif
#ifndef DA_STAT
#define DA_STAT 0
#endif
#if DA_STAT
#define DA_T(k) do { DA_SBAR(); unsigned long long t_; asm volatile("s_memtime %0\n\ts_waitcnt lgkmcnt(0)" : "=s"(t_) :: "memory"); DA_SBAR(); if ((k) == DA_STAT) stat_acc -= t_; if ((k) == DA_STAT + 1) stat_acc += t_; } while (0)
#else
#define DA_T(k) do {} while (0)
#endif
#define DA_PIN(x) asm volatile("" : "+v"(x))
#define DA_EX(v) __builtin_amdgcn_exp2f(v)
#define DA_MF(a, b, c) __builtin_amdgcn_mfma_f32_32x32x16_bf16(a, b, c, 0, 0, 0)
#define DA_K8(kh) (i32x8){(int)kfl[kh].x, (int)kfl[kh].y, (int)kfl[kh].z, (int)kfl[kh].w, (int)kfh[kh].x, (int)kfh[kh].y, (int)kfh[kh].z, (int)kfh[kh].w}
#define DA_MF8(kh, c) __builtin_amdgcn_mfma_scale_f32_32x32x64_f8f6f4(DA_K8(kh), qf8, c, 0, 0, 0, 0x7f7f7f7f, 0, 0x7f7f7f7f)
#define DA_V8(dd) (i32x8){(int)vfl[dd].x, (int)vfl[dd].y, (int)vfl[dd].z, (int)vfl[dd].w, (int)vfh[dd].x, (int)vfh[dd].y, (int)vfh[dd].z, (int)vfh[dd].w}
#define DA_PP8 (i32x8){(int)ppa.x, (int)ppa.y, (int)ppa.z, (int)ppa.w, (int)ppb.x, (int)ppb.y, (int)ppb.z, (int)ppb.w}
#define DA_MFPV(dd) do { o[dd] = __builtin_amdgcn_mfma_scale_f32_32x32x64_f8f6f4(DA_PP8, DA_V8(dd), o[dd], 0, 0, 0, 0x7f7f7f7f, 0, 0x7f7f7f7f); } while (0)
#define DA_MFL() do { lacc = __builtin_amdgcn_mfma_scale_f32_32x32x64_f8f6f4(DA_PP8, ones8, lacc, 0, 0, 0, 0x7f7f7f7f, 0, 0x7f7f7f7f); } while (0)
#define DA_VRD8(dd) do { vfl[dd] = *(const LAS u32x4*)(vp_ + (dd) * 2048); vfh[dd] = *(const LAS u32x4*)(vp_ + (dd) * 2048 + 512); } while (0)
#define DA_KRD(j) do { if ((j) < 4) { const u32x4 t_ = *(const LAS u32x4*)(kp_ + ((j) & 1) * 1024 + ((j) >> 1) * 512); if ((j) & 1) kfh[(j) >> 1] = t_; else kfl[(j) >> 1] = t_; } } while (0)
#define DA_GAPA(MF) do { MF; DA_SBAR(); } while (0)
#define DA_EXG(X, B, PW, w0) do { _Pragma("unroll") for (int q_ = 0; q_ < 8; ++q_) X[(B) + q_] = DA_EX(X[(B) + q_]); \
    PW[w0] = pk4_fp8u(X[B], X[(B) + 1], X[(B) + 2], X[(B) + 3]); PW[(w0) + 1] = pk4_fp8u(X[(B) + 4], X[(B) + 5], X[(B) + 6], X[(B) + 7]); DA_SBAR(); } while (0)
#define DA_RS4(u_, f_) pk4_fp8(__builtin_amdgcn_cvt_f32_fp8((int)(u_), 0) * (f_), __builtin_amdgcn_cvt_f32_fp8((int)(u_), 1) * (f_), __builtin_amdgcn_cvt_f32_fp8((int)(u_), 2) * (f_), __builtin_amdgcn_cvt_f32_fp8((int)(u_), 3) * (f_))
#define DA_DECIDE(FIRST, C0, C1) do { \
    float rm_ = max2a(ma_, mb_);                  \
    if (FIRST || __any(rm_ > THR)) {              \
        { const auto rr_ = __builtin_amdgcn_permlane32_swap(__float_as_uint(rm_), __float_as_uint(rm_), false, false); asm("v_max_f32 %0, %1, %2" : "=v"(rm_) : "v"(rr_[0]), "v"(rr_[1])); }     \
        const float dl_ = FIRST ? rm_ - 4.f : fmaxf(rm_ - 4.f, 0.f), f_ = FIRST ? 0.f : DA_EX(-dl_);     \
        if (hi == 0) wsf[r32] = f_; \
        _Pragma("unroll") for (int g = 0; g < 4; ++g) { const f32x4 fr_ = *(const LAS f32x4*)(wsf + 8 * g + 4 * hi); \
            _Pragma("unroll") for (int i = 0; i < 4; ++i) { lacc[4 * g + i] *= fr_[i]; _Pragma("unroll") for (int d0 = 0; d0 < 4; ++d0) o[d0][4 * g + i] *= fr_[i]; } } \
        _Pragma("unroll") for (int i = 0; i < 4; ++i) { ppa[i] = DA_RS4(ppa[i], f_); ppb[i] = DA_RS4(ppb[i], f_); } \
        _Pragma("unroll") for (int i = 0; i < 16; ++i) { C0[i] -= dl_; C1[i] -= dl_; negm[i] -= dl_; } } \
    DA_SBAR(); } while (0)
#define DA_STEP(tt, FIRST) do { \
    DA_T(1); DA_SYNC4(); DA_T(2); \
    const int m3_ = (tt) & 3, tk_ = (tt) + 4 < NT ? (tt) + 4 : NT - 1, tv_ = (tt) + 2 < NT ? (tt) + 2 : NT - 1;     \
    const int vs_ = ((tt) + 2) & 3, vr_ = ((tt) + 3) & 3, kn_ = ((tt) + 1) & 3; \
    const LAS unsigned char* vp_ = lds + VOFF + vr_ * KSLOT + voff; const LAS unsigned char* kp_ = lds + kn_ * KSLOT + koff; \
    DA_VRD8(0); DA_VRD8(1); DA_GAPA(C0 = DA_MF8(0, negm)); DA_VRD8(2); DA_VRD8(3); DA_GAPA(C1 = DA_MF8(1, negm)); \
    DA_T(4); float ma_ = max3a(C0[0], C0[1], C0[2]), mb_ = max3a(C0[3], C0[4], C0[5]);     \
    _Pragma("unroll") for (int i_ = 6; i_ < 14; i_ += 4) { ma_ = max3a(ma_, C0[i_], C0[i_ + 1]); mb_ = max3a(mb_, C0[i_ + 2], C0[i_ + 3]); } \
    ma_ = max3a(ma_, C0[14], C0[15]); \
    DA_KRD(0); DA_KRD(1); \
    _Pragma("unroll") for (int i_ = 0; i_ < 16; i_ += 4) { mb_ = max3a(mb_, C1[i_], C1[i_ + 1]); ma_ = max3a(ma_, C1[i_ + 2], C1[i_ + 3]); } \
    DA_DECIDE(FIRST, C0, C1); DA_T(5); \
    DA_KRD(2); DA_KRD(3); \
    DA_MFPV(0); DA_EXG(C0, 0, pca, 0); DA_MFPV(1); DA_EXG(C0, 8, pca, 2); DA_MFPV(2); DA_EXG(C1, 0, pcb, 0); DA_MFPV(3); DA_MFL(); DA_EXG(C1, 8, pcb, 2); \
    ppa = pca; ppb = pcb; \
    DA_ISSUE_K(kbt + tk_, m3_, 0); DA_ISSUE_V(kbt + tv_, vs_, 0); \
    DA_T(6); \
    } while (0)

__device__ __forceinline__ void unit(LAS unsigned char* lds, const unsigned char* QBh, const unsigned char* KBh, const unsigned char* VBh, int q0, int kbase, int NT, float lam, const float* subg, float oscale, bf16_t* Yh, int wave, int lane, float* statp) {
    asm volatile("" : "+v"(lane));
    const int c = wave >> 2, s = wave & 3, r32 = lane & 31, hi = lane >> 5;
    LAS float* wsf = (LAS float*)(lds + WSF_OFF) + wave * 64;
    const int kbt = kbase >> 6;
    const unsigned lane16 = (unsigned)lane * 16u;
    DA_ISSUE_K(kbt, 0, 0); DA_ISSUE_K(kbt, 0, 1);
    DA_ISSUE_K(kbt + 1, 1, 0); DA_ISSUE_K(kbt + 1, 1, 1); DA_ISSUE_V(kbt, 3, 0); DA_ISSUE_V(kbt, 3, 1);
    DA_ISSUE_K(kbt + 2, 2, 0); DA_ISSUE_K(kbt + 2, 2, 1); DA_ISSUE_V(kbt, 0, 0); DA_ISSUE_V(kbt, 0, 1);
    DA_ISSUE_K(kbt + 3, 3, 0); DA_ISSUE_K(kbt + 3, 3, 1); DA_ISSUE_V(kbt + 1, 1, 0); DA_ISSUE_V(kbt + 1, 1, 1);
    i32x8 qf8; { const u32x4 qa_ = *(const u32x4*)(QBh + (size_t)(q0 + s * 32 + r32) * 128 + c * 64 + hi * 32), qb_ = *(const u32x4*)(QBh + (size_t)(q0 + s * 32 + r32) * 128 + c * 64 + hi * 32 + 16);
        qf8 = (i32x8){(int)qa_.x, (int)qa_.y, (int)qa_.z, (int)qa_.w, (int)qb_.x, (int)qb_.y, (int)qb_.z, (int)qb_.w}; }
    f32x16 o[4]; f32x16 C0, C1;
#pragma unroll
    for (int i = 0; i < 16; ++i) {
#pragma unroll
        for (int d0 = 0; d0 < 4; ++d0) o[d0][i] = 0.f; }
    f32x16 lacc, negm; i32x8 ones8 = {0x38383838, 0x38383838, 0x38383838, 0x38383838, 0x38383838, 0x38383838, 0x38383838, 0x38383838};
    asm volatile("" : "+v"(ones8));
    { float z_ = 0.f; asm volatile("" : "+v"(z_));
#pragma unroll
    for (int i = 0; i < 16; ++i) { negm[i] = z_; lacc[i] = z_; } }
    asm volatile("" : "+v"(negm));
    unsigned long long stat_acc = 0ull; (void)stat_acc;
    const int koff = c * 4096 + hi * 2048 + r32 * 16, voff = hi * 1024 + r32 * 16;
    u32x4 kfl[2], kfh[2], vfl[4], vfh[4]; u32x4 ppa, ppb, pca, pcb; ppa = ppb = pca = pcb = (u32x4){0u, 0u, 0u, 0u};
    asm volatile("s_waitcnt vmcnt(6)" ::: "memory"); __builtin_amdgcn_s_barrier(); asm volatile("" ::: "memory");
    { const LAS unsigned char* kp_ = lds + koff;
#pragma unroll
      for (int j = 0; j < 8; ++j) DA_KRD(j); }
    if (c) __builtin_amdgcn_s_setprio(1);
    DA_STEP(0, true);
#pragma unroll 1
    for (int t = 1; t < NT; ++t) DA_STEP(t, false);
#if DA_STAT
    if (statp && lane == 0) *statp = 400.f * floorf((float)((double)(long long)stat_acc / (double)NT) * (1.f / 400.f) + 0.5f);
#endif
    __builtin_amdgcn_s_setprio(0);
    { DA_SYNC();
      const LAS unsigned char* vp_ = lds + VOFF + ((NT - 1) & 3) * KSLOT + voff;
      DA_VRD8(0); DA_VRD8(1); DA_VRD8(2); DA_VRD8(3);
      DA_MFPV(0); DA_MFPV(1); DA_MFPV(2); DA_MFPV(3); DA_MFL(); }
#pragma unroll
    for (int i = 0; i < 16; ++i) { const float il_ = 1.f / lacc[i];
#pragma unroll
        for (int d0 = 0; d0 < 4; ++d0) o[d0][i] *= il_; }
    DA_SYNC();
    LAS float* X = (LAS float*)lds + s * 4096;
    if (c == 1) {
#pragma unroll
        for (int d0 = 0; d0 < 4; ++d0)
#pragma unroll
            for (int i = 0; i < 16; ++i) X[(d0 * 16 + i) * 64 + lane] = o[d0][i]; }
    DA_SYNC();
    if (c == 0) {
        float ss[16];
#pragma unroll
        for (int i = 0; i < 16; ++i) ss[i] = 0.f;
#pragma unroll
        for (int d0 = 0; d0 < 4; ++d0)
#pragma unroll
            for (int i = 0; i < 16; ++i) { const float d = o[d0][i] - lam * X[(d0 * 16 + i) * 64 + lane]; o[d0][i] = d; ss[i] += d * d; }
#pragma unroll
        for (int i = 0; i < 16; ++i) { float v = ss[i]; v += xorf_<1>(v); v += xorf_<2>(v); v += xorf_<4>(v); v += xorf_<8>(v); v += xorf_<16>(v); ss[i] = rsqrtf(v * (1.f / 128.f) + EPS) * oscale; }
        float gsub[4];
#pragma unroll
        for (int d0 = 0; d0 < 4; ++d0) gsub[d0] = subg[d0 * 32 + r32];
#pragma unroll
        for (int i = 0; i < 16; ++i) { bf16_t* yr = Yh + (size_t)(q0 + s * 32 + crow(i, hi)) * 512 + r32;
#pragma unroll
            for (int d0 = 0; d0 < 4; ++d0) yr[d0 * 32] = f2bf(o[d0][i] * ss[i] * gsub[d0]); }
    }
    DA_SYNC();
}
}


namespace na {
using da::crow; using da::vtr; using da::cvtpk; using da::s16x4; using da::i32x8;
constexpr int NA_OFF = 132096, NA_WS = 2304;
constexpr float LOG2E = 1.4426950408889634f;
__device__ __forceinline__ void dma8(LAS unsigned char* dst, const unsigned char* src, unsigned lane16) {
    const unsigned d0 = (unsigned)__builtin_amdgcn_readfirstlane((int)(unsigned)(uintptr_t)dst);
    const unsigned long long s0 = (unsigned long long)(uintptr_t)src;
    const unsigned slo = (unsigned)__builtin_amdgcn_readfirstlane((int)(unsigned)s0), shi = (unsigned)__builtin_amdgcn_readfirstlane((int)(unsigned)(s0 >> 32));
#pragma unroll
    for (int j = 0; j < 4; ++j) { const unsigned long long g = (((unsigned long long)shi << 32) | slo) + (unsigned long long)(j * 1024); const unsigned d = d0 + j * 1024; unsigned keep;
        asm volatile("s_mov_b32 %0, m0\n\ts_mov_b32 m0, %2\n\ts_nop 2\n\tglobal_load_lds_dwordx4 %1, %3\n\ts_mov_b32 m0, %0" : "=&s"(keep) : "v"(lane16), "s"(d), "s"(g) : "memory"); }
}
template <int BLK, bool WIN>
__device__ __forceinline__ void qk_softmax(const LAS unsigned char* kb, const i32x8& qf, int qc, unsigned vm0, unsigned vm1, const LAS float* bias2, int drow, LAS float* wsf, int r32, int hi,
                                           f32x16 (&o)[2], float& m, float& l, i32x8& pa) {
    asm volatile("" : "+v"(qc), "+v"(vm0), "+v"(vm1));
#define NA_A0(i) (!WIN || BLK == 0 || (i) >= 12)
#define NA_A1(i) (!WIN || BLK == 1 || (i) < 4)
    f32x16 p0, p1;
    if constexpr (!WIN) {
#pragma unroll
        for (int i = 0; i < 16; ++i) { p0[i] = 0.f; p1[i] = 0.f; }
    } else {
        const LAS float* bl = bias2 + (drow + 15 + 4 * hi - qc);
#pragma unroll
        for (int i = 0; i < 16; ++i) { const int kc = 8 * (i >> 2) + (i & 3);
            if (NA_A0(i)) { const unsigned t0 = (unsigned)__builtin_amdgcn_sbfe((int)vm0, i, 1); p0[i] = __uint_as_float((t0 & __float_as_uint(bl[kc])) | (~t0 & 0xf149f2cau)); } else p0[i] = -1e30f;
            if (NA_A1(i)) { const unsigned t1 = (unsigned)__builtin_amdgcn_sbfe((int)vm1, i, 1); p1[i] = __uint_as_float((t1 & __float_as_uint(bl[kc + 32])) | (~t1 & 0xf149f2cau)); } else p1[i] = -1e30f; } }
    { const u32x4 a0 = *(const LAS u32x4*)kb, a1 = *(const LAS u32x4*)(kb + 1024), b0 = *(const LAS u32x4*)(kb + 512), b1 = *(const LAS u32x4*)(kb + 1536);
      p0 = __builtin_amdgcn_mfma_scale_f32_32x32x64_f8f6f4((i32x8){(int)a0.x, (int)a0.y, (int)a0.z, (int)a0.w, (int)a1.x, (int)a1.y, (int)a1.z, (int)a1.w}, qf, p0, 0, 0, 0, 0x7f7f7f7f, 0, 0x7f7f7f7f);
      p1 = __builtin_amdgcn_mfma_scale_f32_32x32x64_f8f6f4((i32x8){(int)b0.x, (int)b0.y, (int)b0.z, (int)b0.w, (int)b1.x, (int)b1.y, (int)b1.z, (int)b1.w}, qf, p1, 0, 0, 0, 0x7f7f7f7f, 0, 0x7f7f7f7f); }
    float rm = -1e30f;
#pragma unroll
    for (int i = 0; i < 16; ++i) { if (NA_A0(i) && NA_A1(i)) rm = fmaxf(rm, fmaxf(p0[i], p1[i])); else if (NA_A0(i)) rm = fmaxf(rm, p0[i]); else if (NA_A1(i)) rm = fmaxf(rm, p1[i]); }
    { const auto rr = __builtin_amdgcn_permlane32_swap(__float_as_uint(rm), __float_as_uint(rm), false, false); rm = fmaxf(__uint_as_float(rr[0]), __uint_as_float(rr[1])); }
    const float nm = fmaxf(m, rm), f = __builtin_amdgcn_exp2f(m - nm); m = nm; l *= f;
    if (hi == 0) wsf[r32] = f;
    float sum = 0.f;
#pragma unroll
    for (int i = 0; i < 16; ++i) { if (NA_A0(i)) { p0[i] = __builtin_amdgcn_exp2f(p0[i] - nm); sum += p0[i]; } else p0[i] = 0.f;
        if (NA_A1(i)) { p1[i] = __builtin_amdgcn_exp2f(p1[i] - nm); sum += p1[i]; } else p1[i] = 0.f; }
    l += sum;
#pragma unroll
    for (int g = 0; g < 4; ++g) { const f32x4 fr = *(const LAS f32x4*)(wsf + 8 * g + 4 * hi);
#pragma unroll
        for (int i = 0; i < 4; ++i) { o[0][4 * g + i] *= fr[i]; o[1][4 * g + i] *= fr[i]; } }
    pa = (i32x8){(int)pk4_fp8u(p0[0], p0[1], p0[2], p0[3]), (int)pk4_fp8u(p0[4], p0[5], p0[6], p0[7]), (int)pk4_fp8u(p0[8], p0[9], p0[10], p0[11]), (int)pk4_fp8u(p0[12], p0[13], p0[14], p0[15]),
                 (int)pk4_fp8u(p1[0], p1[1], p1[2], p1[3]), (int)pk4_fp8u(p1[4], p1[5], p1[6], p1[7]), (int)pk4_fp8u(p1[8], p1[9], p1[10], p1[11]), (int)pk4_fp8u(p1[12], p1[13], p1[14], p1[15])};
#undef NA_A0
#undef NA_A1
}
__device__ __forceinline__ void pv2(f32x16 (&o)[2], const LAS unsigned char* vp, const i32x8& pa) {
#pragma unroll
    for (int d0 = 0; d0 < 2; ++d0) { const u32x4 lo = *(const LAS u32x4*)(vp + d0 * 2048), h8 = *(const LAS u32x4*)(vp + d0 * 2048 + 512);
        o[d0] = __builtin_amdgcn_mfma_scale_f32_32x32x64_f8f6f4(pa, (i32x8){(int)lo.x, (int)lo.y, (int)lo.z, (int)lo.w, (int)h8.x, (int)h8.y, (int)h8.z, (int)h8.w}, o[d0], 0, 0, 0, 0x7f7f7f7f, 0, 0x7f7f7f7f); }
}
__device__ __forceinline__ void unit(LAS unsigned char* lds, const bf16_t* Z, const unsigned char* KAh, const unsigned char* VAh, const float* rpb_h, int qrow0, int r, int h, bf16_t* Yh, int wave, int lane) {
    asm volatile("" : "+v"(lane));
    const int r32 = lane & 31, hi = lane >> 5; const unsigned lane16 = (unsigned)lane * 16u;
    LAS unsigned char* wl = lds + wave * 16384;
    LAS float* bias2 = (LAS float*)(lds + NA_OFF + wave * NA_WS); LAS float* wsf = bias2 + 480;
    int r0 = 0;
    if (r >= 0) { r0 = r - 4; r0 = r0 < 0 ? 0 : (r0 > 248 ? 248 : r0);
        for (int i = lane; i < 480; i += 64) { const int dr = i >> 5, dc = i & 31; bias2[i] = dc < 31 ? rpb_h[dr * 31 + dc] * LOG2E : 0.f; } }
    const LAS unsigned char* kb = wl + hi * 2048 + r32 * 16; const LAS unsigned char* vp = wl + 8192 + hi * 1024 + r32 * 16;
    const int nt = r >= 0 ? 12 : 4;
    i32x8 qf0, qf1;
    { u32x4 qa[4], qb[4];
#pragma unroll
      for (int k = 0; k < 4; ++k) { qa[k] = *(const u32x4*)(Z + (size_t)(qrow0 + r32) * PROJZ + ZQA + h * 64 + hi * 32 + 8 * k); qb[k] = *(const u32x4*)(Z + (size_t)(qrow0 + 32 + r32) * PROJZ + ZQA + h * 64 + hi * 32 + 8 * k); }
#define NA_Q8(W) (int)pk4_fp8(__uint_as_float((W).x << 16), __uint_as_float((W).x & 0xffff0000u), __uint_as_float((W).y << 16), __uint_as_float((W).y & 0xffff0000u)), (int)pk4_fp8(__uint_as_float((W).z << 16), __uint_as_float((W).z & 0xffff0000u), __uint_as_float((W).w << 16), __uint_as_float((W).w & 0xffff0000u))
      qf0 = (i32x8){NA_Q8(qa[0]), NA_Q8(qa[1]), NA_Q8(qa[2]), NA_Q8(qa[3])}; qf1 = (i32x8){NA_Q8(qb[0]), NA_Q8(qb[1]), NA_Q8(qb[2]), NA_Q8(qb[3])};
#undef NA_Q8
    }
    asm volatile("" :: "v"(qf0), "v"(qf1));
    asm volatile("s_waitcnt vmcnt(0) lgkmcnt(0)" ::: "memory");
    f32x16 o0[2], o1[2]; float m0 = -1e30f, l0 = 0.f, m1 = -1e30f, l1 = 0.f;
#pragma unroll
    for (int d0 = 0; d0 < 2; ++d0)
#pragma unroll
        for (int i = 0; i < 16; ++i) { o0[d0][i] = 0.f; o1[d0][i] = 0.f; }
    int c00 = r32 - 8; c00 = c00 < 0 ? 0 : c00; const int c01 = (32 + r32 - 8) > 48 ? 48 : (32 + r32 - 8);
    unsigned vma0 = 0, vma1 = 0, vmb0 = 0, vmb1 = 0;
#pragma unroll
    for (int i = 0; i < 16; ++i) { const int k = crow(i, hi);
        vma0 |= ((unsigned)(k - c00) < 16u ? 1u : 0u) << i; vma1 |= ((unsigned)(k + 32 - c00) < 16u ? 1u : 0u) << i; vmb0 |= ((unsigned)(k - c01) < 16u ? 1u : 0u) << i; vmb1 |= ((unsigned)(k + 32 - c01) < 16u ? 1u : 0u) << i; }
    { const int kt0 = r >= 0 || true ? L / 64 : 0; dma8(wl, KAh + (size_t)kt0 * 4096, lane16); dma8(wl + 8192, VAh + (size_t)kt0 * 4096, lane16); }
#define NA_TILE(WIN_) do { \
        const int tn = t + 1 < nt ? t + 1 : nt - 1; const int ktn = tn < 4 ? L / 64 + tn : r0 + tn - 4;       \
        const int drow = WIN_ ? (r0 + t - 4 - r + 7) * 32 : 0; \
        i32x8 pa; \
        asm volatile("s_waitcnt vmcnt(4)" ::: "memory");                 \
        qk_softmax<0, WIN_>(kb, qf0, r32, vma0, vma1, bias2, drow, wsf, r32, hi, o0, m0, l0, pa); \
        asm volatile("s_waitcnt vmcnt(0)" ::: "memory");                 \
        pv2(o0, vp, pa); \
        __builtin_amdgcn_sched_barrier(0);                               \
        qk_softmax<1, WIN_>(kb, qf1, 32 + r32, vmb0, vmb1, bias2, drow, wsf, r32, hi, o1, m1, l1, pa); \
        asm volatile("s_waitcnt lgkmcnt(0)" ::: "memory");               \
        dma8(wl, KAh + (size_t)ktn * 4096, lane16); \
        pv2(o1, vp, pa); \
        asm volatile("s_waitcnt lgkmcnt(0)" ::: "memory");               \
        dma8(wl + 8192, VAh + (size_t)ktn * 4096, lane16); } while (0)
#pragma unroll 1
    for (int t = 0; t < 4; ++t) NA_TILE(false);
#pragma unroll 1
    for (int t = 4; t < nt; ++t) NA_TILE(true);
#undef NA_TILE
    asm volatile("s_waitcnt vmcnt(0)" ::: "memory");
    { const auto rr = __builtin_amdgcn_permlane32_swap(__float_as_uint(l0), __float_as_uint(l0), false, false); l0 = __uint_as_float(rr[0]) + __uint_as_float(rr[1]); }
    { const auto rr = __builtin_amdgcn_permlane32_swap(__float_as_uint(l1), __float_as_uint(l1), false, false); l1 = __uint_as_float(rr[0]) + __uint_as_float(rr[1]); }
    if (hi == 0) { wsf[r32] = 1.f / l0; wsf[32 + r32] = 1.f / l1; }
#pragma unroll
    for (int g = 0; g < 4; ++g) { const f32x4 fa = *(const LAS f32x4*)(wsf + 8 * g + 4 * hi), fb = *(const LAS f32x4*)(wsf + 32 + 8 * g + 4 * hi);
#pragma unroll
        for (int i = 0; i < 4; ++i) { bf16_t* ya = Yh + (size_t)(qrow0 + crow(4 * g + i, hi)) * 512 + r32; bf16_t* yb = ya + (size_t)32 * 512;
            ya[0] = f2bf(o0[0][4 * g + i] * fa[i]); ya[32] = f2bf(o0[1][4 * g + i] * fa[i]); yb[0] = f2bf(o1[0][4 * g + i] * fb[i]); yb[32] = f2bf(o1[1][4 * g + i] * fb[i]); } }
    asm volatile("s_waitcnt lgkmcnt(0)" ::: "memory");
}
}

namespace gm {
using da::crow; using da::vtr; using da::cvtpk; using da::s16x4;
__device__ __forceinline__ void unit(LAS unsigned char* lds, const bf16_t* Z, const float* ln_g, const float* ln_b, const float* w_s, const float* b_s, int row0, bf16_t* Yc, int wave, int lane) {
    asm volatile("" : "+v"(lane));
    const int r32 = lane & 31, hi = lane >> 5;
    { u32x4 rw[16];
#pragma unroll
      for (int tk = 0; tk < 16; ++tk) rw[tk] = *(const u32x4*)(Z + (size_t)(row0 + wave * 16 + tk) * PROJZ + ZV + lane * 8);
      float sm[16];
#pragma unroll
      for (int tk = 0; tk < 16; ++tk) { float v[8]; unpack8(rw[tk], v); sm[tk] = ((v[0] + v[1]) + (v[2] + v[3])) + ((v[4] + v[5]) + (v[6] + v[7])); }
#define GM_RED16(X, OUT) do { float a8_[8], a4_[4], a2_[2]; \
        _Pragma("unroll") for (int i = 0; i < 8; ++i) { const bool h_ = (lane & 32) != 0; a8_[i] = (h_ ? X[8 + i] : X[i]) + xor32f_(h_ ? X[i] : X[8 + i], !h_); } \
        _Pragma("unroll") for (int i = 0; i < 4; ++i) { const bool h_ = (lane & 16) != 0; a4_[i] = (h_ ? a8_[4 + i] : a8_[i]) + xorf_<16>(h_ ? a8_[i] : a8_[4 + i]); } \
        _Pragma("unroll") for (int i = 0; i < 2; ++i) { const bool h_ = (lane & 8) != 0; a2_[i] = (h_ ? a4_[2 + i] : a4_[i]) + xorf_<8>(h_ ? a4_[i] : a4_[2 + i]); } \
        { const bool h_ = (lane & 4) != 0; OUT = (h_ ? a2_[1] : a2_[0]) + xorf_<4>(h_ ? a2_[0] : a2_[1]); } OUT += xorf_<2>(OUT); OUT += xorf_<1>(OUT); } while (0)
      float tot; GM_RED16(sm, tot); const float mean_l = tot * (1.f / 512.f);
      float mean[16];
#pragma unroll
      for (int tk = 0; tk < 16; ++tk) mean[tk] = __int_as_float(__builtin_amdgcn_readlane(__float_as_int(mean_l), 4 * tk));
#pragma unroll
      for (int tk = 0; tk < 16; ++tk) { float v[8]; unpack8(rw[tk], v); float q = 0.f;
#pragma unroll
          for (int i = 0; i < 8; ++i) { const float d = v[i] - mean[tk]; q += d * d; }
          sm[tk] = q; }
      float qt; GM_RED16(sm, qt); const float rstd_l = rsqrtf(qt * (1.f / 512.f) + EPS);
#undef GM_RED16
      float lg[8], lb[8];
#pragma unroll
      for (int i = 0; i < 8; ++i) { lg[i] = ln_g[lane * 8 + i]; lb[i] = ln_b[lane * 8 + i]; }
#pragma unroll
      for (int tk = 0; tk < 16; ++tk) { float v[8]; unpack8(rw[tk], v); const float rstd = __int_as_float(__builtin_amdgcn_readlane(__float_as_int(rstd_l), 4 * tk)), mu = mean[tk];
          u32x4 w; w.x = pk2((v[0] - mu) * rstd * lg[0] + lb[0], (v[1] - mu) * rstd * lg[1] + lb[1]); w.y = pk2((v[2] - mu) * rstd * lg[2] + lb[2], (v[3] - mu) * rstd * lg[3] + lb[3]);
          w.z = pk2((v[4] - mu) * rstd * lg[4] + lb[4], (v[5] - mu) * rstd * lg[5] + lb[5]); w.w = pk2((v[6] - mu) * rstd * lg[6] + lb[6], (v[7] - mu) * rstd * lg[7] + lb[7]);
          *(LAS u32x4*)(lds + ((lane >> 2) * 8 + wave) * 1024 + tk * 64 + (lane & 3) * 16) = w; } }
    __syncthreads();
    const int pb = wave & 3, chh = wave >> 2;
    const LAS unsigned char* vp = lds + ((lane >> 4) & 1) * 32 + (lane & 3) * 8 + (4 * hi + ((lane & 15) >> 2)) * 64;
#pragma unroll 1
    for (int gg = 0; gg < 2; ++gg) { const int g = 2 * chh + gg; const float* wrow = w_s + ((size_t)g * 128 + 32 * pb + r32) * 128;
        bf16x8 a[8];
        { f32x4 xw[16];
#pragma unroll
          for (int ks = 0; ks < 8; ++ks) { xw[2 * ks] = *(const GAS f32x4*)(wrow + 16 * ks + 4 * hi); xw[2 * ks + 1] = *(const GAS f32x4*)(wrow + 16 * ks + 8 + 4 * hi); }
#pragma unroll
          for (int ks = 0; ks < 8; ++ks) { const f32x4 x0 = xw[2 * ks], x1 = xw[2 * ks + 1];
            u32x4 w; w.x = cvtpk(x0[0], x0[1]); w.y = cvtpk(x0[2], x0[3]); w.z = cvtpk(x1[0], x1[1]); w.w = cvtpk(x1[2], x1[3]); a[ks] = __builtin_bit_cast(bf16x8, w); } }
        float bsv[16];
#pragma unroll
        for (int i = 0; i < 16; ++i) bsv[i] = b_s[g * 128 + 32 * pb + crow(i, hi)];
#pragma unroll 1
        for (int c4 = 0; c4 < 4; ++c4) { const int cb = g * 4 + c4; f32x16 acc;
            unsigned short uv[16];
#pragma unroll
            for (int i = 0; i < 16; ++i) uv[i] = *(const GAS unsigned short*)(Z + (size_t)(row0 + 32 * pb + crow(i, hi)) * PROJZ + ZU + cb * 32 + r32);
#pragma unroll
            for (int i = 0; i < 16; ++i) acc[i] = 0.f;
#pragma unroll
            for (int ks = 0; ks < 8; ++ks) { const s16x4 lo = vtr(vp + (cb * 8 + ks) * 1024), h8 = vtr(vp + (cb * 8 + ks) * 1024 + 512);
                const bf16x8 vf = {lo[0], lo[1], lo[2], lo[3], h8[0], h8[1], h8[2], h8[3]};
                acc = __builtin_amdgcn_mfma_f32_32x32x16_bf16(a[ks], vf, acc, 0, 0, 0); }
#pragma unroll
            for (int i = 0; i < 16; ++i) { const int row = row0 + 32 * pb + crow(i, hi), ch = cb * 32 + r32;
                *(GAS bf16_t*)(Yc + (size_t)row * 512 + ch) = f2bf(bf2f(uv[i]) * (acc[i] + bsv[i])); } } }
    __syncthreads();
}
}


constexpr int NWAVES = 8, NTHREADS = 512;
constexpr int RING_BYTES = 131072, LDSCTL_OFF = RING_BYTES, MISC_OFF = LDSCTL_OFF + 320, LDS_BYTES = 163840;
constexpr int CW_BAR = 4096;
constexpr int N_PHASES = 20;
#ifndef PROBE_KIND
#define PROBE_KIND (-1)
#define PROBE_N 1
#endif
#ifndef STAT_BID
#define STAT_BID 0
#define STAT_WAVE 0
#endif
#ifndef PROBE_NA
#define PROBE_NA 0
#endif
#ifndef PROBE_CTX
#define PROBE_CTX 0
#endif
#ifndef PROBE_GM
#define PROBE_GM 0
#endif
#ifndef PH_MASK
#define PH_MASK 0xFFFF
#endif
#define PH_ON(k) ((PH_MASK >> (k)) & 1)

__device__ __forceinline__ void p0_transpose_item(const float* W, int K, int N, bf16_t* WT, int mode, LAS unsigned short* scr, int item, int lane) {
    const int nblk = N / 64, kb = item / nblk, nb = item % nblk, k0 = 64 * kb, n0 = 64 * nb;
    const int lk = lane >> 4, ln = (lane & 15) * 4;
    f32x4 v[16];
#pragma unroll
    for (int i = 0; i < 16; ++i) v[i] = *(const f32x4*)(W + (size_t)(k0 + 4 * i + lk) * N + n0 + ln);
#pragma unroll
    for (int i = 0; i < 16; ++i) { const int kk = 4 * i + lk; const unsigned p01 = pk2(v[i][0], v[i][1]), p23 = pk2(v[i][2], v[i][3]);
        scr[(ln + 0) * 66 + kk] = (unsigned short)p01; scr[(ln + 1) * 66 + kk] = (unsigned short)(p01 >> 16); scr[(ln + 2) * 66 + kk] = (unsigned short)p23; scr[(ln + 3) * 66 + kk] = (unsigned short)(p23 >> 16); }
    LDS_WAIT(); asm volatile("" ::: "memory");
    const int c = lane & 7;
#pragma unroll
    for (int j = 0; j < 8; ++j) { const int n = (lane >> 3) + 8 * j; const LAS unsigned* s = (const LAS unsigned*)(scr + n * 66 + 8 * c); const int nn = n0 + n;
        const int row = mode == 0 ? nn : (256 * (nn >> 7) + (nn & 127) + (mode == 2 ? 128 : 0));
        u32x4 o; o.x = s[0]; o.y = s[1]; o.z = s[2]; o.w = s[3];
        *(GAS u32x4*)(WT + (size_t)row * K + k0 + 8 * c) = o; }
    LDS_WAIT(); asm volatile("" ::: "memory");
}
__device__ __forceinline__ void wg_dma4(LAS unsigned char* dst, const char* src, const unsigned (&off)[4]) {
    const unsigned d0 = (unsigned)__builtin_amdgcn_readfirstlane((int)(unsigned)(uintptr_t)dst);
    const unsigned long long s0 = (unsigned long long)(uintptr_t)src;
    const unsigned slo = (unsigned)__builtin_amdgcn_readfirstlane((int)(unsigned)s0), shi = (unsigned)__builtin_amdgcn_readfirstlane((int)(unsigned)(s0 >> 32));
    const unsigned long long g = ((unsigned long long)shi << 32) | slo;
#pragma unroll
    for (int q = 0; q < 4; ++q) { const unsigned d = d0 + q * 1024; unsigned keep;
        asm volatile("s_mov_b32 %0, m0\n\ts_mov_b32 m0, %2\n\ts_nop 2\n\tglobal_load_lds_dwordx4 %1, %3\n\ts_mov_b32 m0, %0" : "=&s"(keep) : "v"(off[q]), "s"(d), "s"(g) : "memory"); }
}
__device__ __forceinline__ void wgemm_lds(LAS unsigned char* wl, int S, const bf16_t* Abase, const unsigned (&aoff)[4], const bf16_t* Bbase, const unsigned (&boff)[4], int K, f32x16& acc, int lane) {
    const int nch = K >> 6;
#pragma unroll
    for (int i = 0; i < 16; ++i) acc[i] = 0.f;
    asm volatile("s_waitcnt vmcnt(0)" ::: "memory");
#define WG_ISSUE(c_, st_) do { const int cc_ = (c_) < nch ? (c_) : nch - 1; LAS unsigned char* d_ = wl + (st_) * 8192; \
        wg_dma4(d_, (const char*)Abase + cc_ * 128, aoff); wg_dma4(d_ + 4096, (const char*)Bbase + cc_ * 128, boff); } while (0)
    for (int c = 0; c < S - 1; ++c) WG_ISSUE(c, c);
    const int rdo = (lane & 31) * 128, xr = lane & 7, h_ = lane >> 5;
    for (int c = 0; c < nch; ++c) {
        asm volatile("s_waitcnt lgkmcnt(0)" ::: "memory");
        WG_ISSUE(c + S - 1, (c + S - 1) & (S - 1));
        if (S == 8) asm volatile("s_waitcnt vmcnt(56)" ::: "memory"); else if (S == 4) asm volatile("s_waitcnt vmcnt(24)" ::: "memory"); else asm volatile("s_waitcnt vmcnt(8)" ::: "memory");
        const LAS unsigned char* sp = wl + (c & (S - 1)) * 8192 + rdo;
#pragma unroll
        for (int s = 0; s < 4; ++s) { const int o = ((2 * s + h_) ^ xr) << 4; const bf16x8 a = *(const LAS bf16x8*)(sp + o), b = *(const LAS bf16x8*)(sp + 4096 + o);
            acc = __builtin_amdgcn_mfma_f32_32x32x16_bf16(b, a, acc, 0, 0, 0); } }
#undef WG_ISSUE
    asm volatile("s_waitcnt vmcnt(0) lgkmcnt(0)" ::: "memory");
}
#define CTX_BEGIN(n_) for (int rp_ = 0; rp_ < 1 + PROBE_CTX; ++rp_) for (int base_ = 0; base_ < (n_); base_ += G * NWAVES) { const int rem_ = (n_) - base_; int na_ = (rem_ + G - 1) / G; na_ = na_ > NWAVES ? NWAVES : na_; \
        const int S_ = na_ <= 2 ? 8 : na_ <= 4 ? 4 : 2; const int it = base_ + bid * na_ + wave; LAS unsigned char* wl_ = lds + wave * (S_ * 8192); \
        if (wave < na_ && it < (n_))
#define CTX_END }
constexpr int XCONV_R = 6144;
#define EXPERT_CONV_ITEM(it_, scr_) do { const int w_ = (it_) >> 12, r_ = (it_) & 4095, z_ = l * 16 + (r_ >> 8); \
        if (w_ < 2) p0_transpose_item((w_ == 0 ? IN(22) : IN(23)) + (size_t)z_ * D * FF, D, FF, W13 + (size_t)z_ * 2048 * D, 1 + w_, scr_, r_ & 255, lane); \
        else p0_transpose_item(IN(24) + (size_t)z_ * FF * D, FF, D, W2 + (size_t)z_ * D * FF, 0, scr_, r_ & 255, lane); } while (0)
#define CTX_SWZ (((lane & 7) ^ (lane >> 3)) * 16)
#define CTX_ROW(q) (8 * (q) + (lane >> 3))
__device__ __forceinline__ void norm_mod_row(const float* x, const float* g, const float* sh, const float* sc, bf16_t* o, int lane) {
    f32x4 v[4]; float s = 0.f;
#pragma unroll
    for (int j = 0; j < 4; ++j) { v[j] = *(const f32x4*)(x + j * 256 + lane * 4); s += (v[j][0] * v[j][0] + v[j][1] * v[j][1]) + (v[j][2] * v[j][2] + v[j][3] * v[j][3]); }
    const float rs = rsqrtf(wave_sum(s) * (1.f / D) + EPS);
#pragma unroll
    for (int j = 0; j < 4; ++j) { const int d = j * 256 + lane * 4; const f32x4 gg = *(const f32x4*)(g + d), a = *(const f32x4*)(sc + d), b = *(const f32x4*)(sh + d);
        const f32x4 h = v[j] * rs * gg * (a + 1.f) + b; u32x2 w; w.x = pk2(h[0], h[1]); w.y = pk2(h[2], h[3]); *(u32x2*)(o + d) = w; }
}

#define IN(i) (args.in[(i) + zero])
struct Args { const float* in[26]; float* out; unsigned char* ws; int ph_lo, ph_hi, li, pad; };

__global__ void __launch_bounds__(NTHREADS, 2) mk_fwd(Args args) {
    extern __shared__ __attribute__((aligned(16))) unsigned char lds_raw[];
    LAS unsigned char* lds = (LAS unsigned char*)lds_raw;
    volatile LAS unsigned* MISC = (volatile LAS unsigned*)(lds + MISC_OFF);
    const int tid0 = threadIdx.x, wave = __builtin_amdgcn_readfirstlane(tid0 >> 6);
    const int G = gridDim.x, bid = blockIdx.x, gw = bid * NWAVES + wave, NGW = G * NWAVES;
    for (int u = tid0; u < (LDS_BYTES - LDSCTL_OFF) / 4; u += NTHREADS) ((LAS unsigned*)(lds + LDSCTL_OFF))[u] = 0u;
    __syncthreads();
    XcdBarrier bar = xcd_barrier_post((unsigned*)(args.ws + WS_CTL) + CW_BAR + args.li * XCD_BAR_WORDS, MISC + 8);

    int nrep_ = 0; (void)nrep_;
    for (int ph = args.ph_lo; ph < args.ph_hi; ++ph) {
        int zero = 0; asm volatile("" : "+s"(zero));
        unsigned char* ws = args.ws + zero;
        const float* x_in = IN(0); const float* ctx_in = IN(2); float* out = args.out + zero;
        float* MOD = (float*)(ws + OFF_MOD); float* ROPE = (float*)(ws + OFF_ROPE); float* LAM = (float*)(ws + OFF_LAM);
        float* AFF = (float*)(ws + OFF_AFF); int* INV = (int*)(ws + OFF_INV); int* IDX = (int*)(ws + OFF_IDX); float* GATE = (float*)(ws + OFF_GATE); float* XC = (float*)(ws + WS_XC);
        bf16_t* WIN = (bf16_t*)(ws + WS_WIN); bf16_t* WBR = (bf16_t*)(ws + WS_WBR); bf16_t* WOUT = (bf16_t*)(ws + WS_WOUT); bf16_t* W13 = (bf16_t*)(ws + WS_W13); bf16_t* W2 = (bf16_t*)(ws + WS_W2);
        bf16_t* H = (bf16_t*)(ws + WS_H); bf16_t* Y = (bf16_t*)(ws + WS_Y); bf16_t* Z = (bf16_t*)(ws + WS_Z);
        bf16_t* MB = H; bf16_t* H2 = Y; bf16_t* HID = (bf16_t*)(ws + WS_Z + ZO_HID); bf16_t* YE = (bf16_t*)(ws + WS_Z + ZO_YE);

        const int l = ph < 2 ? 0 : (ph - 2) / 9, kind = ph < 2 ? ph : 2 + (ph - 2) % 9; const bool last = (l == 1);
        const float* mod = MOD + (size_t)l * 2 * 6144;
        if (kind == K_G1 || kind == K_M1 || kind == K_M2 || kind == K_E1 || kind == K_E2) {
            pg8::Gemm g; g.M = 0; g.N = 0;
            if (kind == K_G1) { g.A = H; g.Bt = WIN + (size_t)l * PROJ * D; g.K = D; }
            else if (kind == K_M1) { g.A = Y; g.Bt = WBR + (size_t)l * 3 * D * 512; g.K = 512; }
            else if (kind == K_M2) { g.A = MB; g.Bt = WOUT + (size_t)l * D * D; g.K = D; }
            else if (kind == K_E1) { g.A = H2; g.Bt = W13 + (size_t)l * 16 * 2048 * D; g.K = D; }
            else { g.A = HID; g.Bt = W2 + (size_t)l * 16 * D * FF; g.K = FF; }
            const USched S{kind, bid, G, IDX}; const UEpi E{kind, l, ws, out, l == 0 ? x_in : out};
            int wv_ = wave; asm volatile("" : "+s"(wv_)); const int tidg = wv_ * 64 + lane_id_();
            if ((PH_MASK >> kind) & 1) pg8::gemm_phase<UEpi, USched>(lds, g, S, E, kind != K_M2, kind == K_E1, tidg);
        }
#define tid (wave * 64 + lane)
#define r32 (lane & 31)
#define hh (lane >> 5)
        if (PH_ON(K_P0) && kind == K_P0) { const int lane = lane_id_(); (void)lane;

            if (bid < 192) {
                LAS float* sv = (LAS float*)(lds + 8192);
                { float c_[2], d_[2];
#pragma unroll
                  for (int q = 0; q < 2; ++q) { c_[q] = IN(1)[tid + q * NTHREADS]; d_[q] = IN(3)[tid + q * NTHREADS]; }
#pragma unroll
                  for (int q = 0; q < 2; ++q) { sv[tid + q * NTHREADS] = siluf_(c_[q]); sv[1024 + tid + q * NTHREADS] = siluf_(d_[q]); } }
                __syncthreads();
            for (int it = bid; it < 192; it += G) { const int ll = it / 96, n0 = (it % 96) * 64; const float* w = IN(4) + (size_t)ll * D * 6144 + n0 + lane;
                float a0 = 0.f, a1 = 0.f;
#pragma unroll 16
                for (int k = wave * 128; k < wave * 128 + 128; ++k) { const float wv = w[(size_t)k * 6144]; a0 += sv[k] * wv; a1 += sv[1024 + k] * wv; }
                LAS float* red = (LAS float*)lds; red[(wave * 2 + 0) * 64 + lane] = a0; red[(wave * 2 + 1) * 64 + lane] = a1; __syncthreads();
                if (wave < 2) { float s = 0.f;
#pragma unroll
                    for (int q = 0; q < 8; ++q) s += red[(q * 2 + wave) * 64 + lane];
                    MOD[(size_t)(ll * 2 + wave) * 6144 + n0 + lane] = s + IN(5)[ll * 6144 + n0 + lane]; }
                __syncthreads(); } }
            if (bid == G - 1) {
                for (int t = tid; t < 320 * 16; t += NTHREADS) { const int pos = t / 16, j = t % 16; const float inv = powf(10000.f, -(float)(2 * j) / 32.f);
                    if (pos < 256) { const float a = (float)pos * inv; ROPE[pos * 16 + j] = cosf(a); ROPE[4096 + pos * 16 + j] = sinf(a); }
                    else { const int p = pos - 256; const float a = (float)p * inv; ROPE[8192 + p * 16 + j] = cosf(a); ROPE[8192 + 1024 + p * 16 + j] = sinf(a); } }
                if (tid < 2) { float s1 = 0.f, s2 = 0.f; for (int i = 0; i < 64; ++i) { s1 += IN(10)[tid * 64 + i] * IN(11)[tid * 64 + i]; s2 += IN(12)[tid * 64 + i] * IN(13)[tid * 64 + i]; }
                    LAM[tid] = expf(s1) - expf(s2) + (0.8f - 0.6f * expf(-0.3f * (float)tid)); }
            }
            LAS unsigned short* scr = (LAS unsigned short*)(lds + wave * 16384);
            for (int it = gw; it < 4864; it += NGW) { int r = it;
                if (r < 3584) { const int z = r / 1792; p0_transpose_item(IN(8) + (size_t)z * D * PROJ, D, PROJ, WIN + (size_t)z * PROJ * D, 0, scr, r % 1792, lane); continue; } r -= 3584;
                if (r < 768) { const int z = r / 128; p0_transpose_item(IN(19) + (size_t)z * 512 * D, 512, D, WBR + (size_t)z * D * 512, 0, scr, r % 128, lane); continue; } r -= 768;
                { const int z = r / 256; p0_transpose_item(IN(20) + (size_t)z * D * D, D, D, WOUT + (size_t)z * D * D, 0, scr, r % 256, lane); }
            }
        } else if (PH_ON(K_H1) && kind == K_H1) { const int lane = lane_id_(); (void)lane;

            for (int row = gw; row < R; row += NGW) { const float* xr = row < L ? x_in + (size_t)row * D : ctx_in + (size_t)(row - L) * D; const float* m = MOD + (row < L ? 0 : 6144);
                norm_mod_row(xr, IN(6), m, m + 1024, H + (size_t)row * D, lane); }
        } else if (PH_ON(K_G1) && kind == K_G1) { const int lane = lane_id_(); (void)lane;

            const int ntn = (last ? 2048 : PROJ) / 32;
            CTX_BEGIN(8 * ntn) { const int mt = it & 7, nt = it >> 3; f32x16 acc[1]; unsigned ao[4], bo[4];
#pragma unroll
                for (int q = 0; q < 4; ++q) { ao[q] = (unsigned)((L + mt * 32 + CTX_ROW(q)) * D * 2 + CTX_SWZ); bo[q] = (unsigned)((nt * 32 + CTX_ROW(q)) * D * 2 + CTX_SWZ); }
                wgemm_lds(wl_, S_, H, ao, WIN + (size_t)l * PROJ * D, bo, D, acc[0], lane);
                const int row = L + mt * 32 + r32; const int nb = nt * 32;
                const int type = (nb >= 2048 && nb < 3072) ? 2 : (nb >= 3072 && nb < 4096) ? 3 : (nb >= 4096) ? 4 : 0;
                bf16_t* dst;
                if ((nb >= 1024 && nb < 2048) || (nb >= 2560 && nb < 3072)) { const int sel = nb < 1536 ? 1 : nb < 2048 ? 2 : 0; bf16_t* hb = (bf16_t*)(ws + WS_QB + (size_t)sel * QKV_STRIDE); const int cq = nb & 511; dst = hb + (size_t)(cq >> 7) * HB; if (sel == 0) dst += (size_t)row * 128 + (cq & 127); }
                else if (nb < 1024) { dst = (bf16_t*)(ws + WS_KA + (size_t)(nb >> 9) * KAV_STRIDE) + (size_t)((nb & 511) >> 6) * HA + (size_t)(row >> 6) * 4096; }
                else { const int zc = nb < 2560 ? ZQA + (nb - 2048) : nb < 4096 ? ZU + (nb - 3072) : ZG + (nb - 4096); dst = Z + (size_t)row * PROJZ + zc; }
#pragma unroll
                for (int g4 = 0; g4 < 4; ++g4) { float v[4];
#pragma unroll
                    for (int i = 0; i < 4; ++i) { float t = acc[0][4 * g4 + i]; t = type == 2 ? t * C2 : type == 3 ? gelu_tanh(t) : type == 4 ? sigmoidf_(t) : t; v[i] = t; }
                    if ((nb >= 2560 && nb < 3072) || (nb >= 1024 && nb < 1536)) {
                        const bool isq = nb >= 2560; const int cq8 = (nb & 511) + 8 * g4 + 4 * hh;
                        unsigned char* p8 = ws + (isq ? WS_QB : WS_KB) + (size_t)(cq8 >> 7) * HB8 + (isq ? (size_t)row * 128 + (cq8 & 127) : k8_tiled_off(row, cq8 & 127));
                        *(unsigned*)p8 = pk4_fp8(v[0], v[1], v[2], v[3]); continue; }
                    if (nb < 1024) {
                        const int d_ = (nb & 63) + 8 * g4 + 4 * hh; unsigned char* b8 = ws + WS_KA + (size_t)(nb >> 9) * KAV_STRIDE + (size_t)((nb & 511) >> 6) * HA8 + (size_t)(row >> 6) * 4096;
                        if (nb < 512) *(unsigned*)(b8 + na8k_off(row & 63, d_)) = pk4_fp8(v[0], v[1], v[2], v[3]);
                        else {
#pragma unroll
                            for (int i = 0; i < 4; ++i) b8[na8v_off(row & 63, d_ + i)] = f2fp8(v[i]); }
                        continue; }
                    if (nb >= 1536 && nb < 2048) {
                        const int cq8 = (nb & 511) + 8 * g4 + 4 * hh; unsigned char* b8 = ws + WS_VB + (size_t)(cq8 >> 7) * HB8;
#pragma unroll
                        for (int i = 0; i < 4; ++i) b8[v8_tiled_off(row, (cq8 & 127) + i)] = f2fp8(v[i]);
                        continue; }
                    u32x2 w; w.x = pk2(v[0], v[1]); w.y = pk2(v[2], v[3]);
                    const bool tiled = (nb >= 1024 && nb < 2048); const int sel2 = nb < 1536 ? 1 : 2;
                    bf16_t* dp = tiled ? dst + kv_tiled_off(sel2, row, (nb & 127) + 8 * g4 + 4 * hh) : nb < 1024 ? dst + na_tiled_off(nb >> 9, row & 63, (nb & 63) + 8 * g4 + 4 * hh) : dst + 8 * g4 + 4 * hh; *(u32x2*)dp = w; } } CTX_END
        } else if (PH_ON(K_MIX) && kind == K_MIX) { const int lane = lane_id_(); (void)lane;

            { const int nchunk = last ? 128 : 130;
              for (int rp_ = 0; rp_ < 1 + PROBE_GM; ++rp_) for (int cu = G - 1 - bid; cu < nchunk; cu += G) gm::unit(lds, Z, IN(15) + l * 512, IN(16) + l * 512, IN(17) + (size_t)l * 4 * 128 * 128, IN(18) + l * 512, cu * 128, Y + 2 * YP, wave, lane_id_()); }
            __syncthreads();
            for (int rp_ = 0; rp_ < 1 + PROBE_NA; ++rp_) for (int it = gw; it < 2048 + (last ? 0 : 32); it += NGW) { const int h = it & 7;
                const int gr = (((it >> 3) & 7) << 5) | (it >> 6);
                const int qrow0 = it < 2048 ? gr * 64 : L + ((it - 2048) >> 3) * 64, rr = it < 2048 ? gr : -1;
                na::unit(lds, Z, ws + WS_KA + (size_t)h * HA8, ws + WS_VA + (size_t)h * HA8, IN(9) + ((size_t)l * 8 + h) * 465, qrow0, rr, h, Y + h * 64, wave, lane_id_()); }
            __syncthreads();
            const float lam = LAM[l], oscale = 1.f - (0.8f - 0.6f * expf(-0.3f * (float)l));
            const unsigned char* QB = ws + WS_QB; const unsigned char* KB = ws + WS_KB; const unsigned char* VB = ws + WS_VB;
            const int nlat = (512 - bid + G - 1) / G, nctx = (!last && bid < 8) ? (8 - bid + G - 1) / G : 0;
            for (int ui = 0; ui < nlat + nctx; ++ui) { int h, q0, kbase, NT;
                if (ui < nlat) { const int uu = bid + ui * G, x = uu & 7, b = (uu >> 3) & 31, i = uu >> 8; h = x >> 1; q0 = (((x & 1) * 32 + b) * 2 + i) * 128; kbase = 0; NT = R / 64; }
                else { const int uu = bid + (ui - nlat) * G; h = uu >> 1; q0 = L + (uu & 1) * 128; kbase = L; NT = C / 64; }
                da::unit(lds, QB + (size_t)h * HB8, KB + (size_t)h * HB8, VB + (size_t)h * HB8, q0, kbase, NT, lam, IN(14) + l * 128, oscale, Y + YP + h * 128, wave, lane_id_(), (bid == STAT_BID && wave == STAT_WAVE && ui == 0 && l == 0) ? (float*)(ws + OFF_LAM + 64) : nullptr); }
        } else if (PH_ON(K_M1) && kind == K_M1) { const int lane = lane_id_(); (void)lane;

            if (!last) CTX_BEGIN(8 * 32) { const int mt = it & 7, nt = it >> 3; const int row = L + mt * 32 + r32; float m4[4][4];
#pragma unroll
                for (int g4 = 0; g4 < 4; ++g4)
#pragma unroll
                    for (int i = 0; i < 4; ++i) m4[g4][i] = 0.f;
                unsigned ao[4], bo[4];
#pragma unroll
                for (int q = 0; q < 4; ++q) { ao[q] = (unsigned)((L + mt * 32 + CTX_ROW(q)) * 512 * 2 + CTX_SWZ); bo[q] = (unsigned)((nt * 32 + CTX_ROW(q)) * 512 * 2 + CTX_SWZ); }
                for (int j = 0; j < 3; ++j) { f32x16 acc[1];
                    wgemm_lds(wl_, S_, Y + (size_t)j * YP, ao, WBR + ((size_t)l * 3 + j) * D * 512, bo, 512, acc[0], lane);
                    u32x2 gq[4];
#pragma unroll
                    for (int g4 = 0; g4 < 4; ++g4) gq[g4] = *(const u32x2*)(Z + (size_t)row * PROJZ + ZG + j * 1024 + nt * 32 + 8 * g4 + 4 * hh);
#pragma unroll
                    for (int g4 = 0; g4 < 4; ++g4) { const u32x2 gw2 = gq[g4];
                        m4[g4][0] += __uint_as_float(gw2.x << 16) * acc[0][4 * g4]; m4[g4][1] += __uint_as_float(gw2.x & 0xffff0000u) * acc[0][4 * g4 + 1];
                        m4[g4][2] += __uint_as_float(gw2.y << 16) * acc[0][4 * g4 + 2]; m4[g4][3] += __uint_as_float(gw2.y & 0xffff0000u) * acc[0][4 * g4 + 3]; } }
#pragma unroll
                for (int g4 = 0; g4 < 4; ++g4) { u32x2 w; w.x = pk2(m4[g4][0], m4[g4][1]); w.y = pk2(m4[g4][2], m4[g4][3]); *(u32x2*)(MB + (size_t)row * D + nt * 32 + 8 * g4 + 4 * hh) = w; } } CTX_END
        } else if (PH_ON(K_M2) && kind == K_M2) { const int lane = lane_id_(); (void)lane;

            const float* xl_old = l == 0 ? x_in : out; const float* xc_old = l == 0 ? ctx_in : XC;
            if (!last) CTX_BEGIN(8 * 32) { const int mt = it & 7, nt = it >> 3; const int rc = mt * 32 + r32; f32x16 acc[1]; unsigned ao[4], bo[4];
#pragma unroll
                for (int q = 0; q < 4; ++q) { ao[q] = (unsigned)((L + mt * 32 + CTX_ROW(q)) * D * 2 + CTX_SWZ); bo[q] = (unsigned)((nt * 32 + CTX_ROW(q)) * D * 2 + CTX_SWZ); }
                wgemm_lds(wl_, S_, MB, ao, WOUT + (size_t)l * D * D, bo, D, acc[0], lane);
                f32x4 xo4[4], gt4[4];
#pragma unroll
                for (int g4 = 0; g4 < 4; ++g4) { const int n = nt * 32 + 8 * g4 + 4 * hh; xo4[g4] = *(const f32x4*)(xc_old + (size_t)rc * D + n); gt4[g4] = *(const f32x4*)(mod + 6144 + 2048 + n); }
#pragma unroll
                for (int g4 = 0; g4 < 4; ++g4) { const int n = nt * 32 + 8 * g4 + 4 * hh;
                    f32x4 a; a[0] = acc[0][4 * g4]; a[1] = acc[0][4 * g4 + 1]; a[2] = acc[0][4 * g4 + 2]; a[3] = acc[0][4 * g4 + 3]; *(f32x4*)(XC + (size_t)rc * D + n) = xo4[g4] + gt4[g4] * a; } } CTX_END
        } else if (PH_ON(K_R) && kind == K_R) { const int lane = lane_id_(); (void)lane;

            const int NR = last ? L : R; const float* g2 = IN(7) + l * D; const float* w_r = IN(21) + (size_t)l * D * 16;
            LAS float* wrT = (LAS float*)lds;
            { f32x4 wq[8];
#pragma unroll
              for (int q = 0; q < 8; ++q) wq[q] = *(const f32x4*)(w_r + 4 * (tid + q * NTHREADS));
#pragma unroll
              for (int q = 0; q < 8; ++q) { const int f = tid + q * NTHREADS, k = f >> 2, e0 = 4 * (f & 3);
#pragma unroll
                  for (int j = 0; j < 4; ++j) wrT[(e0 + j) * 1024 + k] = wq[q][j]; } }
            LAS float* mA = (LAS float*)(lds + 141312); LAS float* mB = mA + 1024;
            { float ga[2], sa[2], sb[2];
#pragma unroll
              for (int q = 0; q < 2; ++q) { const int idx = tid + q * NTHREADS; ga[q] = g2[idx]; sa[q] = mod[4096 + idx]; sb[q] = mod[3072 + idx]; }
#pragma unroll
              for (int q = 0; q < 2; ++q) { const int idx = tid + q * NTHREADS; mA[idx] = ga[q] * (sa[q] + 1.f); mB[idx] = sb[q]; } }
            __syncthreads();
            f32x4 vn[4]; { float z_ = 0.f; asm volatile("" : "+v"(z_));
#pragma unroll
                for (int j = 0; j < 4; ++j) vn[j] = (f32x4){z_, z_, z_, z_}; }
            if (wave & 1) { LAS unsigned short* scr = (LAS unsigned short*)(lds + (wave < 7 ? 65536 + wave * 8448 : 132096));
              for (int it = gw; it < XCONV_R; it += NGW) EXPERT_CONV_ITEM(it, scr); }
            if (gw < NR) { const float* xp = gw < L ? out + (size_t)gw * D : XC + (size_t)(gw - L) * D;
#pragma unroll
                for (int j = 0; j < 4; ++j) vn[j] = *(const f32x4*)(xp + j * 256 + lane * 4); }
            auto r_row = [&](const int row, auto lat_tag) { constexpr bool LAT = decltype(lat_tag)::value;
                f32x4 v[4]; float s = 0.f;
#pragma unroll
                for (int j = 0; j < 4; ++j) { v[j] = vn[j]; s += (v[j][0] * v[j][0] + v[j][1] * v[j][1]) + (v[j][2] * v[j][2] + v[j][3] * v[j][3]); }
                { const int nrow = row + NGW; if (nrow < NR) { const float* xp = nrow < L ? out + (size_t)nrow * D : XC + (size_t)(nrow - L) * D;
#pragma unroll
                    for (int j = 0; j < 4; ++j) vn[j] = *(const f32x4*)(xp + j * 256 + lane * 4); } }
                const float rs = rsqrtf(wave_sum(s) * (1.f / D) + EPS);
#pragma unroll
                for (int j = 0; j < 4; ++j) { const int d = j * 256 + lane * 4; f32x4 ma, mb;
                    if constexpr (LAT) { ma = *(const LAS f32x4*)(mA + d); mb = *(const LAS f32x4*)(mB + d); }
                    else { const float* m = mod + 6144; ma = *(const f32x4*)(g2 + d) * (*(const f32x4*)(m + 4096 + d) + 1.f); mb = *(const f32x4*)(m + 3072 + d); }
                    v[j] = v[j] * rs * ma + mb; u32x2 w; w.x = pk2(v[j][0], v[j][1]); w.y = pk2(v[j][2], v[j][3]); *(u32x2*)(H2 + (size_t)row * D + d) = w; }
                float lg[16];
#pragma unroll
                for (int e = 0; e < 16; ++e) { float a = 0.f;
#pragma unroll
                    for (int j = 0; j < 4; ++j) { const f32x4 w4 = *(const LAS f32x4*)(wrT + e * 1024 + j * 256 + lane * 4); a += (v[j][0] * w4[0] + v[j][1] * w4[1]) + (v[j][2] * w4[2] + v[j][3] * w4[3]); }
                    lg[e] = a; if ((e & 3) == 3) __builtin_amdgcn_sched_barrier(0); }
                float a8[8], a4[4], a2[2];
#pragma unroll
                for (int i = 0; i < 8; ++i) { const bool hi_ = (lane & 32) != 0; a8[i] = (hi_ ? lg[8 + i] : lg[i]) + xor32f_(hi_ ? lg[i] : lg[8 + i], !hi_); }
#pragma unroll
                for (int i = 0; i < 4; ++i) { const bool hi_ = (lane & 16) != 0; a4[i] = (hi_ ? a8[4 + i] : a8[i]) + xorf_<16>(hi_ ? a8[i] : a8[4 + i]); }
#pragma unroll
                for (int i = 0; i < 2; ++i) { const bool hi_ = (lane & 8) != 0; a2[i] = (hi_ ? a4[2 + i] : a4[i]) + xorf_<8>(hi_ ? a4[i] : a4[2 + i]); }
                float lgt; { const bool hi_ = (lane & 4) != 0; lgt = (hi_ ? a2[1] : a2[0]) + xorf_<4>(hi_ ? a2[0] : a2[1]); }
                lgt += xorf_<2>(lgt); lgt += xorf_<1>(lgt);
                float mx = lgt;
                mx = fmaxf(mx, xorf_<4>(mx)); mx = fmaxf(mx, xorf_<8>(mx)); mx = fmaxf(mx, xorf_<16>(mx)); mx = fmaxf(mx, xor32f_(mx, lane < 32));
                const float ex = expf(lgt - mx); float den = ex;
                den += xorf_<4>(den); den += xorf_<8>(den); den += xorf_<16>(den); den = sum32f_(den);
                if ((lane & 3) == 0) AFF[(size_t)(lane >> 2) * R + row] = ex / den;
            };
            { int row = gw;
              for (; row < NR && row < L; row += NGW) r_row(row, std::true_type{});
              for (; row < NR; row += NGW) r_row(row, std::false_type{}); }
            if (!(wave & 1)) { LAS unsigned short* scr = (LAS unsigned short*)(lds + (wave < 7 ? 65536 + wave * 8448 : 132096));
              for (int it = gw; it < XCONV_R; it += NGW) EXPERT_CONV_ITEM(it, scr); }
        } else if (PH_ON(K_S) && kind == K_S) { const int lane = lane_id_(); (void)lane;

            LAS int* red = (LAS int*)lds; LAS int* sc_gt = red + 32; LAS int* sc_eq = sc_gt + NTHREADS;
            for (int it = bid; it < 32; it += G) { const int e = it & 15, set = it >> 4;
                const int base = set == 0 ? 0 : L, cap = set == 0 ? CAPL : CAPC, sbase = set == 0 ? 0 : CAPL;
                if (set == 1) { for (int s = CAPL + (last ? 0 : CAPC) + tid; s < SLOTS; s += NTHREADS) { IDX[e * SLOTS + s] = 0; GATE[e * SLOTS + s] = 0.f; } if (last) continue; }
                unsigned v[32];
                if (set == 0) {
#pragma unroll
                    for (int q = 0; q < 8; ++q) { const u32x4 w = *(const u32x4*)(AFF + (size_t)e * R + tid * 32 + q * 4); v[4 * q] = w.x; v[4 * q + 1] = w.y; v[4 * q + 2] = w.z; v[4 * q + 3] = w.w; }
                } else {
#pragma unroll
                    for (int i = 0; i < 32; ++i) v[i] = 0u;
                    if (tid < C) v[0] = __float_as_uint(AFF[(size_t)e * R + L + tid]);
                }
                const int per = set == 0 ? 32 : 1; const bool act = set == 0 || tid < C;
                unsigned T = 0u;
                for (int rnd = 0; rnd < 15; ++rnd) { const int b1 = 29 - 2 * rnd, b0 = b1 - 1; const unsigned c1 = T | (1u << b1), c2 = T | (1u << b0), c3 = c1 | (1u << b0);
                    int n12 = 0, n3 = 0;
#pragma unroll
                    for (int i = 0; i < 32; ++i) { n12 += (v[i] >= c1 ? 1 : 0) + (v[i] >= c2 ? 65536 : 0); n3 += v[i] >= c3 ? 1 : 0; }
                    n12 += xori_<1>(n12); n3 += xori_<1>(n3); n12 += xori_<2>(n12); n3 += xori_<2>(n3); n12 += xori_<4>(n12); n3 += xori_<4>(n3); n12 += xori_<8>(n12); n3 += xori_<8>(n3); n12 += xori_<16>(n12); n3 += xori_<16>(n3);
                    { const auto r12 = __builtin_amdgcn_permlane32_swap((unsigned)n12, (unsigned)n12, false, false), r3 = __builtin_amdgcn_permlane32_swap((unsigned)n3, (unsigned)n3, false, false); n12 = (int)(r12[0] + r12[1]); n3 = (int)(r3[0] + r3[1]); }
                    LAS int* rb = red + (rnd & 1) * 16; if (lane == 0) { rb[wave] = n12; rb[8 + wave] = n3; } __syncthreads();
                    int t12 = 0, t3 = 0;
#pragma unroll
                    for (int i = 0; i < NWAVES; ++i) { t12 += rb[i]; t3 += rb[8 + i]; }
                    const int t1 = t12 & 0xffff, t2 = t12 >> 16;
                    T = t3 >= cap ? c3 : t1 >= cap ? c1 : t2 >= cap ? c2 : T; }
                int gtc = 0, eqc = 0;
#pragma unroll
                for (int i = 0; i < 32; ++i) { const bool a = act && i < per; gtc += (a && v[i] > T) ? 1 : 0; eqc += (a && v[i] == T) ? 1 : 0; }
                __syncthreads(); sc_gt[tid] = gtc; sc_eq[tid] = eqc; __syncthreads();
                for (int o = 1; o < NTHREADS; o <<= 1) { const int a = tid >= o ? sc_gt[tid - o] : 0, b = tid >= o ? sc_eq[tid - o] : 0; __syncthreads(); sc_gt[tid] += a; sc_eq[tid] += b; __syncthreads(); }
                const int need = cap - sc_gt[NTHREADS - 1]; int gt_before = sc_gt[tid] - gtc, eq_before = sc_eq[tid] - eqc;
#pragma unroll
                for (int i = 0; i < 32; ++i) if (act && i < per) { const int tok = base + tid * per + i; int slot = -1;
                    if (v[i] > T) { slot = gt_before + (eq_before < need ? eq_before : need); ++gt_before; }
                    else if (v[i] == T) { if (eq_before < need) slot = gt_before + eq_before; ++eq_before; }
                    if (slot >= 0) { IDX[e * SLOTS + sbase + slot] = tok; GATE[e * SLOTS + sbase + slot] = __uint_as_float(v[i]); }
                    INV[(size_t)e * R + tok] = slot >= 0 ? sbase + slot : -1; }
                __syncthreads(); }
            { const int nconv = G > 32 ? G - 32 : G, cb = G > 32 ? bid - 32 : bid;
              if (cb >= 0) { LAS unsigned short* scr = (LAS unsigned short*)(lds + wave * 16384);
                  if (G <= 32) __syncthreads();
                  for (int it = XCONV_R + cb * NWAVES + wave; it < 12288; it += nconv * NWAVES) EXPERT_CONV_ITEM(it, scr); } }
        } else if (PH_ON(K_E1) && kind == K_E1) { const int lane = lane_id_(); (void)lane;

            if (!last) CTX_BEGIN(16 * 64) { const int e = it >> 6, t = it & 63, j0 = 16 * t; f32x16 acc[1]; unsigned ao[4], bo[4];
#pragma unroll
                for (int q = 0; q < 4; ++q) { const int tok = IDX[e * SLOTS + CAPL + CTX_ROW(q)]; ao[q] = (unsigned)(tok * D * 2 + CTX_SWZ);
                    bo[q] = (unsigned)((256 * (j0 >> 7) + (j0 & 127) + (q & 1) * 8 + (lane >> 3) + (q >> 1) * 128) * D * 2 + CTX_SWZ); }
                wgemm_lds(wl_, S_, H2, ao, W13 + ((size_t)l * 16 + e) * 2048 * D, bo, D, acc[0], lane);
#pragma unroll
                for (int g4 = 0; g4 < 2; ++g4) { float v[4];
#pragma unroll
                    for (int i = 0; i < 4; ++i) v[i] = siluf_(acc[0][4 * g4 + i]) * acc[0][4 * (g4 + 2) + i];
                    u32x2 w; w.x = pk2(v[0], v[1]); w.y = pk2(v[2], v[3]); *(u32x2*)(HID + ((size_t)e * SLOTS + CAPL + r32) * FF + j0 + 8 * g4 + 4 * hh) = w; } } CTX_END
        } else if (PH_ON(K_E2) && kind == K_E2) { const int lane = lane_id_(); (void)lane;

            if (!last) CTX_BEGIN(16 * 32) { const int e = it >> 5, nt = it & 31; f32x16 acc[1]; const size_t row = (size_t)e * SLOTS + CAPL + r32; unsigned ao[4], bo[4];
#pragma unroll
                for (int q = 0; q < 4; ++q) { ao[q] = (unsigned)((e * SLOTS + CAPL + CTX_ROW(q)) * FF * 2 + CTX_SWZ); bo[q] = (unsigned)((nt * 32 + CTX_ROW(q)) * FF * 2 + CTX_SWZ); }
                wgemm_lds(wl_, S_, HID, ao, W2 + ((size_t)l * 16 + e) * D * FF, bo, FF, acc[0], lane);
                const float gsc = GATE[row];
#pragma unroll
                for (int g4 = 0; g4 < 4; ++g4) { u32x2 w; w.x = pk2(acc[0][4 * g4] * gsc, acc[0][4 * g4 + 1] * gsc); w.y = pk2(acc[0][4 * g4 + 2] * gsc, acc[0][4 * g4 + 3] * gsc);
                    *(u32x2*)(YE + row * D + nt * 32 + 8 * g4 + 4 * hh) = w; } } CTX_END
        } else if (PH_ON(K_CB) && kind == K_CB) { const int lane = lane_id_(); (void)lane;

            const int NR = last ? L : R; const float* gn = last ? IN(25) : IN(6) + D; const float* modn = MOD + (size_t)2 * 6144;
            f32x4 vn[4]; int invn = -1; { float z_ = 0.f; asm volatile("" : "+v"(z_));
#pragma unroll
                for (int j = 0; j < 4; ++j) vn[j] = (f32x4){z_, z_, z_, z_}; }
            if (gw < NR) { const float* xp = gw < L ? out + (size_t)gw * D : XC + (size_t)(gw - L) * D;
#pragma unroll
                for (int j = 0; j < 4; ++j) vn[j] = *(const f32x4*)(xp + j * 256 + lane * 4);
                invn = lane < 16 ? INV[(size_t)lane * R + gw] : -1; }
            LAS float* vG = (LAS float*)lds; LAS float* vA = vG + 1024; LAS float* vB = vA + 1024;
            { float g_[2], a_[2], b_[2], c_[2];
#pragma unroll
              for (int q = 0; q < 2; ++q) { const int idx = tid + q * NTHREADS; g_[q] = mod[5120 + idx]; a_[q] = gn[idx]; b_[q] = last ? 0.f : modn[1024 + idx]; c_[q] = last ? 0.f : modn[idx]; }
#pragma unroll
              for (int q = 0; q < 2; ++q) { const int idx = tid + q * NTHREADS; vG[idx] = g_[q]; vA[idx] = a_[q] * (b_[q] + 1.f); vB[idx] = c_[q]; } }
            __syncthreads();
            auto cb_row = [&](const int row, auto lat_tag) { constexpr bool LAT = decltype(lat_tag)::value;
                float* x = row < L ? out + (size_t)row * D : XC + (size_t)(row - L) * D; const float* m = mod + (row < L ? 0 : 6144);
                f32x4 v[4], a[4];
#pragma unroll
                for (int j = 0; j < 4; ++j) { v[j] = vn[j]; a[j] = (f32x4){0.f, 0.f, 0.f, 0.f}; }
                const int myinv = invn;
                { const int nrow = row + NGW; if (nrow < NR) { const float* xp = nrow < L ? out + (size_t)nrow * D : XC + (size_t)(nrow - L) * D;
#pragma unroll
                    for (int j = 0; j < 4; ++j) vn[j] = *(const f32x4*)(xp + j * 256 + lane * 4);
                    invn = lane < 16 ? INV[(size_t)lane * R + nrow] : -1; } }
                unsigned long long msk = __ballot(myinv >= 0);
                while (msk) { const int e0 = __builtin_ctzll(msk); msk &= msk - 1; const bool has1 = msk != 0ull; const int e1 = has1 ? __builtin_ctzll(msk) : e0; if (has1) msk &= msk - 1;
                    const int s0 = __builtin_amdgcn_readlane(myinv, e0), s1 = __builtin_amdgcn_readlane(myinv, e1); const float w1 = has1 ? 1.f : 0.f;
                    const bf16_t* y0 = YE + ((size_t)e0 * SLOTS + s0) * D; const bf16_t* y1 = YE + ((size_t)e1 * SLOTS + s1) * D;
                    u32x2 u0[4], u1[4];
#pragma unroll
                    for (int j = 0; j < 4; ++j) { u0[j] = *(const u32x2*)(y0 + j * 256 + lane * 4); u1[j] = *(const u32x2*)(y1 + j * 256 + lane * 4); }
#pragma unroll
                    for (int j = 0; j < 4; ++j) { a[j][0] += __uint_as_float(u0[j].x << 16) + w1 * __uint_as_float(u1[j].x << 16); a[j][1] += __uint_as_float(u0[j].x & 0xffff0000u) + w1 * __uint_as_float(u1[j].x & 0xffff0000u);
                        a[j][2] += __uint_as_float(u0[j].y << 16) + w1 * __uint_as_float(u1[j].y << 16); a[j][3] += __uint_as_float(u0[j].y & 0xffff0000u) + w1 * __uint_as_float(u1[j].y & 0xffff0000u); } }
                float s = 0.f;
#pragma unroll
                for (int j = 0; j < 4; ++j) { f32x4 gt; if constexpr (LAT) gt = *(const LAS f32x4*)(vG + j * 256 + lane * 4); else gt = *(const f32x4*)(m + 5120 + j * 256 + lane * 4); v[j] = v[j] + gt * a[j]; s += (v[j][0] * v[j][0] + v[j][1] * v[j][1]) + (v[j][2] * v[j][2] + v[j][3] * v[j][3]); }
                const float rs = rsqrtf(wave_sum(s) * (1.f / D) + EPS);
                if (last) {
#pragma unroll
                    for (int j = 0; j < 4; ++j) { const int d = j * 256 + lane * 4; *(f32x4*)(out + (size_t)row * D + d) = v[j] * rs * *(const LAS f32x4*)(vA + d); }
#if DA_STAT
                    if (row == 0 && lane == 0) out[0] += *(const float*)(ws + OFF_LAM + 64);
#endif
                } else { const float* mn = modn + (row < L ? 0 : 6144);
#pragma unroll
                    for (int j = 0; j < 4; ++j) { const int d = j * 256 + lane * 4; *(f32x4*)(x + d) = v[j];
                        f32x4 h; if constexpr (LAT) h = v[j] * rs * *(const LAS f32x4*)(vA + d) + *(const LAS f32x4*)(vB + d); else h = v[j] * rs * *(const f32x4*)(gn + d) * (*(const f32x4*)(mn + 1024 + d) + 1.f) + *(const f32x4*)(mn + d);
                        u32x2 w; w.x = pk2(h[0], h[1]); w.y = pk2(h[2], h[3]); *(u32x2*)(H + (size_t)row * D + d) = w; } }
            };
            { int row = gw;
              for (; row < NR && row < L; row += NGW) cb_row(row, std::true_type{});
              for (; row < NR; row += NGW) cb_row(row, std::false_type{}); }
        }
        if (ph + 1 < args.ph_hi) xcd_barrier(bar, wave * 64 + lane_id_());
#if PROBE_KIND >= 0
        if (kind == PROBE_KIND && !(kind == K_M2 && l == 1) && nrep_ < PROBE_N && ph + 1 < args.ph_hi) { ++nrep_; --ph; } else nrep_ = 0;
#endif
    }
}
#undef tid
#undef r32
#undef hh


#ifndef FAST_TAIL
#define FAST_TAIL 1
#endif
static void launch_mk(const Args& base, int lo, int hi, int li, int grid, hipStream_t stream) {
    Args a = base; a.ph_lo = lo; a.ph_hi = hi; a.li = li;
    hipLaunchKernelGGL(mk_fwd, dim3(grid), dim3(NTHREADS), LDS_BYTES, stream, a);
}
extern "C" void kernel_launch(void* const* d_in, const int* in_sizes, int n_in, void* d_out, int out_size, void* d_ws, size_t ws_size, hipStream_t stream) {
    static int grid = 0;
    if (grid == 0) {
        if (n_in != 26 || ws_size < WS_END) { fprintf(stderr, "kernel_launch: bad arguments (n_in %d, ws %zu < %zu)\n", n_in, ws_size, (size_t)WS_END); grid = -1; return; }
        int dev = 0, cus = 0;
        if (hipGetDevice(&dev) != hipSuccess || hipDeviceGetAttribute(&cus, hipDeviceAttributeMultiprocessorCount, dev) != hipSuccess) { grid = -1; return; }
        if (hipFuncSetAttribute((const void*)mk_fwd, hipFuncAttributeMaxDynamicSharedMemorySize, LDS_BYTES) != hipSuccess) { fprintf(stderr, "kernel_launch: hipFuncSetAttribute failed\n"); grid = -1; return; }
        int nb = 0;
        if (hipOccupancyMaxActiveBlocksPerMultiprocessor(&nb, (const void*)mk_fwd, NTHREADS, LDS_BYTES) != hipSuccess || nb < 1) { fprintf(stderr, "kernel_launch: the occupancy query grants no resident workgroup per CU\n"); grid = -1; return; }
        grid = cus;
    }
    if (grid < 0) return;
    (void)hipMemsetAsync((char*)d_ws + WS_CTL, 0, CTL_ZERO_BYTES, stream);
    Args base{};
    for (int i = 0; i < 26; ++i) base.in[i] = (const float*)d_in[i];
    base.out = (float*)d_out; base.ws = (unsigned char*)d_ws;
    launch_mk(base, 0, N_PHASES, 0, grid, stream);
}
```
